# Optimizing an MI355X kernel written in HIP

```python
import jax, jax.numpy as jnp
from jax import lax
import numpy as np

D_MODEL = 2048
BATCH = 2
SEQ = 16384
DEPTH = 1

HEAD_DIM = 128
N_MIX_HEADS = D_MODEL // HEAD_DIM
GMLP_GROUPS = N_MIX_HEADS // 4
NSA_HEADS = N_MIX_HEADS // 2
NSA_KV_HEADS = 2
XATTN_HEADS = N_MIX_HEADS // 4
GMLP_WIDTH = GMLP_GROUPS * HEAD_DIM
NSA_WIDTH = NSA_HEADS * HEAD_DIM
NSA_KV_WIDTH = NSA_KV_HEADS * HEAD_DIM
XATTN_WIDTH = XATTN_HEADS * HEAD_DIM
MIX_WIDTH = GMLP_WIDTH + NSA_WIDTH + XATTN_WIDTH
MEM_TOKENS = 256

GMLP_CHUNK = 128
CMP_LEN = 32
CMP_STRIDE = 16
SEL_BLOCK = 64
SEL_TOPK = 16
WINDOW = 512
Q_BLOCK = 128

N_EXPERTS = 32
TOP_K = 4
D_FF_EXPERT = D_MODEL
SWIGLU_ALPHA = 1.702
SWIGLU_LIMIT = 7.0
MOE_BLOCK = 512

ROPE_THETA = 10000.0
EPS = 1e-6

COL_SIZES = (2 * GMLP_WIDTH,
             NSA_WIDTH,
             6 * NSA_KV_WIDTH,
             3 * NSA_HEADS,
             XATTN_WIDTH)
IN_COLS = sum(COL_SIZES)

kernel_name = "hybrid_gmlp_nsa_xattn_moe_layer"


def rms_norm(x, g):
    xf = x.astype(jnp.float32)
    y = xf * lax.rsqrt(jnp.mean(xf * xf, axis=-1, keepdims=True) + EPS)
    return (y * g.astype(jnp.float32)).astype(x.dtype)


def rope(x, pos):
    dh = x.shape[-1]
    half = dh // 2
    inv = ROPE_THETA ** (-jnp.arange(half, dtype=jnp.float32) * 2.0 / dh)
    ang = pos.astype(jnp.float32)[:, :, None, None] * inv
    cos, sin = jnp.cos(ang), jnp.sin(ang)
    x1 = x[..., :half].astype(jnp.float32)
    x2 = x[..., half:].astype(jnp.float32)
    return jnp.concatenate([x1 * cos - x2 * sin, x2 * cos + x1 * sin], axis=-1).astype(x.dtype)


def masked_softmax(s, mask):
    s = jnp.where(mask, s.astype(jnp.float32), -jnp.inf)
    m = jnp.max(s, axis=-1, keepdims=True)
    m = jnp.where(jnp.isfinite(m), m, 0.0)
    e = jnp.exp(s - m)
    d = jnp.sum(e, axis=-1, keepdims=True)
    return e / jnp.where(d > 0, d, 1.0)


def gmlp_mixer(uv, w_s, b_s, g_v):
    B, S, _ = uv.shape
    uv = jax.nn.gelu(uv)
    u, v = jnp.split(uv, 2, axis=-1)
    v = rms_norm(v.reshape(B, S, GMLP_GROUPS, HEAD_DIM), g_v)
    v = v.reshape(B, S // GMLP_CHUNK, GMLP_CHUNK, GMLP_GROUPS, HEAD_DIM)
    causal = jnp.tril(jnp.ones((GMLP_CHUNK, GMLP_CHUNK), w_s.dtype))
    w = w_s * causal[None]
    vs = jnp.einsum('gts,bnsgd->bntgd', w, v) + jnp.transpose(b_s)[None, None, :, :, None]
    return u * vs.reshape(B, S, GMLP_WIDTH)


def nsa_mixer(q, k_cmp, v_cmp, k_sel, v_sel, k_win, v_win, gate_logits, positions,
              cmp_pos, w_ck1, w_ck2, w_cv1, w_cv2, q_g, k_g):
    B, S, H, dh = q.shape
    G = k_cmp.shape[2]
    R = H // G
    scale = dh ** -0.5
    n_cmp = (S - CMP_LEN) // CMP_STRIDE + 1
    n_sel = S // SEL_BLOCK
    n_qb = S // Q_BLOCK
    k_top = min(SEL_TOPK, n_sel)

    cmp_idx = jnp.arange(n_cmp)[:, None] * CMP_STRIDE + jnp.arange(CMP_LEN)[None, :]

    def compress(t, w1, w2):
        blk = t[:, cmp_idx] + cmp_pos[None, None, :, None, :].astype(t.dtype)
        blk = jnp.transpose(blk, (0, 1, 3, 2, 4)).reshape(B, n_cmp, G, CMP_LEN * dh)
        return jax.nn.gelu(blk @ w1) @ w2

    kc = rms_norm(compress(k_cmp, w_ck1, w_ck2), k_g)
    vc = compress(v_cmp, w_cv1, w_cv2)
    cmp_end = jnp.arange(n_cmp) * CMP_STRIDE + CMP_LEN - 1

    qn = rms_norm(q, q_g)
    qr = rope(qn, positions)
    ks = rope(rms_norm(k_sel, k_g), positions)
    kw = rope(rms_norm(k_win, k_g), positions)

    ks_blk = jnp.transpose(ks.reshape(B, n_sel, SEL_BLOCK, G, dh), (0, 3, 1, 2, 4))
    vs_blk = jnp.transpose(v_sel.reshape(B, n_sel, SEL_BLOCK, G, dh), (0, 3, 1, 2, 4))
    pad = ((0, 0), (WINDOW, 0), (0, 0), (0, 0))
    kw_pad = jnp.pad(kw, pad)
    vw_pad = jnp.pad(v_win, pad)

    ratio = SEL_BLOCK // CMP_STRIDE
    offs = (jnp.arange(ratio)[:, None] - jnp.arange(CMP_LEN // CMP_STRIDE)[None, :]).reshape(-1)
    diff = jnp.arange(n_cmp)[:, None] - ratio * jnp.arange(n_sel)[None, :]
    cmp_to_sel = (diff[..., None] == offs).sum(-1).astype(jnp.float32)
    sel_start = jnp.arange(n_sel) * SEL_BLOCK
    sel_ids = jnp.arange(n_sel)

    def to_blocks(a):
        a = a.reshape((B, n_qb, Q_BLOCK) + a.shape[2:])
        return jnp.moveaxis(a, 1, 0)

    qn_b = to_blocks(qn.reshape(B, S, G, R, dh))
    qr_b = to_blocks(qr.reshape(B, S, G, R, dh))
    gt_b = to_blocks(jax.nn.sigmoid(gate_logits.astype(jnp.float32)).reshape(B, S, G, R, 3))

    gather2 = jax.vmap(jax.vmap(lambda kb, ix: kb[ix]))

    def block(args):
        bi, qn_i, qr_i, g_i = args
        s0 = bi * Q_BLOCK
        t = s0 + jnp.arange(Q_BLOCK)
        sc = jnp.einsum('bqgrd,bngd->bgrqn', qn_i, kc) * scale
        pc = masked_softmax(sc, cmp_end[None, :] <= t[:, None])
        o_c = jnp.einsum('bgrqn,bngd->bqgrd', pc.astype(vc.dtype), vc)
        imp = jnp.einsum('bgqn,ns->bgqs', pc.sum(axis=2), cmp_to_sel)
        cur = t // SEL_BLOCK
        valid = sel_start[None, :] <= t[:, None]
        forced = (sel_ids[None, :] == 0) | (sel_ids[None, :] == cur[:, None]) | (sel_ids[None, :] == cur[:, None] - 1)
        score = jnp.where(valid, jnp.where(forced, jnp.inf, imp), -jnp.inf)
        _, idx = lax.top_k(score, k_top)
        kg = gather2(ks_blk, idx)
        vg = gather2(vs_blk, idx)
        ss = jnp.einsum('bqgrd,bgqksd->bgrqks', qr_i, kg) * scale
        tok = idx[..., None] * SEL_BLOCK + jnp.arange(SEL_BLOCK)
        smask = (tok <= t[None, None, :, None, None]).reshape(B, G, 1, Q_BLOCK, -1)
        ps = masked_softmax(ss.reshape(B, G, R, Q_BLOCK, -1), smask).reshape(ss.shape)
        o_s = jnp.einsum('bgrqks,bgqksd->bqgrd', ps.astype(vg.dtype), vg)
        kwi = lax.dynamic_slice_in_dim(kw_pad, s0, Q_BLOCK + WINDOW, axis=1)
        vwi = lax.dynamic_slice_in_dim(vw_pad, s0, Q_BLOCK + WINDOW, axis=1)
        kp = s0 - WINDOW + jnp.arange(Q_BLOCK + WINDOW)
        wmask = (kp[None, :] <= t[:, None]) & (kp[None, :] > t[:, None] - WINDOW) & (kp[None, :] >= 0)
        sw = jnp.einsum('bqgrd,bkgd->bgrqk', qr_i, kwi) * scale
        pw = masked_softmax(sw, wmask)
        o_w = jnp.einsum('bgrqk,bkgd->bqgrd', pw.astype(vwi.dtype), vwi)
        g_i = g_i.astype(o_c.dtype)
        return g_i[..., 0:1] * o_c + g_i[..., 1:2] * o_s + g_i[..., 2:3] * o_w

    out = lax.map(block, (jnp.arange(n_qb), qn_b, qr_b, gt_b))
    return jnp.moveaxis(out, 0, 1).reshape(B, S, H * dh)


def memory_cross_attn(q, mem_kv, q_g, k_g):
    B, M, _ = mem_kv.shape
    k, v = jnp.split(mem_kv, 2, axis=-1)
    k = rms_norm(k.reshape(B, M, XATTN_HEADS, HEAD_DIM), k_g)
    v = v.reshape(B, M, XATTN_HEADS, HEAD_DIM)
    q = rms_norm(q, q_g)
    s = jnp.einsum('bshd,bmhd->bhsm', q, k) * (HEAD_DIM ** -0.5)
    p = jax.nn.softmax(s.astype(jnp.float32), axis=-1)
    o = jnp.einsum('bhsm,bmhd->bshd', p.astype(v.dtype), v)
    return o.reshape(q.shape[0], q.shape[1], XATTN_WIDTH)


def moe_ffn(h, w_router, b_router, w1, b1, w2, b2):
    B, S, D = h.shape
    T = B * S
    xs = h.reshape(T, D)
    logits = (xs @ w_router + b_router).astype(jnp.float32)
    top_vals, top_idx = lax.top_k(logits, TOP_K)
    gate = jax.nn.softmax(top_vals, axis=-1).astype(xs.dtype)
    N = T * TOP_K
    e_flat = top_idx.reshape(N)
    tok_flat = jnp.repeat(jnp.arange(T, dtype=jnp.int32), TOP_K)
    g_flat = gate.reshape(N)
    order = jnp.argsort(e_flat)
    e_sorted = e_flat[order]
    tok_sorted = tok_flat[order]
    g_sorted = g_flat[order]
    counts = jnp.bincount(e_flat, length=N_EXPERTS)
    start = jnp.cumsum(counts) - counts
    padded = ((counts + MOE_BLOCK - 1) // MOE_BLOCK) * MOE_BLOCK
    pend = jnp.cumsum(padded)
    pstart = pend - padded
    dest = pstart[e_sorted] + (jnp.arange(N) - start[e_sorted])
    n_blocks = -(-(N + N_EXPERTS * (MOE_BLOCK - 1)) // MOE_BLOCK)
    rows = n_blocks * MOE_BLOCK
    row_tok = jnp.zeros((rows,), jnp.int32).at[dest].set(tok_sorted)
    row_g = jnp.zeros((rows,), xs.dtype).at[dest].set(g_sorted)
    block_e = jnp.minimum(jnp.searchsorted(pend, jnp.arange(n_blocks) * MOE_BLOCK, side='right'), N_EXPERTS - 1)

    def body(acc, inp):
        e, tok, g = inp
        hb = xs[tok] @ w1[e] + b1[e]
        glu = jnp.minimum(hb[:, 0::2], SWIGLU_LIMIT)
        lin = jnp.clip(hb[:, 1::2], -SWIGLU_LIMIT, SWIGLU_LIMIT)
        act = glu * jax.nn.sigmoid(SWIGLU_ALPHA * glu) * (lin + 1)
        yb = act @ w2[e] + b2[e]
        return acc.at[tok].add(yb * g[:, None]), None

    acc, _ = lax.scan(body, jnp.zeros((T, D), xs.dtype),
                      (block_e, row_tok.reshape(n_blocks, MOE_BLOCK), row_g.reshape(n_blocks, MOE_BLOCK)))
    return acc.reshape(B, S, D)


def setup_inputs(seed: int = 0) -> dict:
    key = jax.random.key(seed)
    ks = jax.random.split(key, 32)
    f32 = jnp.float32
    L = DEPTH

    def nrm(k, shape, fan_in):
        return jax.random.normal(k, shape, f32) * (fan_in ** -0.5)

    def gain(k, shape):
        return 1.0 + 0.02 * jax.random.normal(k, shape, f32)

    return {
        "x": jax.random.normal(ks[0], (BATCH, SEQ, D_MODEL), f32),
        "mem": jax.random.normal(ks[1], (BATCH, MEM_TOKENS, D_MODEL), f32),
        "positions": jnp.broadcast_to(jnp.arange(SEQ, dtype=jnp.int32), (BATCH, SEQ)),
        "mix_norm_g": gain(ks[2], (L, D_MODEL)),
        "mem_norm_g": gain(ks[3], (L, D_MODEL)),
        "w_in": nrm(ks[4], (L, D_MODEL, IN_COLS), D_MODEL),
        "w_out": nrm(ks[5], (L, MIX_WIDTH, D_MODEL), MIX_WIDTH),
        "gmlp_ws": nrm(ks[6], (L, GMLP_GROUPS, GMLP_CHUNK, GMLP_CHUNK), GMLP_CHUNK),
        "gmlp_bs": gain(ks[7], (L, GMLP_GROUPS, GMLP_CHUNK)),
        "gmlp_vg": gain(ks[8], (L, GMLP_GROUPS, HEAD_DIM)),
        "nsa_cmp_pos": 0.5 * jax.random.normal(ks[9], (L, CMP_LEN, HEAD_DIM), f32),
        "nsa_ck1": nrm(ks[10], (L, CMP_LEN * HEAD_DIM, HEAD_DIM), CMP_LEN * HEAD_DIM),
        "nsa_ck2": nrm(ks[11], (L, HEAD_DIM, HEAD_DIM), HEAD_DIM),
        "nsa_cv1": nrm(ks[12], (L, CMP_LEN * HEAD_DIM, HEAD_DIM), CMP_LEN * HEAD_DIM),
        "nsa_cv2": nrm(ks[13], (L, HEAD_DIM, HEAD_DIM), HEAD_DIM),
        "nsa_q_g": gain(ks[14], (L, HEAD_DIM)),
        "nsa_k_g": gain(ks[15], (L, HEAD_DIM)),
        "xattn_wkv": nrm(ks[16], (L, D_MODEL, 2 * XATTN_WIDTH), D_MODEL),
        "xattn_q_g": gain(ks[17], (L, HEAD_DIM)),
        "xattn_k_g": gain(ks[18], (L, HEAD_DIM)),
        "ffn_norm_g": gain(ks[19], (L, D_MODEL)),
        "w_router": nrm(ks[20], (L, D_MODEL, N_EXPERTS), D_MODEL),
        "b_router": 0.01 * jax.random.normal(ks[21], (L, N_EXPERTS), f32),
        "w_e1": nrm(ks[22], (L, N_EXPERTS, D_MODEL, 2 * D_FF_EXPERT), D_MODEL),
        "b_e1": 0.01 * jax.random.normal(ks[23], (L, N_EXPERTS, 2 * D_FF_EXPERT), f32),
        "w_e2": nrm(ks[24], (L, N_EXPERTS, D_FF_EXPERT, D_MODEL), D_FF_EXPERT),
        "b_e2": 0.01 * jax.random.normal(ks[25], (L, N_EXPERTS, D_MODEL), f32),
    }


def reference(x, mem, positions, mix_norm_g, mem_norm_g, w_in, w_out, gmlp_ws, gmlp_bs, gmlp_vg,
              nsa_cmp_pos, nsa_ck1, nsa_ck2, nsa_cv1, nsa_cv2, nsa_q_g, nsa_k_g,
              xattn_wkv, xattn_q_g, xattn_k_g, ffn_norm_g, w_router, b_router,
              w_e1, b_e1, w_e2, b_e2):
    B, S, _ = x.shape
    split_pts = [int(v) for v in np.cumsum(COL_SIZES)[:-1]]
    for l in range(DEPTH):
        h = rms_norm(x, mix_norm_g[l])
        proj = h @ w_in[l]
        uv, q_nsa, kv_nsa, gate_nsa, q_x = jnp.split(proj, split_pts, axis=-1)
        y_a = gmlp_mixer(uv, gmlp_ws[l], gmlp_bs[l], gmlp_vg[l])
        kvs = [t.reshape(B, S, NSA_KV_HEADS, HEAD_DIM) for t in jnp.split(kv_nsa, 6, axis=-1)]
        y_b = nsa_mixer(q_nsa.reshape(B, S, NSA_HEADS, HEAD_DIM), kvs[0], kvs[1], kvs[2], kvs[3],
                        kvs[4], kvs[5], gate_nsa, positions, nsa_cmp_pos[l], nsa_ck1[l], nsa_ck2[l],
                        nsa_cv1[l], nsa_cv2[l], nsa_q_g[l], nsa_k_g[l])
        mem_kv = rms_norm(mem, mem_norm_g[l]) @ xattn_wkv[l]
        y_c = memory_cross_attn(q_x.reshape(B, S, XATTN_HEADS, HEAD_DIM), mem_kv, xattn_q_g[l], xattn_k_g[l])
        mix = jnp.concatenate([y_a, y_b, y_c], axis=-1)
        x = x + mix @ w_out[l]
        h2 = rms_norm(x, ffn_norm_g[l])
        x = x + moe_ffn(h2, w_router[l], b_router[l], w_e1[l], b_e1[l], w_e2[l], b_e2[l])
    return x
```

```cpp
#include <hip/hip_runtime.h>
#include <cstdio>
#include <cstdint>

#ifndef MK_N_LAUNCHES
#define MK_N_LAUNCHES 1
#endif

#define LAS __attribute__((address_space(3)))
typedef unsigned short bf16_t;
typedef short bf16x8 __attribute__((ext_vector_type(8)));
typedef float f32x4 __attribute__((ext_vector_type(4)));
typedef float f32x2 __attribute__((ext_vector_type(2)));
typedef _Float16 f16x8 __attribute__((ext_vector_type(8)));
typedef float f32x8 __attribute__((ext_vector_type(8)));
typedef unsigned u32x4 __attribute__((ext_vector_type(4)));
typedef unsigned u32x2 __attribute__((ext_vector_type(2)));

constexpr int NB = 2, S_ = 16384, T_ = NB * S_, D_ = 2048, MEMT = 256;
constexpr int NPROJ = 4352;
constexpr int C_UV = 0, C_Q = 1024, C_KV = 2048, C_QX = 3584, C_GATE = 4096;
constexpr int IN_COLS = 4120;
constexpr int NEXP = 32, FF = 2048;
constexpr int LIST_CAP = T_;
constexpr int MAX_TILES = (T_ * 4) / 256 + NEXP;
constexpr float EPS = 1e-6f;

constexpr size_t al256(size_t x) { return (x + 255) & ~(size_t)255; }
constexpr size_t WS_CTL   = 0;
constexpr size_t CTL_BYTES = 65536;
constexpr size_t WS_H     = al256(WS_CTL + CTL_BYTES);
constexpr size_t WS_WIN   = al256(WS_H + (size_t)T_ * D_ * 2);
constexpr size_t WS_WOUT  = al256(WS_WIN + (size_t)NPROJ * D_ * 2);
constexpr size_t WS_W1T   = al256(WS_WOUT + (size_t)D_ * D_ * 2);
constexpr size_t WS_W2T   = al256(WS_W1T + (size_t)NEXP * 4096 * D_ * 2);
constexpr size_t WS_WKV   = al256(WS_W2T + (size_t)NEXP * D_ * FF * 2);
constexpr size_t WS_WRH   = al256(WS_WKV + (size_t)1024 * D_ * 2);
constexpr size_t WS_WRL   = al256(WS_WRH + (size_t)32 * D_ * 2);
constexpr size_t WS_CK1   = al256(WS_WRL + (size_t)32 * D_ * 2);
constexpr size_t WS_CV1   = al256(WS_CK1 + (size_t)128 * 4096 * 2);
constexpr size_t WS_CK2   = al256(WS_CV1 + (size_t)128 * 4096 * 2);
constexpr size_t WS_CV2   = al256(WS_CK2 + (size_t)128 * 128 * 2);
constexpr size_t WS_C1    = al256(WS_CV2 + (size_t)128 * 128 * 2);
constexpr size_t WS_B1G   = al256(WS_C1 + 1024);
constexpr size_t WS_B1L   = al256(WS_B1G + (size_t)NEXP * FF * 4);
constexpr size_t WS_GWS   = al256(WS_B1L + (size_t)NEXP * FF * 4);
constexpr size_t WS_MISC  = al256(WS_GWS + (size_t)4 * 128 * 128 * 2);
constexpr size_t WS_MEMN  = al256(WS_MISC + 1024);
constexpr size_t WS_PROJ  = al256(WS_MEMN + (size_t)512 * D_ * 2);
constexpr size_t WS_MEMKV = al256(WS_PROJ + (size_t)T_ * NPROJ * 2);
constexpr size_t WS_UB    = al256(WS_MEMKV + (size_t)512 * 1024 * 2);
constexpr size_t WS_VTG   = al256(WS_UB + (size_t)T_ * 512 * 2);
constexpr size_t WS_QN    = al256(WS_VTG + (size_t)T_ * 512 * 2);
constexpr size_t WS_QR    = al256(WS_QN + (size_t)T_ * 1024 * 2);
constexpr size_t KVROWS   = (size_t)NB * 2 * S_ + 64;
constexpr size_t WS_KCMP  = al256(WS_QR + (size_t)T_ * 1024 * 2);
constexpr size_t WS_VCMP  = al256(WS_KCMP + KVROWS * 128 * 2);
constexpr size_t WS_KSEL  = al256(WS_VCMP + KVROWS * 128 * 2);
constexpr size_t WS_KWIN  = al256(WS_KSEL + KVROWS * 128 * 2);
constexpr size_t WS_VSELT = al256(WS_KWIN + KVROWS * 128 * 2);
constexpr size_t WS_VWINT = al256(WS_VSELT + KVROWS * 128 * 2);
constexpr size_t WS_KC    = al256(WS_VWINT + KVROWS * 128 * 2);
constexpr size_t WS_VCT   = al256(WS_KC + (size_t)4 * 1024 * 128 * 2);
constexpr size_t WS_KX    = al256(WS_VCT + (size_t)4 * 1024 * 128 * 2);
constexpr size_t WS_VXT   = al256(WS_KX + (size_t)8 * 256 * 128 * 2);
constexpr size_t WS_QX    = al256(WS_VXT + (size_t)8 * 256 * 128 * 2);
constexpr size_t WS_GATES = al256(WS_QX + (size_t)T_ * 512 * 2);
constexpr size_t WS_MIXACC= al256(WS_GATES + (size_t)T_ * 24 * 4);
constexpr size_t WS_MIX   = al256(WS_MIXACC + (size_t)T_ * 1024 * 4);
constexpr size_t WS_IDX   = al256(WS_MIX + (size_t)T_ * D_ * 2);
constexpr size_t WS_ROWSS = al256(WS_IDX + (size_t)4 * S_ * 16 * 4);
constexpr size_t WS_PAIRG = al256(WS_ROWSS + (size_t)T_ * 32 * 4);
constexpr size_t WS_LIST  = al256(WS_PAIRG + (size_t)T_ * 4 * 4);
constexpr size_t WS_LGATE = al256(WS_LIST + (size_t)NEXP * LIST_CAP * 4);
constexpr size_t WS_H8    = al256(WS_LGATE + (size_t)NEXP * LIST_CAP * 4);
constexpr size_t WS_WIN8  = al256(WS_H8 + (size_t)T_ * D_);
constexpr size_t WS_ACT   = al256(WS_WIN8 + (size_t)3328 * D_);
constexpr size_t WS_Y     = al256(WS_ACT + (size_t)MAX_TILES * 256 * FF * 2);
constexpr size_t WS_X1H   = al256(WS_Y + (size_t)T_ * 4 * D_ * 2);
constexpr size_t WS_B2C   = al256(WS_X1H + (size_t)T_ * D_ * 2);
constexpr size_t WS_END   = al256(WS_B2C + (size_t)NEXP * D_ * 4);
constexpr int CW_BAR = 0;
constexpr int CW_GCOUNT = 4096;
constexpr int CW_XSLOT = 4352;

constexpr int LDS_SCRATCH = 139264;
constexpr int LDS_MISC = LDS_SCRATCH;
constexpr int LDS_BYTES = 147456;

__device__ __forceinline__ float bf2f(bf16_t v) { return __uint_as_float(((unsigned)v) << 16); }
__device__ __forceinline__ bf16_t f2bf(float f) { unsigned u = __float_as_uint(f); u += 0x7FFFu + ((u >> 16) & 1u); return (bf16_t)(u >> 16); }
__device__ __forceinline__ unsigned cvt_pk_bf16(float lo, float hi) { unsigned r; asm volatile("v_cvt_pk_bf16_f32 %0, %1, %2" : "=v"(r) : "v"(lo), "v"(hi)); return r; }
__device__ __forceinline__ bf16x8 pack8(float a0, float a1, float a2, float a3, float a4, float a5, float a6, float a7) {
    u32x4 w = {cvt_pk_bf16(a0, a1), cvt_pk_bf16(a2, a3), cvt_pk_bf16(a4, a5), cvt_pk_bf16(a6, a7)}; return __builtin_bit_cast(bf16x8, w); }
__device__ __forceinline__ unsigned pk4_fp8(float a, float b, float c, float d) {
    a = fminf(fmaxf(a, -448.f), 448.f); b = fminf(fmaxf(b, -448.f), 448.f); c = fminf(fmaxf(c, -448.f), 448.f); d = fminf(fmaxf(d, -448.f), 448.f);
    int p = __builtin_amdgcn_cvt_pk_fp8_f32(a, b, 0, false); p = __builtin_amdgcn_cvt_pk_fp8_f32(c, d, p, true); return (unsigned)p; }
typedef int i32x4 __attribute__((ext_vector_type(4)));
typedef int i32x8 __attribute__((ext_vector_type(8)));
constexpr float W_FP8_SCALE = 256.0f;
constexpr int W_FP8_SCALE_E8M0 = 0x77777777;
constexpr float MIX_SCALE = 16.0f;
constexpr int MIXP = 2560;
constexpr float Y_FP8_SCALE = 16.0f;
template <int CTRL> __device__ __forceinline__ float dppf(float v) { return __builtin_bit_cast(float, __builtin_amdgcn_update_dpp(0, __builtin_bit_cast(int, v), CTRL, 0xF, 0xF, true)); }
template <int CTRL> __device__ __forceinline__ unsigned dppu(unsigned v) { return (unsigned)__builtin_amdgcn_update_dpp(0, (int)v, CTRL, 0xF, 0xF, true); }
__device__ __forceinline__ float rdlane(float v, int l) { return __builtin_bit_cast(float, __builtin_amdgcn_readlane(__builtin_bit_cast(int, v), l)); }
__device__ __forceinline__ float wave_sum(float v) {
    v += dppf<0xB1>(v); v += dppf<0x4E>(v); v += dppf<0x141>(v); v += dppf<0x140>(v);
    return (rdlane(v, 0) + rdlane(v, 16)) + (rdlane(v, 32) + rdlane(v, 48)); }
__device__ __forceinline__ unsigned wave_umax(unsigned v) {
    unsigned t;
    t = dppu<0xB1>(v); v = v > t ? v : t; t = dppu<0x4E>(v); v = v > t ? v : t; t = dppu<0x141>(v); v = v > t ? v : t; t = dppu<0x140>(v); v = v > t ? v : t;
    const unsigned a = (unsigned)__builtin_amdgcn_readlane((int)v, 0), b = (unsigned)__builtin_amdgcn_readlane((int)v, 16), c = (unsigned)__builtin_amdgcn_readlane((int)v, 32), d = (unsigned)__builtin_amdgcn_readlane((int)v, 48);
    const unsigned m0 = a > b ? a : b, m1 = c > d ? c : d; return m0 > m1 ? m0 : m1; }
__device__ __forceinline__ unsigned wave_umax63(unsigned v) {
    unsigned t;
    t = dppu<0xB1>(v); v = v > t ? v : t; t = dppu<0x4E>(v); v = v > t ? v : t; t = dppu<0x141>(v); v = v > t ? v : t; t = dppu<0x140>(v); v = v > t ? v : t;
    t = (unsigned)__builtin_amdgcn_update_dpp(0, (int)v, 0x142, 0xA, 0xF, false); v = v > t ? v : t;
    t = (unsigned)__builtin_amdgcn_update_dpp(0, (int)v, 0x143, 0xC, 0xF, false); v = v > t ? v : t;
    return (unsigned)__builtin_amdgcn_readlane((int)v, 63); }
__device__ __forceinline__ float gelu_tanh(float x) {
    const float u = 1.5957691216057308f * (x + 0.044715f * x * x * x);
    return x / (1.0f + __expf(-u)); }
__device__ __forceinline__ float sigmoidf_(float x) { return 1.0f / (1.0f + __expf(-x)); }
#define XB_TMO      128
#define XB_XCNT(j)  (256  + 64 * (j))
#define XB_XSUB(j)  (1280 + 64 * (j))
#define XB_XGEN(j)  (2304 + 64 * (j))
#define XB_TOP      3328
#define XB_TOPGEN   3392
#define XCD_BAR_WORDS 3456
#define XB_SPIN_CAP (1u << 22)

__device__ __forceinline__ unsigned xb_ld(unsigned* p)              { return __hip_atomic_load(p, __ATOMIC_RELAXED, __HIP_MEMORY_SCOPE_AGENT); }
__device__ __forceinline__ unsigned xb_add(unsigned* p, unsigned v) { return __hip_atomic_fetch_add(p, v, __ATOMIC_RELAXED, __HIP_MEMORY_SCOPE_AGENT); }
__device__ __forceinline__ unsigned xb_xcc_id() { return (unsigned)__builtin_amdgcn_s_getreg((3 << 11) | 20) & 0xFu; }
#define XB_SPIN(cond, bar) do { unsigned _sp = 0; while (cond) { __builtin_amdgcn_s_sleep(1); \
    if ((++_sp & 255u) == 0u) { if (xb_ld(&(bar)[XB_TMO])) break; if (_sp > XB_SPIN_CAP) { atomicAdd(&(bar)[XB_TMO], 1u); break; } } } } while (0)

struct XcdBarrier {
    unsigned* bar; unsigned x;
    volatile LAS unsigned* st;
};
__device__ __forceinline__ XcdBarrier xcd_barrier_post(unsigned* bar, volatile LAS unsigned* st) {
    XcdBarrier b; b.bar = bar; b.x = xb_xcc_id(); b.st = st;
    if (threadIdx.x == 0) (void)xb_add(&bar[XB_XCNT(b.x)], 1u);
    return b;
}
__device__ __forceinline__ void xcd_barrier_complete(unsigned* bar, unsigned x, unsigned& nloc, unsigned& nx) {
    const unsigned G = gridDim.x * gridDim.y * gridDim.z;
    unsigned sum, cnt, mine, sp = 0u;
    for (;;) {
        sum = 0u; cnt = 0u; mine = 0u;
#pragma unroll
        for (unsigned j = 0; j < 16; ++j) { const unsigned c = xb_ld(&bar[XB_XCNT(j)]); sum += c; cnt += (c > 0u) ? 1u : 0u; mine = (j == x) ? c : mine; }
        if (sum == G) break;
        __builtin_amdgcn_s_sleep(1);
        if ((++sp & 255u) == 0u) { if (xb_ld(&bar[XB_TMO])) break; if (sp > XB_SPIN_CAP) { atomicAdd(&bar[XB_TMO], 1u); break; } }
    }
    nloc = mine > 0u ? mine : 1u; nx = cnt > 0u ? cnt : 1u;
}
__device__ __forceinline__ void xcd_barrier(const XcdBarrier& b) {
    asm volatile("s_waitcnt vmcnt(0)" ::: "memory");
    __syncthreads();
    if (threadIdx.x == 0) {
        unsigned* bar = b.bar;
        __builtin_amdgcn_s_waitcnt(0);
        unsigned nloc = b.st[0], nx = b.st[1];
        if (nloc == 0u) { xcd_barrier_complete(bar, b.x, nloc, nx); b.st[0] = nloc; b.st[1] = nx; }
        const unsigned old = xb_add(&bar[XB_XSUB(b.x)], 1u);
        const unsigned gen = old / nloc;
        if (old + 1u == (gen + 1u) * nloc) {
            __builtin_amdgcn_fence(__ATOMIC_RELEASE, "agent");
            asm volatile("s_waitcnt vmcnt(0)" ::: "memory");
            const unsigned og = xb_add(&bar[XB_TOP], 1u);
            const unsigned tg = og / nx;
            if (og + 1u == (tg + 1u) * nx) xb_add(&bar[XB_TOPGEN], 1u);
            else XB_SPIN(xb_ld(&bar[XB_TOPGEN]) == tg, bar);
            __builtin_amdgcn_fence(__ATOMIC_ACQUIRE, "agent");
            xb_add(&bar[XB_XGEN(b.x)], 1u);
            asm volatile("s_waitcnt vmcnt(0)" ::: "memory");
        } else {
            XB_SPIN(xb_ld(&bar[XB_XGEN(b.x)]) == gen, bar);
            __builtin_amdgcn_fence(__ATOMIC_ACQUIRE, "agent");
            asm volatile("s_waitcnt vmcnt(0)" ::: "memory");
        }
    }
    __syncthreads();
}

struct Args;
__device__ __forceinline__ const float* args_in(const Args* ka, int k);
namespace pg8 {
constexpr int BM = 256, BK = 64, HALF = 128, HTB = HALF * BK * 2  , STAGE_BYTES = 8 * HTB, NXCD = 8, WGM = 8;
__host__ __device__ __forceinline__ int lds_byte(int r, int c) { const int st = (r >> 4) * 2 + (c >> 5), rr = r & 15, cc = c & 31, ob = rr * 64 + cc * 2; return st * 1024 + (ob ^ (((ob >> 9) & 1) << 5)); }
__host__ __device__ __forceinline__ void stage_rc(int b, int& R, int& C) { const int st = b / 1024, sb = b % 1024, swz = sb ^ (((sb >> 9) & 1) << 5); R = (st >> 1) * 16 + swz / 64; C = (st & 1) * 32 + (swz % 64) / 2; }
__host__ __device__ __forceinline__ int perm32(int rho) { const int n = rho >> 4, i = rho & 15; return 8 * (i >> 2) + 4 * n + (i & 3); }

struct Unit { int pm, pn, pb, e, cnt, pos0; };
struct Gemm { const bf16_t* A; const bf16_t* Bt; int M, N, K; };

struct StaticOrder {
    int nM, nN, nwg, G, c;
    __host__ __device__ void init(int M, int N, int G_, int c_) { nM = M / BM; nN = N / BM; nwg = nM * nN; G = G_; c = c_; }
    __host__ __device__ bool map(int i, int& pm, int& pn) const {
        const int L = i * G + c; if (L >= nwg || c < 0) return false;
        int wgid = L; { const int q = nwg / NXCD, r = nwg % NXCD, xcd = wgid % NXCD, off = wgid / NXCD; wgid = (xcd < r ? xcd * (q + 1) : r * (q + 1) + (xcd - r) * q) + off; }
        const int nig = WGM * nN, gid = wgid / nig, fm = gid * WGM, gsz = (nM - fm) < WGM ? (nM - fm) : WGM;
        pm = fm + ((wgid % nig) % gsz); pn = (wgid % nig) / gsz; return true;
    }
    __device__ __forceinline__ bool next(int i, Unit& u) const { if (!map(i, u.pm, u.pn)) return false; u.pb = u.pn; u.e = 0; u.cnt = 0; u.pos0 = 0; return true; }
    __device__ __forceinline__ int arow(const Unit&, int) const { return 0; }
    __device__ __forceinline__ void tables(LAS unsigned char*, LAS unsigned char*, const Unit&, int, int) const {}
    __device__ __forceinline__ void a_ready(const Unit&) const {}
    __device__ __forceinline__ void done(const Unit&) const {}
};
struct MoeOrder : StaticOrder {
    const LAS int* tb; const unsigned char* ws;
    const LAS int* ul;
    __device__ void init_moe(int nN_, int G_, int c_, const LAS int* tb_, const unsigned char* ws_, LAS int* ul_) { tb = tb_; ws = ws_; ul = ul_; nM = __builtin_amdgcn_readfirstlane(tb_[32]); nN = nN_; nwg = nM * nN; G = G_; c = c_;
        const int k = threadIdx.x;
        if (k < 128) { int pm = -1, pn = 0, e = 0, cnt = 0, pos0 = 0;
            if (map(k, pm, pn)) {
#pragma unroll
                for (int s = 16; s >= 1; s >>= 1) if (tb[e + s] <= pm) e += s;
                cnt = tb[33 + e]; pos0 = (pm - tb[e]) * BM; } else pm = -1;
            ul_[k * 8 + 0] = pm; ul_[k * 8 + 1] = pn; ul_[k * 8 + 2] = e; ul_[k * 8 + 3] = cnt; ul_[k * 8 + 4] = pos0; ul_[k * 8 + 5] = e * nN_ + pn; }
        __syncthreads(); }
    __device__ __forceinline__ bool next(int i, Unit& u) const {
        if (i >= 128) return false;
        const i32x4 a = *(const LAS i32x4*)(ul + i * 8); const int p0 = ul[i * 8 + 4], pb = ul[i * 8 + 5];
        u.pm = __builtin_amdgcn_readfirstlane(a[0]); if (u.pm < 0) return false;
        u.pn = __builtin_amdgcn_readfirstlane(a[1]); u.e = __builtin_amdgcn_readfirstlane(a[2]); u.cnt = __builtin_amdgcn_readfirstlane(a[3]); u.pos0 = __builtin_amdgcn_readfirstlane(p0); u.pb = __builtin_amdgcn_readfirstlane(pb); return true;
    }
    __device__ __forceinline__ void tables(LAS unsigned char* tbl, LAS unsigned char* b2l, const Unit& u, int wid, int lane) const {
        if (wid < 4) { int pos = u.pos0 + 64 * wid + lane; pos = pos < u.cnt ? pos : u.cnt - 1; const int vo = (u.e * LIST_CAP + pos) * 4;
            const __amdgpu_buffer_rsrc_t rl = __builtin_amdgcn_make_buffer_rsrc((void*)(ws + WS_LIST), 0, 0xFFFFFFF0u, 0x00020000);
            __builtin_amdgcn_raw_ptr_buffer_load_lds(rl, (LAS void*)(tbl + wid * 256), 4, vo, 0, 0, 0);
            if (nN == 8) { const __amdgpu_buffer_rsrc_t rg = __builtin_amdgcn_make_buffer_rsrc((void*)(ws + WS_LGATE), 0, 0xFFFFFFF0u, 0x00020000);
                __builtin_amdgcn_raw_ptr_buffer_load_lds(rg, (LAS void*)(tbl + 1024 + wid * 256), 4, vo, 0, 0, 0); }
        } else if (nN == 8) {
            const __amdgpu_buffer_rsrc_t rb = __builtin_amdgcn_make_buffer_rsrc((void*)(ws + WS_B2C), 0, 0xFFFFFFF0u, 0x00020000);
            __builtin_amdgcn_raw_ptr_buffer_load_lds(rb, (LAS void*)(b2l + (wid - 4) * 256), 4, (u.e * D_ + u.pn * BM + 64 * (wid - 4) + lane) * 4, 0, 0, 0);
        } else if (wid < 6) { const __amdgpu_buffer_rsrc_t rb = __builtin_amdgcn_make_buffer_rsrc((void*)(ws + (wid == 4 ? WS_B1G : WS_B1L)), 0, 0xFFFFFFF0u, 0x00020000);
            const int vo = (u.e * FF + u.pn * HALF + lane) * 4;
            __builtin_amdgcn_raw_ptr_buffer_load_lds(rb, (LAS void*)(tbl + 1024 + (wid - 4) * 512), 4, vo, 0, 0, 0);
            __builtin_amdgcn_raw_ptr_buffer_load_lds(rb, (LAS void*)(tbl + 1024 + (wid - 4) * 512 + 256), 4, vo + 256, 0, 0, 0); }
    }
    __device__ __forceinline__ int arow(const Unit& u, int r) const { int pos = u.pos0 + r; pos = pos < u.cnt ? pos : u.cnt - 1; return ((const int*)(ws + WS_LIST))[(size_t)u.e * LIST_CAP + pos] >> 2; }
};

struct EpiBf16 {
    static constexpr bool PERM = true;
    bf16_t* O; int ldc; int colo; float scale;
    __device__ __forceinline__ void operator()(const f32x4 (&acc)[2][2][4][2], const Unit& u, int wr, int wc, int fr, int fq, LAS const unsigned char* tbl, LAS const unsigned char* b2l) const {
        { int t_ = threadIdx.x; asm volatile("" : "+v"(t_)); fr = t_ & 15; fq = (t_ >> 4) & 3; }
        const int row0 = u.pm * BM + wr * 64 + fr; const int col0 = colo + u.pn * BM + wc * 32 + 8 * fq;
#pragma unroll
        for (int ai = 0; ai < 2; ++ai)
#pragma unroll
            for (int m = 0; m < 4; ++m) { bf16_t* rowp = O + (size_t)(row0 + ai * HALF + m * 16) * ldc + col0;
#pragma unroll
                for (int bj = 0; bj < 2; ++bj) { const f32x4 v0 = acc[ai][bj][m][0] * scale, v1 = acc[ai][bj][m][1] * scale;
                    u32x4 w; w.x = cvt_pk_bf16(v0[0], v0[1]); w.y = cvt_pk_bf16(v0[2], v0[3]); w.z = cvt_pk_bf16(v1[0], v1[1]); w.w = cvt_pk_bf16(v1[2], v1[3]);
                    *(u32x4*)(rowp + bj * HALF) = w; } }
    }
};
struct EpiResF32 {
    static constexpr bool PERM = true;
    const Args* ka; unsigned char* ws; int ldc; size_t rowss_off; float scale;
    __device__ __forceinline__ void operator()(const f32x4 (&acc)[2][2][4][2], const Unit& u, int wr, int wc, int fr, int fq, LAS const unsigned char* tbl, LAS const unsigned char* b2l) const {
        const int row0 = u.pm * BM + wr * 64 + fr, col0 = u.pn * BM + wc * 32 + 8 * fq;
        const float* __restrict__ rp = args_in(ka, 0); _Float16* __restrict__ cp = (_Float16*)(ws + WS_X1H); float* rowss = (float*)(ws + rowss_off);
#pragma unroll
        for (int ai = 0; ai < 2; ++ai)
#pragma unroll
            for (int mp = 0; mp < 2; ++mp) { f32x4 r[2][2][2];
#pragma unroll
                for (int mm = 0; mm < 2; ++mm) { const size_t off = (size_t)(row0 + ai * HALF + (2 * mp + mm) * 16) * ldc + col0;
#pragma unroll
                    for (int bj = 0; bj < 2; ++bj)
#pragma unroll
                        for (int n = 0; n < 2; ++n) r[mm][bj][n] = *(const f32x4*)(rp + off + bj * HALF + n * 4); }
#pragma unroll
                for (int mm = 0; mm < 2; ++mm) { const int m = 2 * mp + mm; const int row = row0 + ai * HALF + m * 16; const size_t off = (size_t)row * ldc + col0; float ss = 0.f;
#pragma unroll
                    for (int bj = 0; bj < 2; ++bj) { const f32x4 o0 = r[mm][bj][0] + acc[ai][bj][m][0] * scale, o1 = r[mm][bj][1] + acc[ai][bj][m][1] * scale;
                        ss += ((o0[0] * o0[0] + o0[1] * o0[1]) + (o0[2] * o0[2] + o0[3] * o0[3])) + ((o1[0] * o1[0] + o1[1] * o1[1]) + (o1[2] * o1[2] + o1[3] * o1[3]));
                        f16x8 h;
#pragma unroll
                        for (int j = 0; j < 4; ++j) { h[j] = (_Float16)__builtin_amdgcn_fmed3f(o0[j], -65504.0f, 65504.0f); h[4 + j] = (_Float16)__builtin_amdgcn_fmed3f(o1[j], -65504.0f, 65504.0f); }
                        *(f16x8*)(cp + off + bj * HALF) = h; }
                    ss += __shfl_xor(ss, 16); ss += __shfl_xor(ss, 32);
                    if (fq == 0) rowss[(size_t)row * 32 + u.pn * 4 + wc] = ss; } }
    }
};
struct EpiGlu {
    static constexpr bool PERM = true;
    unsigned char* ws;
    __device__ __forceinline__ void operator()(const f32x4 (&acc)[2][2][4][2], const Unit& u, int wr, int wc, int fr, int fq, LAS const unsigned char* tbl, LAS const unsigned char* b2l) const {
        { int t_ = threadIdx.x; asm volatile("" : "+v"(t_)); fr = t_ & 15; fq = (t_ >> 4) & 3; }
        const int row0 = u.pm * BM + wr * 64 + fr; const int cl = wc * 32 + 8 * fq; const int col0 = u.pn * HALF + cl;
        unsigned char* act = ws + WS_ACT;
        typedef float f32x2_ __attribute__((ext_vector_type(2)));
        f32x4 gb[2], lb[2]; gb[0] = *(LAS const f32x4*)(tbl + 1024 + cl * 4); gb[1] = *(LAS const f32x4*)(tbl + 1024 + cl * 4 + 16); lb[0] = *(LAS const f32x4*)(tbl + 1536 + cl * 4) + 1.0f; lb[1] = *(LAS const f32x4*)(tbl + 1536 + cl * 4 + 16) + 1.0f;
        const f32x2_ sc2 = {1.0f / W_FP8_SCALE, 1.0f / W_FP8_SCALE}, ce2 = {-1.702f * 1.4426950409f, -1.702f * 1.4426950409f}, one2 = {1.0f, 1.0f};
#pragma unroll
        for (int ai = 0; ai < 2; ++ai)
#pragma unroll
            for (int m = 0; m < 4; ++m) { unsigned char* rowp = act + (size_t)(row0 + ai * HALF + m * 16) * FF + col0; f32x2_ o[4];
#pragma unroll
                for (int n = 0; n < 2; ++n)
#pragma unroll
                    for (int h = 0; h < 2; ++h) { const f32x4 ag = acc[ai][0][m][n], al = acc[ai][1][m][n];
                        const f32x2_ a2 = {ag[2 * h], ag[2 * h + 1]}, b2 = {al[2 * h], al[2 * h + 1]}, g2 = {gb[n][2 * h], gb[n][2 * h + 1]}, l2 = {lb[n][2 * h], lb[n][2 * h + 1]};
                        f32x2_ gv = __builtin_elementwise_fma(a2, sc2, g2), lv = __builtin_elementwise_fma(b2, sc2, l2);
                        gv[0] = fminf(gv[0], 7.0f); gv[1] = fminf(gv[1], 7.0f); lv[0] = __builtin_amdgcn_fmed3f(lv[0], -6.0f, 8.0f); lv[1] = __builtin_amdgcn_fmed3f(lv[1], -6.0f, 8.0f);
                        f32x2_ e = gv * ce2; e[0] = __builtin_amdgcn_exp2f(e[0]); e[1] = __builtin_amdgcn_exp2f(e[1]); e = e + one2; e[0] = __builtin_amdgcn_rcpf(e[0]); e[1] = __builtin_amdgcn_rcpf(e[1]);
                        o[n * 2 + h] = (gv * e) * lv; }
                u32x2 w; int p0 = __builtin_amdgcn_cvt_pk_fp8_f32(o[0][0], o[0][1], 0, false); p0 = __builtin_amdgcn_cvt_pk_fp8_f32(o[1][0], o[1][1], p0, true);
                int p1 = __builtin_amdgcn_cvt_pk_fp8_f32(o[2][0], o[2][1], 0, false); p1 = __builtin_amdgcn_cvt_pk_fp8_f32(o[3][0], o[3][1], p1, true); w.x = (unsigned)p0; w.y = (unsigned)p1;
                *(u32x2*)rowp = w; }
    }
};
struct EpiScatter {
    static constexpr bool PERM = true;
    unsigned char* ws; const Args* ka;
    __device__ __forceinline__ void operator()(const f32x4 (&acc)[2][2][4][2], const Unit& u, int wr, int wc, int fr, int fq, LAS const unsigned char* tbl, LAS const unsigned char* b2l) const {
        { int t_ = threadIdx.x; asm volatile("" : "+v"(t_)); fr = t_ & 15; fq = (t_ >> 4) & 3; }
        const int r0 = wr * 64 + fr; const int col0 = u.pn * BM + wc * 32 + 8 * fq;
        unsigned char* Y = ws + WS_Y;
        f32x4 bv[2][2];
#pragma unroll
        for (int bj = 0; bj < 2; ++bj)
#pragma unroll
            for (int n = 0; n < 2; ++n) bv[bj][n] = *(LAS const f32x4*)(b2l + (wc * 32 + 8 * fq + bj * HALF + 4 * n) * 4);
#pragma unroll
        for (int ai = 0; ai < 2; ++ai)
#pragma unroll
            for (int m = 0; m < 4; ++m) { const int row = r0 + ai * HALF + m * 16;
                if (u.pos0 + row < u.cnt) { const int pid = *(LAS const int*)(tbl + row * 4); const float gt = *(LAS const float*)(tbl + 1024 + row * 4) * Y_FP8_SCALE; unsigned char* rowp = Y + (size_t)pid * D_ + col0;
#pragma unroll
                    for (int bj = 0; bj < 2; ++bj) { const f32x4 v0 = (acc[ai][bj][m][0] * (1.0f / W_FP8_SCALE) + bv[bj][0]) * gt, v1 = (acc[ai][bj][m][1] * (1.0f / W_FP8_SCALE) + bv[bj][1]) * gt;
                        u32x2 w; w.x = pk4_fp8(v0[0], v0[1], v0[2], v0[3]); w.y = pk4_fp8(v1[0], v1[1], v1[2], v1[3]);
                        *(u32x2*)(rowp + bj * HALF) = w; } } }
    }
};

template <class Epi, class Sched, bool GATHER, int FP8 = 0  >
__device__ __forceinline__ void gemm_phase(LAS unsigned char* lds, const Gemm g, const Sched& S, const Epi& E) {
    int tid_ = threadIdx.x; asm volatile("" : "+v"(tid_));
    const int tid = tid_, wid = __builtin_amdgcn_readfirstlane(tid >> 6), lane = tid & 63, wr = wid >> 2, wc = wid & 3, fr = lane & 15, fq = lane >> 4;
    const int K = g.K, nt = K / BK;
    const __amdgpu_buffer_rsrc_t rsA = __builtin_amdgcn_make_buffer_rsrc((void*)g.A, 0, 0xFFFFFFF0u, 0x00020000);
    const __amdgpu_buffer_rsrc_t rsB = __builtin_amdgcn_make_buffer_rsrc((void*)g.Bt, 0, 0xFFFFFFF0u, 0x00020000);
    unsigned voffB[2];
#pragma unroll
    for (int i = 0; i < 2; ++i) { int R, C; stage_rc(tid * 16 + i * 8192, R, C); const int Rb = Epi::PERM ? ((R & ~31) + perm32(R & 31)) : R; voffB[i] = (unsigned)(Rb * K + C) * 2u; }
    const unsigned kstep = (unsigned)(BK * 2);
    const unsigned hstep = (unsigned)HALF * (unsigned)K * 2u;
    const unsigned tstep = 2u * hstep;
    const unsigned ldsw = (unsigned)wid * 1024u;
    const int aoff = lds_byte(wr * 64 + fr, fq * 8), boff = lds_byte(wc * 32 + fr, fq * 8);
#define PG8_SA(b, h) (((b) * 2 + (h)) * HTB)
#define PG8_SB(b, h) ((4 + (b) * 2 + (h)) * HTB)
#define PG8_STAGE(bufoff, rs, soff, voff) do { _Pragma("unroll") for (int _i = 0; _i < 2; ++_i) \
        __builtin_amdgcn_raw_ptr_buffer_load_lds(rs, (LAS void*)(lds + (bufoff) + ldsw + _i * 8192), 16, (int)(voff)[_i], (int)(soff), 0, 0); } while (0)
#define PG8_STAGE2(bufoff, rs, soff, o0, o1) do { \
        __builtin_amdgcn_raw_ptr_buffer_load_lds(rs, (LAS void*)(lds + (bufoff) + ldsw), 16, (int)(o0), (int)(soff), 0, 0); \
        __builtin_amdgcn_raw_ptr_buffer_load_lds(rs, (LAS void*)(lds + (bufoff) + ldsw + 8192), 16, (int)(o1), (int)(soff), 0, 0); } while (0)
#define PG8_LDA(dst, b, h) do { _Pragma("unroll") for (int m = 0; m < 4; ++m) _Pragma("unroll") for (int k = 0; k < 2; ++k) dst[m][k] = *(const LAS bf16x8*)(lds + PG8_SA(b, h) + aoff + m * 2048 + k * 1024); } while (0)
#define PG8_LDB(dst, b, h) do { _Pragma("unroll") for (int n = 0; n < 2; ++n) _Pragma("unroll") for (int k = 0; k < 2; ++k) dst[n][k] = *(const LAS bf16x8*)(lds + PG8_SB(b, h) + boff + n * 2048 + k * 1024); } while (0)
#define PG8_MMA(ai, bj, At, Bt) do { __builtin_amdgcn_s_setprio(1); _Pragma("unroll") for (int m = 0; m < 4; ++m) _Pragma("unroll") for (int n = 0; n < 2; ++n) { \
        if (f8now) { const i32x8 _b = __builtin_shufflevector(__builtin_bit_cast(i32x4, Bt[n][0]), __builtin_bit_cast(i32x4, Bt[n][1]), 0, 1, 2, 3, 4, 5, 6, 7); \
                   const i32x8 _a = __builtin_shufflevector(__builtin_bit_cast(i32x4, At[m][0]), __builtin_bit_cast(i32x4, At[m][1]), 0, 1, 2, 3, 4, 5, 6, 7); \
                   acc[ai][bj][m][n] = __builtin_amdgcn_mfma_scale_f32_16x16x128_f8f6f4(_b, _a, acc[ai][bj][m][n], 0, 0, 0, 0, 0, 0); } \
        else { _Pragma("unroll") for (int k = 0; k < 2; ++k) acc[ai][bj][m][n] = __builtin_amdgcn_mfma_f32_16x16x32_bf16(Bt[n][k], At[m][k], acc[ai][bj][m][n], 0, 0, 0); } } \
        __builtin_amdgcn_s_setprio(0); } while (0)
#define PG8_H1(p) (GATHER ? (p) : (p) + hstep)
#define PG8_CV1(i) (GATHER ? cv[1][i] : cv[0][i])
#define PG8_WAIT_V(n) asm volatile("s_waitcnt vmcnt(" #n ")" ::: "memory")
#define PG8_WAIT_L(n) asm volatile("s_waitcnt lgkmcnt(" #n ")" ::: "memory")
#define PG8_BAR __builtin_amdgcn_s_barrier()
#define PG8_SCHED __builtin_amdgcn_sched_barrier(0)
#define PG8_AOFF(dst, un) do { _Pragma("unroll") for (int _i = 0; _i < 2; ++_i) { int _R, _C; stage_rc(tid * 16 + _i * 8192, _R, _C); _Pragma("unroll") for (int _h = 0; _h < 2; ++_h) \
        dst[_h][_i] = GATHER ? (unsigned)S.arow(un, _h * HALF + _R) * (unsigned)(K * 2) + (unsigned)(_C * 2) : (unsigned)((_h * HALF + _R) * K + _C) * 2u; } } while (0)
    Unit cur, nxt; int ui = 0;
    if (!S.next(0, cur)) return;
    f32x4 acc[2][2][4][2];
#pragma unroll
    for (int a = 0; a < 2; ++a)
#pragma unroll
        for (int b = 0; b < 2; ++b)
#pragma unroll
            for (int m = 0; m < 4; ++m)
#pragma unroll
                for (int n = 0; n < 2; ++n) acc[a][b][m][n] = (f32x4){0.f, 0.f, 0.f, 0.f};
    bf16x8 At[4][2], B0[2][2], B1[2][2];
    unsigned cv[2][2];
    PG8_AOFF(cv, cur);
    unsigned cA = GATHER ? 0u : (unsigned)cur.pm * tstep, cB = (unsigned)cur.pb * tstep;
    S.a_ready(cur);
    int tbi = 0;
#define PG8_B2L(tb_) ((tb_) < 2 ? STAGE_BYTES + 6144 + (tb_) * 1024 : LDS_MISC + 6144)
    S.tables(lds + STAGE_BYTES, lds + PG8_B2L(0), cur, wid, lane);
    PG8_STAGE(PG8_SB(0, 0), rsB, cB, voffB); PG8_STAGE2(PG8_SA(0, 0), rsA, cA, cv[0][0], cv[0][1]); PG8_STAGE(PG8_SB(0, 1), rsB, cB + hstep, voffB); PG8_STAGE2(PG8_SA(0, 1), rsA, PG8_H1(cA), PG8_CV1(0), PG8_CV1(1));
    if (wr == 1) PG8_BAR;
    PG8_WAIT_V(4); PG8_BAR;
    PG8_STAGE(PG8_SB(1, 0), rsB, cB + kstep, voffB); PG8_STAGE2(PG8_SA(1, 0), rsA, cA + kstep, cv[0][0], cv[0][1]); PG8_STAGE(PG8_SB(1, 1), rsB, cB + hstep + kstep, voffB);
    PG8_WAIT_V(6); PG8_BAR;
    for (;;) {
        const bool has_next = S.next(ui + 1, nxt);
        const unsigned nA = has_next ? (GATHER ? 0u : (unsigned)nxt.pm * tstep) : cA, nB = has_next ? (unsigned)nxt.pb * tstep : cB;
        const int tbn = tbi == 2 ? 0 : tbi + 1;
        if (has_next) S.tables(lds + STAGE_BYTES + tbn * 2048, lds + PG8_B2L(tbn), nxt, wid, lane);
#define PG8_ITER(F8_) do { \
            const bool last = (t == nt - 2); const bool f8now = (F8_); (void)f8now; \
            const unsigned a1 = cA + (unsigned)(t + 1) * kstep; \
            const unsigned a2 = last ? nA : cA + (unsigned)(t + 2) * kstep, b2 = last ? nB : cB + (unsigned)(t + 2) * kstep; \
            const unsigned a3 = a2 + kstep, b3 = b2 + kstep; \
            if (last && has_next) S.a_ready(nxt); \
            PG8_LDB(B0, 0, 0); PG8_SCHED; PG8_LDA(At, 0, 0); PG8_STAGE2(PG8_SA(1, 1), rsA, PG8_H1(a1), PG8_CV1(0), PG8_CV1(1)); \
            PG8_WAIT_L(8); PG8_BAR; PG8_WAIT_L(0); PG8_MMA(0, 0, At, B0); PG8_BAR; PG8_SCHED; \
            PG8_LDB(B1, 0, 1); PG8_STAGE(PG8_SB(0, 0), rsB, b2, voffB); \
            PG8_BAR; PG8_WAIT_L(0); PG8_MMA(0, 1, At, B1); PG8_BAR; \
            if (GATHER && last && has_next) { const LAS int* _tb = (const LAS int*)(lds + STAGE_BYTES + tbn * 2048); \
                _Pragma("unroll") for (int _i = 0; _i < 2; ++_i) { int _R, _C; stage_rc(tid * 16 + _i * 8192, _R, _C); _Pragma("unroll") for (int _h = 0; _h < 2; ++_h) cv[_h][_i] = (unsigned)(_tb[_h * HALF + _R] >> 2) * (unsigned)(K * 2) + (unsigned)(_C * 2); } \
                PG8_WAIT_L(0); } \
            PG8_LDA(At, 0, 1); PG8_STAGE2(PG8_SA(0, 0), rsA, a2, cv[0][0], cv[0][1]); \
            PG8_BAR; PG8_WAIT_L(0); PG8_MMA(1, 0, At, B0); PG8_BAR; PG8_SCHED; \
            PG8_STAGE(PG8_SB(0, 1), rsB, b2 + hstep, voffB); \
            PG8_WAIT_V(6); PG8_BAR; PG8_MMA(1, 1, At, B1); PG8_BAR; \
            PG8_LDB(B0, 1, 0); PG8_SCHED; PG8_LDA(At, 1, 0); PG8_STAGE2(PG8_SA(0, 1), rsA, PG8_H1(a2), PG8_CV1(0), PG8_CV1(1)); \
            PG8_WAIT_L(8); PG8_BAR; PG8_WAIT_L(0); PG8_MMA(0, 0, At, B0); PG8_BAR; PG8_SCHED; \
            PG8_LDB(B1, 1, 1); PG8_STAGE(PG8_SB(1, 0), rsB, b3, voffB); \
            PG8_BAR; PG8_WAIT_L(0); PG8_MMA(0, 1, At, B1); PG8_BAR; \
            PG8_LDA(At, 1, 1); PG8_STAGE2(PG8_SA(1, 0), rsA, a3, cv[0][0], cv[0][1]); \
            PG8_BAR; PG8_WAIT_L(0); PG8_MMA(1, 0, At, B0); PG8_BAR; PG8_SCHED; \
            PG8_STAGE(PG8_SB(1, 1), rsB, b3 + hstep, voffB); \
            PG8_WAIT_V(6); PG8_BAR; PG8_MMA(1, 1, At, B1); PG8_BAR; \
        } while (0)
        if (FP8 == 2) { for (int t = 0; t < 8; t += 2) PG8_ITER(false); for (int t = 8; t < nt; t += 2) PG8_ITER(true); }
        else { for (int t = 0; t < nt; t += 2) PG8_ITER(FP8 == 1); }
#undef PG8_ITER
        E(acc, cur, wr, wc, fr, fq, lds + STAGE_BYTES + tbi * 2048, lds + PG8_B2L(tbi)); S.done(cur);
#ifdef MK_EPI2
        if (FP8 == 1) { asm volatile("" ::: "memory"); E(acc, cur, wr, wc, fr, fq, lds + STAGE_BYTES + tbi * 2048, lds + PG8_B2L(tbi)); }
#endif
        if (!has_next) break;
#pragma unroll
        for (int a = 0; a < 2; ++a)
#pragma unroll
            for (int b = 0; b < 2; ++b)
#pragma unroll
                for (int m = 0; m < 4; ++m)
#pragma unroll
                    for (int n = 0; n < 2; ++n) acc[a][b][m][n] = (f32x4){0.f, 0.f, 0.f, 0.f};
        cur = nxt; cA = nA; cB = nB; ++ui; tbi = tbn;
    }
    PG8_WAIT_V(0);
    if (wr == 0) PG8_BAR;
    PG8_BAR;
#undef PG8_SA
#undef PG8_SB
#undef PG8_STAGE
#undef PG8_STAGE2
#undef PG8_LDA
#undef PG8_LDB
#undef PG8_MMA
#undef PG8_WAIT_V
#undef PG8_WAIT_L
#undef PG8_BAR
#undef PG8_SCHED
#undef PG8_AOFF
#undef PG8_B2L
#undef PG8_H1
#undef PG8_CV1
}
}
struct Args { const float* in[27]; float* out; unsigned char* ws; int ph_lo, ph_hi; };
__device__ __forceinline__ const float* args_in(const Args* ka, int k) { return ka->in[k]; }
struct Ctx {
    const Args* ka;
    float* out; unsigned char* ws;
    LAS unsigned char* lds; int tid, lane, wave, G, bid;
};
#define WSP(type, off) ((type*)(C.ws + (off)))
enum { I_X = 0, I_MEM, I_POS, I_MIXG, I_MEMG, I_WIN, I_WOUT, I_GWS, I_GBS, I_GVG, I_CPOS, I_CK1, I_CK2, I_CV1, I_CV2, I_NQG, I_NKG, I_WKV, I_XQG, I_XKG, I_FFG, I_WR, I_BR, I_WE1, I_BE1, I_WE2, I_BE2 };

struct TReg { f32x4 v[4]; };
__device__ __forceinline__ int tt_idx(int k, int n) { return k * 65 + 8 * (k >> 5) + n; }
constexpr int TT_TILE_BYTES = (128 * 65 + 32) * 4;
__device__ __forceinline__ void tt_load(TReg& R, const float* src, int N, int ld, int k0, int n0, int tid) {
    const int kr = tid >> 4, nc = (tid & 15) * 4;
#pragma unroll
    for (int rep = 0; rep < 4; ++rep) { R.v[rep] = (f32x4){0.f, 0.f, 0.f, 0.f}; if (n0 + nc < N) R.v[rep] = *(const f32x4*)(src + (size_t)(k0 + kr + 32 * rep) * ld + n0 + nc); } }
__device__ __forceinline__ void tt_put(const TReg& R, LAS float* tile, int tid) {
    const int kr = tid >> 4, nc = (tid & 15) * 4;
#pragma unroll
    for (int rep = 0; rep < 4; ++rep) { LAS float* p = tile + tt_idx(kr + 32 * rep, nc); p[0] = R.v[rep][0]; p[1] = R.v[rep][1]; p[2] = R.v[rep][2]; p[3] = R.v[rep][3]; } }
__device__ __forceinline__ void tt_finish(LAS const float* tile, bf16_t* dst, int ldd, int k0, int n0, int N, int map, bool fp8, int tid) {
    const int n = tid >> 3; const int ns = n0 + n;
    if (ns < N) { int r = ns;
        if (map == 1) r = ns < 3584 ? ns : (ns < 3608 ? C_GATE + (ns - 3584) : C_QX + (ns - 3608));
        else if (map == 2) { const int j = ns >> 1, par = ns & 1; r = 256 * (j >> 7) + 128 * par + (j & 127); }
        else if (map == 3) { const int no = ns + 1024; r = (no < 3584 ? no : (no < 3608 ? C_GATE + (no - 3584) : C_QX + (no - 3608))) - 1024; }
        if (map == 4) {
            unsigned char* rowp = (unsigned char*)dst + (size_t)r * MIXP;
            if (k0 < 512) { const int kc = (tid & 7) * 8;
#pragma unroll
                for (int rep = 0; rep < 2; ++rep) { const int kk = kc + 64 * rep; float f[8];
#pragma unroll
                    for (int j = 0; j < 8; ++j) f[j] = tile[tt_idx(kk + j, n)] * W_FP8_SCALE;
                    u32x4 w; w.x = cvt_pk_bf16(f[0], f[1]); w.y = cvt_pk_bf16(f[2], f[3]); w.z = cvt_pk_bf16(f[4], f[5]); w.w = cvt_pk_bf16(f[6], f[7]);
                    *(u32x4*)(rowp + 2 * (k0 + kk)) = w; }
            } else { const int kk = (tid & 7) * 16; float f[16];
#pragma unroll
                for (int j = 0; j < 16; ++j) f[j] = tile[tt_idx(kk + j, n)] * W_FP8_SCALE;
                u32x4 w; w.x = pk4_fp8(f[0], f[1], f[2], f[3]); w.y = pk4_fp8(f[4], f[5], f[6], f[7]); w.z = pk4_fp8(f[8], f[9], f[10], f[11]); w.w = pk4_fp8(f[12], f[13], f[14], f[15]);
                *(u32x4*)(rowp + 1024 + (k0 - 512) + kk) = w; }
        } else if (fp8) { const int kk = (tid & 7) * 16; float f[16];
#pragma unroll
            for (int j = 0; j < 16; ++j) f[j] = tile[tt_idx(kk + j, n)] * W_FP8_SCALE;
            u32x4 w; w.x = pk4_fp8(f[0], f[1], f[2], f[3]); w.y = pk4_fp8(f[4], f[5], f[6], f[7]); w.z = pk4_fp8(f[8], f[9], f[10], f[11]); w.w = pk4_fp8(f[12], f[13], f[14], f[15]);
            *(u32x4*)((unsigned char*)dst + (size_t)r * ldd + k0 + kk) = w;
        } else { const int kc = (tid & 7) * 8;
#pragma unroll
            for (int rep = 0; rep < 2; ++rep) { const int kk = kc + 64 * rep; float f[8];
#pragma unroll
                for (int j = 0; j < 8; ++j) f[j] = tile[tt_idx(kk + j, n)];
                u32x4 w; w.x = cvt_pk_bf16(f[0], f[1]); w.y = cvt_pk_bf16(f[2], f[3]); w.z = cvt_pk_bf16(f[4], f[5]); w.w = cvt_pk_bf16(f[6], f[7]);
                *(u32x4*)(dst + (size_t)r * ldd + k0 + kk) = w; } } }
}
__device__ __forceinline__ void tt_put4(const TReg& R, LAS float* tile, int tid) {
    const int kr = tid >> 4, q = tid & 15;
#pragma unroll
    for (int rep = 0; rep < 4; ++rep) { const int k = kr + 32 * rep; *(LAS f32x4*)(tile + k * 64 + 4 * (q ^ ((k >> 4) & 7))) = R.v[rep]; } }
__device__ __forceinline__ void tt_finish4(LAS const float* tile, unsigned char* dst, int ldd, int k0, int n0, int map, int tid) {
    const int n = tid >> 3, ns = n0 + n, kq = tid & 7, kk = kq * 16; int r = ns;
    if (map == 2) { const int j = ns >> 1, par = ns & 1; r = 256 * (j >> 7) + 128 * par + (j & 127); }
    LAS const float* col = tile + 4 * ((n >> 2) ^ kq) + (n & 3); float f[16];
#pragma unroll
    for (int j = 0; j < 16; ++j) f[j] = col[(kk + j) * 64] * W_FP8_SCALE;
    u32x4 w; w.x = pk4_fp8(f[0], f[1], f[2], f[3]); w.y = pk4_fp8(f[4], f[5], f[6], f[7]); w.z = pk4_fp8(f[8], f[9], f[10], f[11]); w.w = pk4_fp8(f[12], f[13], f[14], f[15]);
    *(u32x4*)(dst + (size_t)r * ldd + k0 + kk) = w;
}
template <int K_, int N_, int MAP_> __device__ __forceinline__ void tjob_deep(const Ctx& C, int bid, int G, const float* src, unsigned char* dstb, int nbatch) {
    constexpr int kt = K_ / 128, ntile = N_ / 64, per = kt * ntile; const int tot = per * nbatch;
    TReg R0, R1, R2, R3; int kbuf = 0;
#define TD_LOAD(R_, t_) do { const int _t = (t_); if (_t < tot) { const int _b = _t / per, _r = _t % per; tt_load(R_, src + (size_t)_b * K_ * N_, N_, N_, (_r % kt) * 128, (_r / kt) * 64, C.tid); } } while (0)
#define TD_STEP(R_, t_) do { const int _u = (t_); if (_u < tot) { LAS float* tile = (LAS float*)(C.lds + kbuf * TT_TILE_BYTES); tt_put4(R_, tile, C.tid); TD_LOAD(R_, _u + 4 * G); __syncthreads(); \
        { const int _b = _u / per, _r = _u % per; tt_finish4(tile, dstb + (size_t)_b * K_ * (MAP_ == 2 ? 4096 : N_), K_, (_r % kt) * 128, (_r / kt) * 64, MAP_, C.tid); } kbuf ^= 1; } } while (0)
    TD_LOAD(R0, bid); TD_LOAD(R1, bid + G); TD_LOAD(R2, bid + 2 * G); TD_LOAD(R3, bid + 3 * G);
    for (int t = bid; t < tot; t += 4 * G) { TD_STEP(R0, t); TD_STEP(R1, t + G); TD_STEP(R2, t + 2 * G); TD_STEP(R3, t + 3 * G); }
    __syncthreads();
#undef TD_LOAD
#undef TD_STEP
}
__device__ __forceinline__ void p0_prologue(const Ctx& C) {
    int base = 0;
#define TJOB(IN_, DST_, K_, N_, BATCH_, MAP_, FP8_) TJOBX(IN_, DST_, K_, N_, N_, 0, BATCH_, MAP_, FP8_)
#define TJOBX(IN_, DST_, K_, N_, LD_, COLOFF_, BATCH_, MAP_, FP8_) do { constexpr int kt = (K_) / 128, ntile = ((N_) + 63) / 64, per = kt * ntile, tot = per * (BATCH_); \
        const int first = (C.bid - base % C.G + C.G) % C.G; const float* srcb = C.ka->in[IN_] + (COLOFF_); TReg R; int kbuf = 0; \
        if (first < tot) { const int b = first / per, r = first % per; tt_load(R, srcb + (size_t)b * (K_) * (LD_), (N_), (LD_), (r % kt) * 128, (r / kt) * 64, C.tid); } \
        for (int t = first; t < tot; t += C.G, kbuf ^= 1) { LAS float* tile = (LAS float*)(C.lds + kbuf * TT_TILE_BYTES); \
            tt_put(R, tile, C.tid); \
            { const int tn = t + C.G; if (tn < tot) { const int b = tn / per, r = tn % per; tt_load(R, srcb + (size_t)b * (K_) * (LD_), (N_), (LD_), (r % kt) * 128, (r / kt) * 64, C.tid); } } \
            __syncthreads(); \
            { const int b = t / per, r = t % per; \
              tt_finish(tile, (bf16_t*)(C.ws + (DST_) + (size_t)b * (K_) * ((MAP_) == 2 ? 4096 : (N_)) * ((FP8_) ? 1 : 2)), (K_), (r % kt) * 128, (r / kt) * 64, (N_), (MAP_), (FP8_), C.tid); } } \
        __syncthreads(); base += tot; } while (0)
      TJOBX(I_WIN, WS_WIN, 2048, 1024, IN_COLS, 0, 1, 0, false); TJOBX(I_WIN, WS_WIN8, 2048, IN_COLS - 1024, IN_COLS, 1024, 1, 3, true); TJOB(I_WOUT, WS_WOUT, 2048, 2048, 1, 4, false);
    TJOB(I_WKV, WS_WKV, 2048, 1024, 1, 0, true); TJOB(I_CK1, WS_CK1, 4096, 128, 1, 0, false); TJOB(I_CV1, WS_CV1, 4096, 128, 1, 0, false); TJOB(I_CK2, WS_CK2, 128, 128, 1, 0, false); TJOB(I_CV2, WS_CV2, 128, 128, 1, 0, false);
#undef TJOB
#undef TJOBX
    const int gw = C.bid * 8 + C.wave, NWV = C.G * 8, lane = C.lane;
    for (int row = gw; row < T_ + NB * MEMT; row += NWV) {
        const bool ismem = row >= T_; const float* src = ismem ? C.ka->in[I_MEM] + (size_t)(row - T_) * D_ : C.ka->in[I_X] + (size_t)row * D_;
        const float* gv = ismem ? C.ka->in[I_MEMG] : C.ka->in[I_MIXG]; bf16_t* dst = WSP(bf16_t, WS_H) + (size_t)row * D_; unsigned char* d8 = ismem ? WSP(unsigned char, WS_MEMN) + (size_t)(row - T_) * D_ : WSP(unsigned char, WS_H8) + (size_t)row * D_;
        f32x4 v[8]; float ss = 0.f;
#pragma unroll
        for (int c = 0; c < 8; ++c) { v[c] = *(const f32x4*)(src + c * 256 + lane * 4); ss += (v[c][0] * v[c][0] + v[c][1] * v[c][1]) + (v[c][2] * v[c][2] + v[c][3] * v[c][3]); }
        ss = wave_sum(ss); const float rs = rsqrtf(ss * (1.0f / D_) + EPS);
#pragma unroll
        for (int c = 0; c < 8; ++c) { const f32x4 g4 = *(const f32x4*)(gv + c * 256 + lane * 4); const float h0 = v[c][0] * rs * g4[0], h1 = v[c][1] * rs * g4[1], h2 = v[c][2] * rs * g4[2], h3 = v[c][3] * rs * g4[3];
            if (!ismem) { u32x2 w; w.x = cvt_pk_bf16(h0, h1); w.y = cvt_pk_bf16(h2, h3); *(u32x2*)(dst + c * 256 + lane * 4) = w; }
            *(unsigned*)(d8 + c * 256 + lane * 4) = pk4_fp8(h0, h1, h2, h3); }
    }
    const size_t gt = (size_t)C.bid * 512 + C.tid, GT = (size_t)C.G * 512;
    for (size_t i = gt; i < (size_t)32 * D_; i += GT) {
        const int e = (int)(i / D_), k = (int)(i % D_); const float w = C.ka->in[I_WR][(size_t)k * 32 + e]; const bf16_t hi = f2bf(w); WSP(bf16_t, WS_WRH)[i] = hi; WSP(bf16_t, WS_WRL)[i] = f2bf(w - bf2f(hi)); }
    for (size_t i = gt; i < (size_t)NEXP * D_; i += GT) WSP(float, WS_B2C)[i] = C.ka->in[I_BE2][i];
    for (size_t i = gt; i < (size_t)NEXP * FF; i += GT) {
        const int e = (int)(i / FF), j = (int)(i % FF); WSP(float, WS_B1G)[i] = C.ka->in[I_BE1][(size_t)e * 4096 + 2 * j]; WSP(float, WS_B1L)[i] = C.ka->in[I_BE1][(size_t)e * 4096 + 2 * j + 1]; }
    for (size_t i = gt; i < (size_t)4 * 128 * 128; i += GT) {
        const int s = (int)(i & 127), t = (int)((i >> 7) & 127); WSP(bf16_t, WS_GWS)[i] = s <= t ? f2bf(C.ka->in[I_GWS][i]) : (bf16_t)0; }
    if (C.bid == 0) {
        if (C.tid < 64) WSP(float, WS_MISC)[C.tid] = (float)pow(10000.0, -(double)C.tid / 64.0);
        if (C.wave == 1) {
            float a = fmaxf(fabsf(C.ka->in[I_NQG][lane]), fabsf(C.ka->in[I_NQG][lane + 64])), b = fmaxf(fabsf(C.ka->in[I_NKG][lane]), fabsf(C.ka->in[I_NKG][lane + 64]));
            float c = fmaxf(fabsf(C.ka->in[I_XQG][lane]), fabsf(C.ka->in[I_XQG][lane + 64])), d = fmaxf(fabsf(C.ka->in[I_XKG][lane]), fabsf(C.ka->in[I_XKG][lane + 64]));
            for (int o = 32; o >= 1; o >>= 1) { a = fmaxf(a, __shfl_xor(a, o)); b = fmaxf(b, __shfl_xor(b, o)); c = fmaxf(c, __shfl_xor(c, o)); d = fmaxf(d, __shfl_xor(d, o)); }
            if (lane == 0) { WSP(float, WS_MISC)[64] = 11.313708499f * a * b * 1.4426950409f; WSP(float, WS_MISC)[65] = 11.313708499f * c * d * 1.4426950409f; } }
    }
    for (int job = C.bid; job < 64; job += C.G) { const int m = job >> 5, j = job & 31;
        const float* w1 = m == 0 ? C.ka->in[I_CK1] : C.ka->in[I_CV1]; const float* pos = C.ka->in[I_CPOS]; LAS float* red = (LAS float*)C.lds;
        const int o = C.tid & 127, part = C.tid >> 7; float s = 0.f; const int k0 = j * 128 + part * 32;
#pragma unroll
        for (int kk = 0; kk < 32; ++kk) s += pos[k0 + kk] * w1[(size_t)(k0 + kk) * 128 + o];
        __syncthreads(); red[C.tid] = s; __syncthreads();
        if (C.tid < 128) ((float*)(C.ws + WS_CTL + 32768))[(m * 32 + j) * 128 + o] = (red[o] + red[128 + o]) + (red[256 + o] + red[384 + o]);
    }
    __syncthreads();
}
__device__ __forceinline__ float row16_sum(float v) { v += dppf<0xB1>(v); v += dppf<0x4E>(v); v += dppf<0x141>(v); v += dppf<0x140>(v); return v; }
__device__ __forceinline__ void unpack8(const u32x4 w, float (&f)[8]) {
    f[0] = __uint_as_float(w.x << 16); f[1] = __uint_as_float(w.x & 0xFFFF0000u); f[2] = __uint_as_float(w.y << 16); f[3] = __uint_as_float(w.y & 0xFFFF0000u);
    f[4] = __uint_as_float(w.z << 16); f[5] = __uint_as_float(w.z & 0xFFFF0000u); f[6] = __uint_as_float(w.w << 16); f[7] = __uint_as_float(w.w & 0xFFFF0000u); }
__device__ __forceinline__ u32x4 pack8u(const float (&f)[8]) { u32x4 w; w.x = cvt_pk_bf16(f[0], f[1]); w.y = cvt_pk_bf16(f[2], f[3]); w.z = cvt_pk_bf16(f[4], f[5]); w.w = cvt_pk_bf16(f[6], f[7]); return w; }
__device__ __forceinline__ u32x4 ror8(const u32x4 w) { u32x4 o; o.x = dppu<0x128>(w.x); o.y = dppu<0x128>(w.y); o.z = dppu<0x128>(w.z); o.w = dppu<0x128>(w.w); return o; }
__device__ __forceinline__ void p2_token_prep(const Ctx& C) {
    const int gw = C.bid * 8 + C.wave, NWV = C.G * 8, L = C.lane, r = L & 15, rowid = L >> 4, rp = r ^ 8;
    if (C.bid == 0 && C.tid < 256) { const float* cp = (const float*)(C.ws + WS_CTL + 32768) + (C.tid >> 7) * 32 * 128 + (C.tid & 127); float s = 0.f;
        for (int j = 0; j < 32; ++j) s += cp[j * 128];
        WSP(float, WS_C1)[C.tid] = s; }
    const bf16_t* PROJ = WSP(bf16_t, WS_PROJ);
    LAS bf16_t* TS = (LAS bf16_t*)C.lds; LAS bf16_t* TW = (LAS bf16_t*)(C.lds + 32768); LAS bf16_t* TG = (LAS bf16_t*)(C.lds + 65536);
    LAS float* cs = (LAS float*)(C.lds + 131072 + C.wave * 512);
    const float inv = WSP(float, WS_MISC)[L];
    float qgo[8], qgp[8], kgo[8], kgp[8], xgo[8], gvo[8];
#pragma unroll
    for (int j = 0; j < 8; ++j) { qgo[j] = C.ka->in[I_NQG][8 * r + j]; qgp[j] = C.ka->in[I_NQG][8 * rp + j]; kgo[j] = C.ka->in[I_NKG][8 * r + j]; kgp[j] = C.ka->in[I_NKG][8 * rp + j];
        xgo[j] = C.ka->in[I_XQG][8 * r + j]; gvo[j] = C.ka->in[I_GVG][rowid * 128 + 8 * r + j]; }
    const float sgn = r < 8 ? -1.0f : 1.0f;
    for (int unit = C.bid; unit < T_ / 64; unit += C.G) {
      for (int tl = 0; tl < 8; ++tl) {
        const int tok = 8 * C.wave + tl, t = unit * 64 + tok;
        const bf16_t* pr = PROJ + (size_t)t * NPROJ + 8 * L; const int b = t / S_, s = t % S_;
        u32x4 ld[8];
#pragma unroll
        for (int m = 0; m < 8; ++m) ld[m] = *(const u32x4*)(pr + 512 * m);
        { const float ang = (float)((const int*)C.ka->in[I_POS])[t] * inv; float sn, c; sincosf(ang, &sn, &c); cs[L] = c; cs[64 + L] = sn; }
        float cw[8], sw[8];
        { const f32x4 c0 = *(const LAS f32x4*)(cs + 8 * (r & 7)), c1 = *(const LAS f32x4*)(cs + 8 * (r & 7) + 4), s0 = *(const LAS f32x4*)(cs + 64 + 8 * (r & 7)), s1 = *(const LAS f32x4*)(cs + 64 + 8 * (r & 7) + 4);
#pragma unroll
          for (int j = 0; j < 4; ++j) { cw[j] = c0[j]; cw[4 + j] = c1[j]; sw[j] = s0[j] * sgn; sw[4 + j] = s1[j] * sgn; } }
        float f[8], fp[8], o[8];
        { unpack8(ld[0], f);
#pragma unroll
          for (int j = 0; j < 8; ++j) o[j] = gelu_tanh(f[j]);
          *(u32x4*)(WSP(bf16_t, WS_UB) + (size_t)t * 512 + 128 * rowid + 8 * r) = pack8u(o); }
        { unpack8(ld[1], f); float ss = 0.f;
#pragma unroll
          for (int j = 0; j < 8; ++j) { f[j] = gelu_tanh(f[j]); ss += f[j] * f[j]; }
          const float rn = rsqrtf(row16_sum(ss) * (1.0f / 128.0f) + EPS);
          LAS bf16_t* vt = TG + (rowid * 128 + 8 * r) * 64 + tok;
#pragma unroll
          for (int j = 0; j < 8; ++j) vt[j * 64] = f2bf(f[j] * rn * gvo[j]); }
#pragma unroll
        for (int m = 2; m < 4; ++m) { unpack8(ld[m], f); unpack8(ror8(ld[m]), fp); float ss = 0.f;
#pragma unroll
            for (int j = 0; j < 8; ++j) ss += f[j] * f[j];
            const float rn = rsqrtf(row16_sum(ss) * (1.0f / 128.0f) + EPS); const int h = 4 * (m - 2) + rowid;
#pragma unroll
            for (int j = 0; j < 8; ++j) { f[j] *= rn * qgo[j]; o[j] = f[j] * cw[j] + fp[j] * rn * qgp[j] * sw[j]; }
            *(u32x4*)(WSP(bf16_t, WS_QN) + (size_t)t * 1024 + h * 128 + 8 * r) = pack8u(f);
            *(u32x4*)(WSP(bf16_t, WS_QR) + (size_t)t * 1024 + h * 128 + 8 * r) = pack8u(o); }
        { const size_t rowkv = ((size_t)(b * 2 + (rowid & 1)) * S_ + s) * 128 + 8 * r; *(u32x4*)(WSP(bf16_t, rowid < 2 ? WS_KCMP : WS_VCMP) + rowkv) = ld[4]; }
#pragma unroll
        for (int m = 5; m < 7; ++m) { unpack8(ld[m], f); unpack8(ror8(ld[m]), fp); float ss = 0.f;
#pragma unroll
            for (int j = 0; j < 8; ++j) ss += f[j] * f[j];
            const float rn = rsqrtf(row16_sum(ss) * (1.0f / 128.0f) + EPS); const int g = rowid & 1;
            if (rowid < 2) {
#pragma unroll
                for (int j = 0; j < 8; ++j) o[j] = f[j] * rn * kgo[j] * cw[j] + fp[j] * rn * kgp[j] * sw[j];
                *(u32x4*)(WSP(bf16_t, m == 5 ? WS_KSEL : WS_KWIN) + ((size_t)(b * 2 + g) * S_ + s) * 128 + 8 * r) = pack8u(o);
            } else { LAS bf16_t* d = (m == 5 ? TS : TW) + (g * 128 + 8 * r) * 64 + tok;
                const u32x4 wv = ld[m];
                d[0] = (bf16_t)(wv.x & 0xFFFFu); d[64] = (bf16_t)(wv.x >> 16); d[128] = (bf16_t)(wv.y & 0xFFFFu); d[192] = (bf16_t)(wv.y >> 16);
                d[256] = (bf16_t)(wv.z & 0xFFFFu); d[320] = (bf16_t)(wv.z >> 16); d[384] = (bf16_t)(wv.w & 0xFFFFu); d[448] = (bf16_t)(wv.w >> 16); } }
        { unpack8(ld[7], f); float ss = 0.f;
#pragma unroll
          for (int j = 0; j < 8; ++j) ss += f[j] * f[j];
          const float rn = rsqrtf(row16_sum(ss) * (1.0f / 128.0f) + EPS);
#pragma unroll
          for (int j = 0; j < 8; ++j) o[j] = f[j] * rn * xgo[j];
          *(u32x4*)(WSP(bf16_t, WS_QX) + (size_t)t * 512 + rowid * 128 + 8 * r) = pack8u(o); }
        if (L < 24) WSP(float, WS_GATES)[(size_t)t * 24 + L] = sigmoidf_(bf2f(PROJ[(size_t)t * NPROJ + C_GATE + L]));
      }
      __syncthreads();
      { const int t0 = unit * 64, b = t0 / S_, s0 = t0 % S_;
#pragma unroll
        for (int k = 0; k < 4; ++k) { const int c = C.tid + 512 * k, g = c >> 10;
            const size_t dst = ((size_t)(b * 2 + g) * 256 + (s0 >> 6)) * 8192 + (size_t)(c & 1023) * 8;
            *(u32x4*)(WSP(bf16_t, WS_VSELT) + dst) = *(const LAS u32x4*)(TS + c * 8); *(u32x4*)(WSP(bf16_t, WS_VWINT) + dst) = *(const LAS u32x4*)(TW + c * 8); }
#pragma unroll
        for (int k = 0; k < 8; ++k) { const int c = C.tid + 512 * k, row = c >> 3, ch = c & 7;
            *(u32x4*)(WSP(bf16_t, WS_VTG) + ((size_t)(t0 >> 7) * 512 + row) * 128 + ((t0 >> 6) & 1) * 64 + ch * 8) = *(const LAS u32x4*)(TG + c * 8); } }
      __syncthreads();
    }
    const int i = C.lane;
    const float mg0 = C.ka->in[I_XKG][i], mg1 = C.ka->in[I_XKG][i + 64];
    for (int m = gw; m < NB * MEMT; m += NWV) { const bf16_t* pr = WSP(bf16_t, WS_MEMKV) + (size_t)m * 1024; const int b = m / MEMT, mm = m % MEMT;
#pragma unroll
        for (int h = 0; h < 4; ++h) { const float a = bf2f(pr[h * 128 + i]), bb = bf2f(pr[h * 128 + 64 + i]); const float r = rsqrtf(wave_sum(a * a + bb * bb) * (1.0f / 128.0f) + EPS);
            bf16_t* k = WSP(bf16_t, WS_KX) + ((size_t)(b * 4 + h) * 256 + mm) * 128; k[i] = f2bf(a * r * mg0); k[i + 64] = f2bf(bb * r * mg1);
            bf16_t* v = WSP(bf16_t, WS_VXT) + ((size_t)(b * 4 + h) * 4 + (mm >> 6)) * 128 * 64 + (mm & 63); v[(size_t)i * 64] = pr[512 + h * 128 + i]; v[(size_t)(i + 64) * 64] = pr[512 + h * 128 + 64 + i]; } }
}

struct QF { bf16x8 f[4]; };
enum { MODE_NONE = 0, MODE_WIN = 1, MODE_CMP = 2, MODE_SEL = 3 };
__device__ __forceinline__ QF load_qf(const bf16_t* qrow, int g) { QF q;
#pragma unroll
    for (int ks = 0; ks < 4; ++ks) q.f[ks] = *(const bf16x8*)(qrow + 32 * ks + 8 * g);
    return q; }
template <int MODE> __device__ __forceinline__ void qk_group(const QF& q, const bf16_t* Kblk, int kg, int i, int g, int tq, int kbase, float c2, float mb, float (&p)[8]) {
    f32x4 s0 = {0.f, 0.f, 0.f, 0.f}, s1 = {0.f, 0.f, 0.f, 0.f};
    const bf16_t* k0 = Kblk + (size_t)(32 * kg + 8 * (i >> 2) + (i & 3)) * 128 + 8 * g;
#pragma unroll
    for (int ks = 0; ks < 4; ++ks) { const bf16x8 a0 = *(const bf16x8*)(k0 + 32 * ks), a1 = *(const bf16x8*)(k0 + 4 * 128 + 32 * ks);
        s0 = __builtin_amdgcn_mfma_f32_16x16x32_bf16(a0, q.f[ks], s0, 0, 0, 0); s1 = __builtin_amdgcn_mfma_f32_16x16x32_bf16(a1, q.f[ks], s1, 0, 0, 0); }
#pragma unroll
    for (int r = 0; r < 8; ++r) { const int key = kbase + 32 * kg + 8 * g + r; const float sv = r < 4 ? s0[r & 3] : s1[r & 3];
        bool valid = true;
        if (MODE == MODE_WIN) valid = (key <= tq) && (key > tq - 512);
        if (MODE == MODE_CMP) valid = (16 * key + 31 <= tq);
        if (MODE == MODE_SEL) valid = (key <= tq);
        p[r] = valid ? __builtin_amdgcn_exp2f(sv * c2 - mb) : 0.f; }
}
__device__ __forceinline__ void pv_group(const float (&p)[8], const bf16_t* VTblk, int kg, int i, int g, f32x4 (&O)[8]) {
    const bf16x8 pf = pack8(p[0], p[1], p[2], p[3], p[4], p[5], p[6], p[7]);
    const bf16_t* v0 = VTblk + (size_t)i * 64 + 32 * kg + 8 * g;
#pragma unroll
    for (int dt = 0; dt < 8; ++dt) { const bf16x8 vt = *(const bf16x8*)(v0 + (size_t)dt * 16 * 64); O[dt] = __builtin_amdgcn_mfma_f32_16x16x32_bf16(vt, pf, O[dt], 0, 0, 0); }
}
template <int MODE> __device__ __forceinline__ void attn_block(const QF& q, const bf16_t* Kblk, const bf16_t* VTblk, f32x4 (&O)[8], float& l, int i, int g, int tq, int kbase, float c2, float mb) {
#pragma unroll
    for (int kg = 0; kg < 2; ++kg) { float p[8]; qk_group<MODE>(q, Kblk, kg, i, g, tq, kbase, c2, mb, p);
        l += ((p[0] + p[1]) + (p[2] + p[3])) + ((p[4] + p[5]) + (p[6] + p[7]));
        pv_group(p, VTblk, kg, i, g, O); }
}
constexpr float C2_ = 0.08838834764831845f * 1.4426950408889634f;
__device__ __forceinline__ void compress_coop(const Ctx& C) {
    const int w = C.wave, lane = C.lane, i = lane & 15, g4 = lane >> 4, half = w >> 2, kq = w & 3;
    LAS float* part = (LAS float*)C.lds;
    for (int pair = C.bid; pair < 256; pair += C.G) {
        const int task = pair * 2 + half;
        const int kv = task >> 8, bg = (task >> 6) & 3, rt = task & 63, n = 16 * rt + i;
        const bf16_t* src = WSP(bf16_t, kv ? WS_VCMP : WS_KCMP) + (size_t)bg * S_ * 128;
        const bf16_t* w1T = WSP(bf16_t, kv ? WS_CV1 : WS_CK1);
        const bf16_t* brow = src + (size_t)(16 * n) * 128 + 8 * g4 + 1024 * kq;
        const bf16_t* arow = w1T + (size_t)i * 4096 + 8 * g4 + 1024 * kq;
        f32x4 acc[8];
#pragma unroll
        for (int ot = 0; ot < 8; ++ot) acc[ot] = (f32x4){0.f, 0.f, 0.f, 0.f};
        bf16x8 bN = *(const bf16x8*)brow, aN[8], bM = *(const bf16x8*)(brow + 32), aM[8];
#pragma unroll
        for (int ot = 0; ot < 8; ++ot) { aN[ot] = *(const bf16x8*)(arow + (size_t)ot * 16 * 4096); aM[ot] = *(const bf16x8*)(arow + (size_t)ot * 16 * 4096 + 32); }
        for (int ks = 0; ks < 32; ++ks) { const bf16x8 bfr = bN; bf16x8 a[8];
#pragma unroll
            for (int ot = 0; ot < 8; ++ot) { a[ot] = aN[ot]; aN[ot] = aM[ot]; }
            bN = bM;
            const int kn = ks + 2 < 32 ? ks + 2 : 31;
            bM = *(const bf16x8*)(brow + 32 * kn);
#pragma unroll
            for (int ot = 0; ot < 8; ++ot) aM[ot] = *(const bf16x8*)(arow + (size_t)ot * 16 * 4096 + 32 * kn);
#pragma unroll
            for (int ot = 0; ot < 8; ++ot) acc[ot] = __builtin_amdgcn_mfma_f32_16x16x32_bf16(a[ot], bfr, acc[ot], 0, 0, 0); }
#pragma unroll
        for (int ot = 0; ot < 8; ++ot) *(LAS f32x4*)(part + (((half * 4 + kq) * 8 + ot) * 64 + lane) * 4) = acc[ot];
        __syncthreads();
        if (kq == 0) {
#pragma unroll
            for (int ot = 0; ot < 8; ++ot) { acc[ot] = *(const LAS f32x4*)(part + (((half * 4 + 0) * 8 + ot) * 64 + lane) * 4);
#pragma unroll
                for (int qq = 1; qq < 4; ++qq) acc[ot] += *(const LAS f32x4*)(part + (((half * 4 + qq) * 8 + ot) * 64 + lane) * 4); }
            const float* c1 = WSP(float, WS_C1) + kv * 128;
#pragma unroll
            for (int ot = 0; ot < 8; ++ot) { const f32x4 cb = *(const f32x4*)(c1 + 16 * ot + 4 * g4);
#pragma unroll
                for (int r = 0; r < 4; ++r) acc[ot][r] = gelu_tanh(acc[ot][r] + cb[r]); }
            const bf16_t* w2T = WSP(bf16_t, kv ? WS_CV2 : WS_CK2);
            f32x4 acc2[8];
#pragma unroll
            for (int ot = 0; ot < 8; ++ot) acc2[ot] = (f32x4){0.f, 0.f, 0.f, 0.f};
#pragma unroll
            for (int ks2 = 0; ks2 < 4; ++ks2) {
                const bf16x8 pf = pack8(acc[2 * ks2][0], acc[2 * ks2][1], acc[2 * ks2][2], acc[2 * ks2][3], acc[2 * ks2 + 1][0], acc[2 * ks2 + 1][1], acc[2 * ks2 + 1][2], acc[2 * ks2 + 1][3]);
#pragma unroll
                for (int o2t = 0; o2t < 8; ++o2t) { const bf16_t* wr = w2T + (size_t)(16 * o2t + i) * 128 + 32 * ks2 + 4 * g4;
                    const u32x2 lo = *(const u32x2*)wr, hi = *(const u32x2*)(wr + 16); const u32x4 wv = {lo.x, lo.y, hi.x, hi.y};
                    acc2[o2t] = __builtin_amdgcn_mfma_f32_16x16x32_bf16(__builtin_bit_cast(bf16x8, wv), pf, acc2[o2t], 0, 0, 0); } }
            const bool pad = (n == 1023);
            if (kv == 0) {
                float ss = 0.f;
#pragma unroll
                for (int o2t = 0; o2t < 8; ++o2t) ss += (acc2[o2t][0] * acc2[o2t][0] + acc2[o2t][1] * acc2[o2t][1]) + (acc2[o2t][2] * acc2[o2t][2] + acc2[o2t][3] * acc2[o2t][3]);
                ss += __shfl_xor(ss, 16); ss += __shfl_xor(ss, 32);
                const float r = pad ? 0.f : rsqrtf(ss * (1.0f / 128.0f) + EPS);
                bf16_t* dst = WSP(bf16_t, WS_KC) + ((size_t)bg * 1024 + n) * 128;
                const float* nkg = C.ka->in[I_NKG] + 4 * g4; f32x4 kgv[8];
#pragma unroll
                for (int o2t = 0; o2t < 8; ++o2t) kgv[o2t] = *(const f32x4*)(nkg + 16 * o2t);
#pragma unroll
                for (int o2t = 0; o2t < 8; ++o2t) { const f32x4 kg = kgv[o2t]; u32x2 wv;
                    wv.x = cvt_pk_bf16(acc2[o2t][0] * r * kg[0], acc2[o2t][1] * r * kg[1]); wv.y = cvt_pk_bf16(acc2[o2t][2] * r * kg[2], acc2[o2t][3] * r * kg[3]);
                    *(u32x2*)(dst + 16 * o2t + 4 * g4) = wv; }
            } else {
                bf16_t* dst = WSP(bf16_t, WS_VCT) + ((size_t)bg * 16 + (n >> 6)) * 128 * 64 + (n & 63);
#pragma unroll
                for (int o2t = 0; o2t < 8; ++o2t)
#pragma unroll
                    for (int r = 0; r < 4; ++r) dst[(size_t)(16 * o2t + 4 * g4 + r) * 64] = pad ? (bf16_t)0 : f2bf(acc2[o2t][r]);
            }
        }
        __syncthreads();
    }
}
__device__ __forceinline__ void gmlp_task(const Ctx& C, int task) {
    const int i = C.lane & 15, g4 = C.lane >> 4;
    const int tt = task & 7, gg = (task >> 3) & 3, ch = task >> 5;
    const bf16_t* arow = WSP(bf16_t, WS_VTG) + ((size_t)(ch * 4 + gg) * 128 + i) * 128 + 8 * g4;
    const bf16_t* brow = WSP(bf16_t, WS_GWS) + ((size_t)gg * 128 + 16 * tt + i) * 128 + 8 * g4;
    f32x4 acc[8];
#pragma unroll
    for (int dt = 0; dt < 8; ++dt) acc[dt] = (f32x4){0.f, 0.f, 0.f, 0.f};
    bf16x8 bfr[4], af[4][8];
#pragma unroll
    for (int ks = 0; ks < 4; ++ks) { bfr[ks] = *(const bf16x8*)(brow + 32 * ks);
#pragma unroll
        for (int dt = 0; dt < 8; ++dt) af[ks][dt] = *(const bf16x8*)(arow + (size_t)dt * 16 * 128 + 32 * ks); }
    const int tok = ch * 128 + 16 * tt + i; const float bs = C.ka->in[I_GBS][gg * 128 + 16 * tt + i];
    const bf16_t* ub = WSP(bf16_t, WS_UB) + (size_t)tok * 512 + gg * 128 + 4 * g4; bf16_t* mix = (bf16_t*)(WSP(unsigned char, WS_MIX) + (size_t)tok * MIXP) + gg * 128 + 4 * g4;
    u32x2 uq[8];
#pragma unroll
    for (int dt = 0; dt < 8; ++dt) uq[dt] = *(const u32x2*)(ub + 16 * dt);
#pragma unroll
    for (int ks = 0; ks < 4; ++ks)
#pragma unroll
        for (int dt = 0; dt < 8; ++dt) acc[dt] = __builtin_amdgcn_mfma_f32_16x16x32_bf16(af[ks][dt], bfr[ks], acc[dt], 0, 0, 0);
#pragma unroll
    for (int dt = 0; dt < 8; ++dt) { const u32x2 uu = uq[dt];
        const float u0 = __uint_as_float(uu.x << 16), u1 = __uint_as_float(uu.x & 0xFFFF0000u), u2 = __uint_as_float(uu.y << 16), u3 = __uint_as_float(uu.y & 0xFFFF0000u);
        u32x2 w; w.x = cvt_pk_bf16(MIX_SCALE * u0 * (acc[dt][0] + bs), MIX_SCALE * u1 * (acc[dt][1] + bs)); w.y = cvt_pk_bf16(MIX_SCALE * u2 * (acc[dt][2] + bs), MIX_SCALE * u3 * (acc[dt][3] + bs));
        *(u32x2*)(mix + 16 * dt) = w; }
}
__device__ __forceinline__ void window_task(const Ctx& C, int task) {
    const int i = C.lane & 15, g4 = C.lane >> 4;
    const int qt = task & 1023, h = (task >> 10) & 7, b = task >> 13, bg = b * 2 + (h >> 2);
    const int t0 = 16 * qt, tq = t0 + i; const size_t t = (size_t)b * S_ + tq;
    const float mb = WSP(float, WS_MISC)[64];
    const QF qf = load_qf(WSP(bf16_t, WS_QR) + t * 1024 + h * 128, g4);
    f32x4 O[8];
#pragma unroll
    for (int dt = 0; dt < 8; ++dt) O[dt] = (f32x4){0.f, 0.f, 0.f, 0.f};
    float l = 0.f;
    const int blo = (t0 - 511 > 0 ? t0 - 511 : 0) >> 6, bhi = (t0 + 15) >> 6;
    for (int blk = blo; blk <= bhi; ++blk)
        attn_block<MODE_WIN>(qf, WSP(bf16_t, WS_KWIN) + ((size_t)bg * S_ + 64 * blk) * 128, WSP(bf16_t, WS_VWINT) + ((size_t)bg * 256 + blk) * 8192, O, l, i, g4, tq, 64 * blk, C2_, mb);
    l += __shfl_xor(l, 16); l += __shfl_xor(l, 32);
    const float sc = (l > 0.f ? 1.0f / l : 0.f) * WSP(float, WS_GATES)[t * 24 + h * 3 + 2];
    float* dst = WSP(float, WS_MIXACC) + t * 1024 + h * 128 + 4 * g4;
#pragma unroll
    for (int dt = 0; dt < 8; ++dt) *(f32x4*)(dst + 16 * dt) = O[dt] * sc;
}
__device__ __forceinline__ void xattn_task(const Ctx& C, int task) {
    const int i = C.lane & 15, g4 = C.lane >> 4;
    const int qt = task & 1023, hx = (task >> 10) & 3, b = task >> 12;
    const int tq = 16 * qt + i; const size_t t = (size_t)b * S_ + tq;
    const float mb = WSP(float, WS_MISC)[65];
    const QF qf = load_qf(WSP(bf16_t, WS_QX) + t * 512 + hx * 128, g4);
    f32x4 O[8];
#pragma unroll
    for (int dt = 0; dt < 8; ++dt) O[dt] = (f32x4){0.f, 0.f, 0.f, 0.f};
    float l = 0.f;
    for (int blk = 0; blk < 4; ++blk)
        attn_block<MODE_NONE>(qf, WSP(bf16_t, WS_KX) + ((size_t)(b * 4 + hx) * 256 + 64 * blk) * 128, WSP(bf16_t, WS_VXT) + ((size_t)(b * 4 + hx) * 4 + blk) * 8192, O, l, i, g4, tq, 64 * blk, C2_, mb);
    l += __shfl_xor(l, 16); l += __shfl_xor(l, 32);
    const float sc = l > 0.f ? 1.0f / l : 0.f;
    bf16_t* dst = WSP(bf16_t, WS_MIX) + t * D_ + 1536 + hx * 128 + 4 * g4;
#pragma unroll
    for (int dt = 0; dt < 8; ++dt) { u32x2 w; w.x = cvt_pk_bf16(O[dt][0] * sc, O[dt][1] * sc); w.y = cvt_pk_bf16(O[dt][2] * sc, O[dt][3] * sc); *(u32x2*)(dst + 16 * dt) = w; }
}
constexpr int P3_NX = NB * 4 * 1024, P3_NG = 256 * 4 * 8;
#ifndef MK_REPEAT
#define MK_REPEAT 0
#endif
__device__ __forceinline__ void p3_tasks(const Ctx& C) {
    for (int rep = 0; rep < 1 + ((MK_REPEAT >> 12) & 1); ++rep) compress_coop(C);
    const int gw = C.bid * 8 + C.wave, NWV = C.G * 8;
    for (int rep = 0; rep < 1 + ((MK_REPEAT >> 14) & 1); ++rep) for (int task = gw; task < P3_NG; task += NWV) gmlp_task(C, task);
}

__device__ __forceinline__ void p4_compressed(const Ctx& C) {
    const int gw = C.bid * 8 + C.wave, NWV = C.G * 8, lane = C.lane, i = lane & 15, g4 = lane >> 4;
    LAS float* imp = (LAS float*)(C.lds + C.wave * 16448);
    const float mb = WSP(float, WS_MISC)[64];
    const int NTASK = 4 * 1024;
    for (int task = gw; task < NTASK; task += NWV) {
        const int round = task / NWV, base = NWV * round, cntr = (NTASK - base) < NWV ? (NTASK - base) : NWV, off = task - base;
        const int tk = base + ((round & 1) ? cntr - 1 - off : off);
        const int qt = 1023 - (tk >> 2), bg = tk & 3, b = bg >> 1, g = bg & 1;
        const int t0 = 16 * qt, tq = t0 + i; const size_t t = (size_t)b * S_ + tq;
        for (int k = lane; k < 16 * 257; k += 64) imp[k] = 0.f;
        const int nb = (qt + 63) >> 6;
        const bf16_t* KC = WSP(bf16_t, WS_KC) + (size_t)bg * 1024 * 128; const bf16_t* VCT = WSP(bf16_t, WS_VCT) + (size_t)bg * 16 * 8192;
        float invl[4];
#pragma unroll
        for (int r = 0; r < 4; ++r) { const QF qf = load_qf(WSP(bf16_t, WS_QN) + t * 1024 + (g * 4 + r) * 128, g4); float l = 0.f;
            for (int blk = 0; blk < nb; ++blk)
#pragma unroll
                for (int kg = 0; kg < 2; ++kg) { float p[8]; qk_group<MODE_CMP>(qf, KC + (size_t)blk * 64 * 128, kg, i, g4, tq, 64 * blk, C2_, mb, p); l += ((p[0] + p[1]) + (p[2] + p[3])) + ((p[4] + p[5]) + (p[6] + p[7])); }
            l += __shfl_xor(l, 16); l += __shfl_xor(l, 32); invl[r] = l > 0.f ? 1.0f / l : 0.f; }
#pragma unroll
        for (int r = 0; r < 4; ++r) { const QF qf = load_qf(WSP(bf16_t, WS_QN) + t * 1024 + (g * 4 + r) * 128, g4);
            f32x4 O[8];
#pragma unroll
            for (int dt = 0; dt < 8; ++dt) O[dt] = (f32x4){0.f, 0.f, 0.f, 0.f};
            for (int blk = 0; blk < nb; ++blk)
#pragma unroll
                for (int kg = 0; kg < 2; ++kg) { float p[8]; qk_group<MODE_CMP>(qf, KC + (size_t)blk * 64 * 128, kg, i, g4, tq, 64 * blk, C2_, mb, p);
#pragma unroll
                    for (int j = 0; j < 8; ++j) p[j] *= invl[r];
                    LAS float* ip = imp + i * 257 + 16 * blk + 8 * kg + 2 * g4;
                    __hip_atomic_fetch_add(ip, 2.0f * (p[0] + p[1] + p[2]) + p[3], __ATOMIC_RELAXED, __HIP_MEMORY_SCOPE_WORKGROUP);
                    __hip_atomic_fetch_add(ip + 1, p[3] + 2.0f * (p[4] + p[5] + p[6]) + p[7], __ATOMIC_RELAXED, __HIP_MEMORY_SCOPE_WORKGROUP);
                    __hip_atomic_fetch_add(ip + 2, p[7], __ATOMIC_RELAXED, __HIP_MEMORY_SCOPE_WORKGROUP);
                    pv_group(p, VCT + (size_t)blk * 8192, kg, i, g4, O); }
            const float gate = WSP(float, WS_GATES)[t * 24 + (g * 4 + r) * 3 + 0];
            float* dst = WSP(float, WS_MIXACC) + t * 1024 + (g * 4 + r) * 128 + 4 * g4;
#pragma unroll
            for (int dt = 0; dt < 8; ++dt) { const f32x4 old = *(const f32x4*)(dst + 16 * dt); *(f32x4*)(dst + 16 * dt) = old + O[dt] * gate; } }
        const int cur = t0 >> 6; int* idx = WSP(int, WS_IDX) + ((size_t)bg * S_ + t0) * 16;
        if (cur <= 15) { for (int q = 0; q < 16; ++q) if (lane < 16) idx[q * 16 + lane] = lane <= cur ? lane : -1; }
        else {
            for (int q = 0; q < 16; ++q) {
                unsigned key[4];
#pragma unroll
                for (int c = 0; c < 4; ++c) { const int j = lane + 64 * c; const float v = imp[q * 257 + j]; key[c] = (j >= 1 && j <= cur - 2) ? ((__float_as_uint(v) & 0xFFFFFF00u) | (unsigned)(255 - j)) : 0u; }
                int mypick = lane == 0 ? 0 : (lane == 1 ? cur - 1 : (lane == 2 ? cur : -1));
                for (int rd = 0; rd < 13; ++rd) {
                    unsigned m = key[0] > key[1] ? key[0] : key[1]; const unsigned m2 = key[2] > key[3] ? key[2] : key[3]; m = m > m2 ? m : m2;
                    const unsigned M = wave_umax(m); const int jsel = M ? 255 - (int)(M & 255u) : -1;
#pragma unroll
                    for (int c = 0; c < 4; ++c) if (key[c] == M) key[c] = 0u;
                    if (lane == 3 + rd) mypick = jsel;
                }
                if (lane < 16) idx[q * 16 + lane] = mypick;
            }
        }
    }
}

__device__ __forceinline__ void p5_selected(const Ctx& C) {
    const int gw = C.bid * 8 + C.wave, NWV = C.G * 8, lane = C.lane, i = lane & 15, g4 = lane >> 4;
    const float mb = WSP(float, WS_MISC)[64];
    for (int task = gw; task < 4 * S_; task += NWV) {
        const int bg = task / S_, tq = task % S_, b = bg >> 1, g = bg & 1; const size_t t = (size_t)b * S_ + tq;
        const int idxv = lane < 16 ? WSP(int, WS_IDX)[((size_t)bg * S_ + tq) * 16 + lane] : -1;
        QF qf;
        if (i < 4) qf = load_qf(WSP(bf16_t, WS_QR) + t * 1024 + (g * 4 + i) * 128, g4);
        else {
#pragma unroll
            for (int ks = 0; ks < 4; ++ks) qf.f[ks] = (bf16x8){0, 0, 0, 0, 0, 0, 0, 0}; }
        f32x4 O[8];
#pragma unroll
        for (int dt = 0; dt < 8; ++dt) O[dt] = (f32x4){0.f, 0.f, 0.f, 0.f};
        float l = 0.f;
        for (int k = 0; k < 16; ++k) { const int j = __builtin_amdgcn_readlane(idxv, k); if (j < 0) continue;
            attn_block<MODE_SEL>(qf, WSP(bf16_t, WS_KSEL) + ((size_t)bg * S_ + 64 * j) * 128, WSP(bf16_t, WS_VSELT) + ((size_t)bg * 256 + j) * 8192, O, l, i, g4, tq, 64 * j, C2_, mb); }
        l += __shfl_xor(l, 16); l += __shfl_xor(l, 32);
        if (i < 4) { const int h = g * 4 + i; const float sc = (l > 0.f ? 1.0f / l : 0.f) * WSP(float, WS_GATES)[t * 24 + h * 3 + 1];
            const float* ma = WSP(float, WS_MIXACC) + t * 1024 + h * 128 + 4 * g4; bf16_t* dst = WSP(bf16_t, WS_MIX) + t * D_ + 512 + h * 128 + 4 * g4;
#pragma unroll
            for (int dt = 0; dt < 8; ++dt) { const f32x4 v = *(const f32x4*)(ma + 16 * dt) + O[dt] * sc; u32x2 w; w.x = cvt_pk_bf16(v[0], v[1]); w.y = cvt_pk_bf16(v[2], v[3]); *(u32x2*)(dst + 16 * dt) = w; } }
    }
}
__device__ __forceinline__ int ta_swk(int r) { return (((r >> 3) & 3) << 2) | (r & 3); }
__device__ __forceinline__ void ta_issue(LAS unsigned char* lds, int bufi, const bf16_t* Kb, const bf16_t* Vb, int w, int lane, bool konly = false) {
    LAS unsigned char* kb = lds + bufi * 32768; LAS unsigned char* vb = kb + 16384;
#pragma unroll
    for (int q = 0; q < 2; ++q) { const int r = 8 * w + 4 * q + (lane >> 4), s = lane & 15;
        __builtin_amdgcn_global_load_lds((const unsigned*)(Kb + (size_t)r * 128 + ((s ^ ta_swk(r)) * 8)), (LAS unsigned*)(kb + (8 * w + 4 * q) * 256), 16, 0, 0); }
    if (konly) return;
#pragma unroll
    for (int q = 0; q < 2; ++q) { const int d = 16 * w + 8 * q + (lane >> 3), s = lane & 7;
        __builtin_amdgcn_global_load_lds((const unsigned*)(Vb + (size_t)d * 64 + ((s ^ ((d >> 1) & 7)) * 8)), (LAS unsigned*)(vb + (16 * w + 8 * q) * 128), 16, 0, 0); }
}
#define TA_SB __builtin_amdgcn_sched_barrier(0)
__device__ __forceinline__ void ta_ldk(LAS const unsigned char* kb, int kg, int i, int g4, bf16x8 (&a0)[4], bf16x8 (&a1)[4]) {
    LAS const unsigned char* kr = kb + (32 * kg + 8 * (i >> 2) + (i & 3)) * 256;
#pragma unroll
    for (int ks = 0; ks < 4; ++ks) { const int co = ((4 * ks + g4) ^ i) * 16; a0[ks] = *(LAS const bf16x8*)(kr + co); a1[ks] = *(LAS const bf16x8*)(kr + 4 * 256 + co); } }
__device__ __forceinline__ void ta_ldv(LAS const unsigned char* vb, int kg, int i, int g4, bf16x8 (&vt)[8]) {
    LAS const unsigned char* vr = vb + i * 128 + (((4 * kg + g4) ^ ((i >> 1) & 7)) * 16);
#pragma unroll
    for (int dt = 0; dt < 8; ++dt) vt[dt] = *(LAS const bf16x8*)(vr + dt * 16 * 128); }
__device__ __forceinline__ void ta_qk(const bf16x8 (&a0)[4], const bf16x8 (&a1)[4], const QF& q, f32x4& s0, f32x4& s1) {
    s0 = (f32x4){0.f, 0.f, 0.f, 0.f}; s1 = (f32x4){0.f, 0.f, 0.f, 0.f};
#pragma unroll
    for (int ks = 0; ks < 4; ++ks) { s0 = __builtin_amdgcn_mfma_f32_16x16x32_bf16(a0[ks], q.f[ks], s0, 0, 0, 0); s1 = __builtin_amdgcn_mfma_f32_16x16x32_bf16(a1[ks], q.f[ks], s1, 0, 0, 0); } }
template <int MODE, bool FULL = false> __device__ __forceinline__ bf16x8 ta_sm(const f32x4 s0, const f32x4 s1, float& l, int kg, int g4, int tq, bool colvalid, int kbase, float mb) {
    float p[8];
#pragma unroll
    for (int r = 0; r < 8; ++r) { const int key = kbase + 32 * kg + 8 * g4 + r; const float sv = r < 4 ? s0[r & 3] : s1[r & 3];
        bool valid = colvalid && (key <= tq);
        if (MODE == MODE_WIN) valid = valid && (key > tq - 512);
        if (MODE == MODE_NONE || FULL) valid = true;
        p[r] = valid ? __builtin_amdgcn_exp2f(sv * C2_ - mb) : 0.f; }
    l += ((p[0] + p[1]) + (p[2] + p[3])) + ((p[4] + p[5]) + (p[6] + p[7]));
    return pack8(p[0], p[1], p[2], p[3], p[4], p[5], p[6], p[7]); }
__device__ __forceinline__ void ta_pv(const bf16x8 (&vt)[8], const bf16x8 pf, f32x4 (&O)[8]) {
#pragma unroll
    for (int dt = 0; dt < 8; ++dt) O[dt] = __builtin_amdgcn_mfma_f32_16x16x32_bf16(vt[dt], pf, O[dt], 0, 0, 0); }
template <int MODE> __device__ __forceinline__ void ta_compute_pinned(LAS const unsigned char* kb, const QF& q, f32x4 (&O)[8], float& l, int i, int g4, int tq, bool colvalid, int kbase, float mb) {
    LAS const unsigned char* vb = kb + 16384;
    bf16x8 ka0[4], ka1[4], kb0[4], kb1[4], va[8], vc[8]; f32x4 s0, s1, t0, t1;
    ta_ldk(kb, 0, i, g4, ka0, ka1); TA_SB; ta_ldk(kb, 1, i, g4, kb0, kb1); TA_SB;
    ta_qk(ka0, ka1, q, s0, s1); TA_SB;
    ta_ldv(vb, 0, i, g4, va); TA_SB;
    ta_qk(kb0, kb1, q, t0, t1); TA_SB;
    const bf16x8 pf0 = ta_sm<MODE>(s0, s1, l, 0, g4, tq, colvalid, kbase, mb); TA_SB;
    ta_ldv(vb, 1, i, g4, vc); TA_SB;
    ta_pv(va, pf0, O); TA_SB;
    const bf16x8 pf1 = ta_sm<MODE>(t0, t1, l, 1, g4, tq, colvalid, kbase, mb); TA_SB;
    ta_pv(vc, pf1, O); TA_SB;
}
template <int MODE, bool FULL = false> __device__ __forceinline__ void ta_compute_plain(LAS const unsigned char* kb, const QF& q, f32x4 (&O)[8], float& l, int i, int g4, int tq, bool colvalid, int kbase, float mb) {
    LAS const unsigned char* vb = kb + 16384;
#pragma unroll
    for (int kg = 0; kg < 2; ++kg) {
        bf16x8 a0[4], a1[4], vt[8]; f32x4 s0, s1;
        ta_ldk(kb, kg, i, g4, a0, a1); ta_qk(a0, a1, q, s0, s1);
        const bf16x8 pf = ta_sm<MODE, FULL>(s0, s1, l, kg, g4, tq, colvalid, kbase, mb);
        ta_ldv(vb, kg, i, g4, vt); ta_pv(vt, pf, O);
    }
}
template <int MODE, bool FULL = false> __device__ __forceinline__ void ta_compute2(LAS const unsigned char* kb, const QF& q0, const QF& q1, f32x4 (&O0)[8], f32x4 (&O1)[8], float& l0, float& l1, int i, int g4, int tq0, int tq1, bool n0, bool n1, bool cv0, bool cv1, int kbase, float mb, bool full = false  ) {
    LAS const unsigned char* vb = kb + 16384;
    const float m0 = cv0 ? mb : 1e30f, m1 = cv1 ? mb : 1e30f;
    bf16x8 ka0[4], ka1[4], kb0[4], kb1[4], va[8], vc[8]; f32x4 s0, s1, t0, t1, u0, u1, v0, v1; bf16x8 pa0, pb0, pa1, pb1;
    ta_ldk(kb, 0, i, g4, ka0, ka1); ta_ldk(kb, 1, i, g4, kb0, kb1); TA_SB;
    if (n0) { ta_qk(ka0, ka1, q0, s0, s1); ta_qk(kb0, kb1, q0, t0, t1); } TA_SB;
    if (n1) { ta_qk(ka0, ka1, q1, u0, u1); ta_qk(kb0, kb1, q1, v0, v1); } TA_SB;
    ta_ldv(vb, 0, i, g4, va); TA_SB;
    if (n0) { if (full) { pa0 = ta_sm<MODE, true>(s0, s1, l0, 0, g4, tq0, true, kbase, m0); pb0 = ta_sm<MODE, true>(t0, t1, l0, 1, g4, tq0, true, kbase, m0); }
              else { pa0 = ta_sm<MODE, FULL>(s0, s1, l0, 0, g4, tq0, cv0, kbase, mb); pb0 = ta_sm<MODE, FULL>(t0, t1, l0, 1, g4, tq0, cv0, kbase, mb); } } TA_SB;
    if (n1) { if (full) { pa1 = ta_sm<MODE, true>(u0, u1, l1, 0, g4, tq1, true, kbase, m1); pb1 = ta_sm<MODE, true>(v0, v1, l1, 1, g4, tq1, true, kbase, m1); }
              else { pa1 = ta_sm<MODE, FULL>(u0, u1, l1, 0, g4, tq1, cv1, kbase, mb); pb1 = ta_sm<MODE, FULL>(v0, v1, l1, 1, g4, tq1, cv1, kbase, mb); } } TA_SB;
    ta_ldv(vb, 1, i, g4, vc); TA_SB;
    if (n0) { ta_pv(va, pa0, O0); ta_pv(vc, pb0, O0); } TA_SB;
    if (n1) { ta_pv(va, pa1, O1); ta_pv(vc, pb1, O1); } TA_SB;
}
template <int MODE> __device__ __forceinline__ void ta_compute(LAS const unsigned char* kb, const QF& q, f32x4 (&O)[8], float& l, int i, int g4, int tq, bool colvalid, int kbase, float mb) {
    if (MODE == MODE_SEL) ta_compute_pinned<MODE>(kb, q, O, l, i, g4, tq, colvalid, kbase, mb); else ta_compute_plain<MODE>(kb, q, O, l, i, g4, tq, colvalid, kbase, mb);
}
template <int MODE, int DRY = 0  > __device__ __forceinline__ void tile_attn_phase(const Ctx& C) {
    const int w = C.wave, lane = C.lane, i = lane & 15, g4 = lane >> 4, tid = C.tid;
    LAS unsigned char* lds = C.lds;
    LAS unsigned* MASK = (LAS unsigned*)(lds + 131072);
    LAS int* USED = (LAS int*)(lds + LDS_MISC + 512);
    LAS int* WCNT = (LAS int*)(lds + LDS_MISC + 512 + 1024);
    const float mb = WSP(float, WS_MISC)[64];
    const bf16_t* Kall = WSP(bf16_t, MODE == MODE_SEL ? WS_KSEL : WS_KWIN); const bf16_t* VTall = WSP(bf16_t, MODE == MODE_SEL ? WS_VSELT : WS_VWINT);
    constexpr int NT = 4 * 256;
    for (int it = C.bid; it < NT; it += C.G) {
        const int round = it / C.G, base = C.G * round, cntr = (NT - base) < C.G ? (NT - base) : C.G, off = it - base;
        const int tk = base + ((round & 1) ? cntr - 1 - off : off);
        const int qt = 255 - (tk >> 2), bg = tk & 3, b = bg >> 1, g = bg & 1, t0 = 64 * qt;
        int nblk, blo = 0;
        if (MODE == MODE_SEL) {
            for (int k = tid; k < 2048; k += 512) MASK[k] = 0u;
            __syncthreads();
            const int* idx = WSP(int, WS_IDX) + ((size_t)bg * S_ + t0) * 16;
#pragma unroll
            for (int e = tid; e < 1024; e += 512) { const int j = idx[e]; const int qq = e >> 4; if (j >= 0) __hip_atomic_fetch_or(MASK + j * 8 + (qq >> 3), 1u << (qq & 7), __ATOMIC_RELAXED, __HIP_MEMORY_SCOPE_WORKGROUP); }
            __syncthreads();
            bool any = false; unsigned long long bal = 0ull;
            if (tid < 256) { unsigned o = 0u;
#pragma unroll
                for (int k = 0; k < 8; ++k) o |= MASK[tid * 8 + k];
                any = o != 0u; bal = __ballot(any); if (lane == 0) WCNT[w] = __popcll(bal); }
            __syncthreads();
            if (tid < 256 && any) { int bs = 0;
#pragma unroll
                for (int k = 0; k < 4; ++k) bs += (k < w) ? WCNT[k] : 0;
                USED[bs + __popcll(bal & ((1ull << lane) - 1ull))] = tid; }
            nblk = WCNT[0] + WCNT[1] + WCNT[2] + WCNT[3];
            __syncthreads();
            if (32 * w < nblk) {
                const int cb = 32 * w, cn = (nblk - cb) < 32 ? (nblk - cb) : 32;
                const int id = lane < cn ? USED[cb + lane] : 0; unsigned h1 = 0u, h2 = 0u;
                { const u32x4 ma = *(LAS const u32x4*)(MASK + id * 8), mc = *(LAS const u32x4*)(MASK + id * 8 + 4);
#pragma unroll
                  for (int k = 0; k < 8; ++k) { const unsigned m = k < 4 ? ma[k & 3] : mc[k & 3]; const unsigned a = (m & 0x0Fu) ? 1u : 0u, c = (m & 0xF0u) ? 1u : 0u; h1 |= (a | c) << k; h2 |= (a & c) << k; } }
                unsigned long long alive = __ballot(lane < cn); int k = 0;
                while (alive) {
                    const int l1 = __builtin_ctzll(alive); alive &= alive - 1ull;
                    const unsigned a1 = __builtin_amdgcn_readlane(h1, l1), a2 = __builtin_amdgcn_readlane(h2, l1); const int id1 = __builtin_amdgcn_readlane(id, l1); int id2 = -1;
                    if (alive) {
                        const bool c4 = (h2 & a2) != 0u, c3 = ((h2 & a1) | (h1 & a2)) != 0u, c2 = ((h2 | a2) | (h1 & a1)) != 0u;
                        const unsigned long long m1 = __ballot(!c2) & alive, m2 = __ballot(!c3) & alive, m3 = __ballot(!c4) & alive;
                        const unsigned long long pick = m1 ? m1 : (m2 ? m2 : (m3 ? m3 : alive));
                        const int l2 = __builtin_ctzll(pick); alive &= ~(1ull << l2); id2 = __builtin_amdgcn_readlane(id, l2); }
                    if (lane == 0) { USED[cb + k] = id1; if (id2 >= 0) USED[cb + k + 1] = id2; }
                    k += 2; }
            }
            __syncthreads();
        } else { blo = (t0 - 511 > 0 ? t0 - 511 : 0) >> 6; nblk = qt - blo + 1; __syncthreads(); }
        const int tq0 = t0 + 8 * w + (i >> 2), tq1 = tq0 + 4; const size_t tt0 = (size_t)b * S_ + tq0, tt1 = tt0 + 4; const int hh = g * 4 + (i & 3);
        const QF q0 = load_qf(WSP(bf16_t, WS_QR) + tt0 * 1024 + hh * 128, g4), q1 = load_qf(WSP(bf16_t, WS_QR) + tt1 * 1024 + hh * 128, g4);
        f32x4 O0[8], O1[8]; float l0 = 0.f, l1 = 0.f;
#pragma unroll
        for (int dt = 0; dt < 8; ++dt) { O0[dt] = (f32x4){0.f, 0.f, 0.f, 0.f}; O1[dt] = (f32x4){0.f, 0.f, 0.f, 0.f}; }
        const bf16_t* Kbg = Kall + (size_t)bg * S_ * 128; const bf16_t* Vbg = VTall + (size_t)bg * 256 * 8192;
#define TA_BLK(n_) (MODE == MODE_SEL ? USED[n_] : blo + (n_))
#define TA_ISSUE(n_) do { if (DRY == 2) break; const int _j = TA_BLK(n_); ta_issue(lds, (n_) & 3, Kbg + (size_t)_j * 64 * 128, Vbg + (size_t)_j * 8192, w, lane); } while (0)
#define TA_DO(n_) do { if (DRY == 1) break; const int _j = TA_BLK(n_); const unsigned _m = MODE == MODE_SEL ? (unsigned)__builtin_amdgcn_readfirstlane((int)MASK[_j * 8 + w]) : 0xFFu; unsigned _ko = ((n_) & 3) * 32768; asm volatile("" : "+s"(_ko)); LAS const unsigned char* _kb = lds + _ko;   \
            if (_m) ta_compute2<MODE>(_kb, q0, q1, O0, O1, l0, l1, i, g4, tq0, tq1, (_m & 0x0Fu) != 0u, (_m & 0xF0u) != 0u, ((_m >> (i >> 2)) & 1u) != 0u, ((_m >> (4 + (i >> 2))) & 1u) != 0u, 64 * _j, mb, MODE == MODE_SEL ? _j < qt : (_j < qt && _j > qt - 8)); } while (0)
        if (MODE == MODE_SEL) {
            TA_ISSUE(0); if (nblk > 1) TA_ISSUE(1);
            for (int n = 0; n < nblk; n += 2) {
                asm volatile("s_waitcnt vmcnt(0)" ::: "memory"); __syncthreads();
                if (n + 2 < nblk) TA_ISSUE(n + 2);
                if (n + 3 < nblk) TA_ISSUE(n + 3);
                TA_DO(n);
                if (n + 1 < nblk) TA_DO(n + 1);
            }
        } else {
            TA_ISSUE(0);
            for (int n = 0; n < nblk; ++n) {
                asm volatile("s_waitcnt vmcnt(0)" ::: "memory"); __syncthreads();
                if (n + 1 < nblk) TA_ISSUE(n + 1);
                TA_DO(n);
            }
        }
#undef TA_ISSUE
#undef TA_DO
#undef TA_BLK
        l0 += __shfl_xor(l0, 16); l0 += __shfl_xor(l0, 32); l1 += __shfl_xor(l1, 16); l1 += __shfl_xor(l1, 32);
        const float* gates = WSP(float, WS_GATES);
        const float sc0 = (l0 > 0.f ? 1.0f / l0 : 0.f) * gates[tt0 * 24 + hh * 3 + (MODE == MODE_SEL ? 1 : 2)], sc1 = (l1 > 0.f ? 1.0f / l1 : 0.f) * gates[tt1 * 24 + hh * 3 + (MODE == MODE_SEL ? 1 : 2)];
        float* ma0 = WSP(float, WS_MIXACC) + tt0 * 1024 + hh * 128 + 4 * g4; float* ma1 = WSP(float, WS_MIXACC) + tt1 * 1024 + hh * 128 + 4 * g4;
        if (DRY) { asm volatile("" :: "v"(sc0), "v"(sc1));
#pragma unroll
            for (int dt = 0; dt < 8; ++dt) asm volatile("" :: "v"(O0[dt]), "v"(O1[dt]));
        } else if (MODE == MODE_SEL) {
            unsigned char* d0 = WSP(unsigned char, WS_MIX) + tt0 * MIXP + 1024 + hh * 128 + 4 * g4; unsigned char* d1 = WSP(unsigned char, WS_MIX) + tt1 * MIXP + 1024 + hh * 128 + 4 * g4;
#pragma unroll
            for (int dt = 0; dt < 8; ++dt) { const f32x4 v0 = (*(const f32x4*)(ma0 + 16 * dt) + O0[dt] * sc0) * MIX_SCALE, v1 = (*(const f32x4*)(ma1 + 16 * dt) + O1[dt] * sc1) * MIX_SCALE;
                *(unsigned*)(d0 + 16 * dt) = pk4_fp8(v0[0], v0[1], v0[2], v0[3]); *(unsigned*)(d1 + 16 * dt) = pk4_fp8(v1[0], v1[1], v1[2], v1[3]); }
        } else {
#pragma unroll
            for (int dt = 0; dt < 8; ++dt) { *(f32x4*)(ma0 + 16 * dt) = O0[dt] * sc0; *(f32x4*)(ma1 + 16 * dt) = O1[dt] * sc1; }
        }
        __syncthreads();
    }
}

template <int PASS, bool FULL = false> __device__ __forceinline__ bf16x8 cmp_sm(const f32x4 s0, const f32x4 s1, float& l, float mbi  , LAS float* improw, int kg, int i, int g4, int tq, int j, float mb) {
    float p[8];
#pragma unroll
    for (int r = 0; r < 8; ++r) { const int key = 64 * j + 32 * kg + 8 * g4 + r; const float sv = r < 4 ? s0[r & 3] : s1[r & 3];
        const float e = __builtin_amdgcn_exp2f(sv * C2_ - (PASS == 1 ? mb : mbi));
        p[r] = (FULL || 16 * key + 31 <= tq) ? e : 0.f; }
    if (PASS == 1) { l += ((p[0] + p[1]) + (p[2] + p[3])) + ((p[4] + p[5]) + (p[6] + p[7])); return (bf16x8){0, 0, 0, 0, 0, 0, 0, 0}; }
    float ia = 2.0f * (p[0] + p[1] + p[2]) + p[3], ib = p[3] + 2.0f * (p[4] + p[5] + p[6]) + p[7], ic = p[7];
    ia += dppf<0xB1>(ia); ia += dppf<0x4E>(ia); ib += dppf<0xB1>(ib); ib += dppf<0x4E>(ib); ic += dppf<0xB1>(ic); ic += dppf<0x4E>(ic);
    if ((i & 3) == 0) { LAS float* ip = improw + 16 * j + 8 * kg + 2 * g4;
        __hip_atomic_fetch_add(ip, ia, __ATOMIC_RELAXED, __HIP_MEMORY_SCOPE_WORKGROUP); __hip_atomic_fetch_add(ip + 1, ib, __ATOMIC_RELAXED, __HIP_MEMORY_SCOPE_WORKGROUP); __hip_atomic_fetch_add(ip + 2, ic, __ATOMIC_RELAXED, __HIP_MEMORY_SCOPE_WORKGROUP); }
    return pack8(p[0], p[1], p[2], p[3], p[4], p[5], p[6], p[7]);
}
template <int PASS> __device__ __forceinline__ void cmp_compute(LAS const unsigned char* kb, const QF& q, f32x4 (&O)[8], float& l, float inv, LAS float* improw, int i, int g4, int tq, int j, float mb) {
    LAS const unsigned char* vb = kb + 16384;
    bf16x8 ka0[4], ka1[4], kb0[4], kb1[4]; f32x4 s0, s1, t0, t1;
    ta_ldk(kb, 0, i, g4, ka0, ka1); TA_SB; ta_ldk(kb, 1, i, g4, kb0, kb1); TA_SB;
    ta_qk(ka0, ka1, q, s0, s1); TA_SB;
    if (PASS == 1) { ta_qk(kb0, kb1, q, t0, t1); TA_SB; (void)cmp_sm<1>(s0, s1, l, inv, improw, 0, i, g4, tq, j, mb); (void)cmp_sm<1>(t0, t1, l, inv, improw, 1, i, g4, tq, j, mb); TA_SB; }
    else { bf16x8 va[8], vc[8];
        ta_ldv(vb, 0, i, g4, va); TA_SB;
        ta_qk(kb0, kb1, q, t0, t1); TA_SB;
        const bf16x8 pf0 = cmp_sm<2>(s0, s1, l, inv, improw, 0, i, g4, tq, j, mb); TA_SB;
        ta_ldv(vb, 1, i, g4, vc); TA_SB;
        ta_pv(va, pf0, O); TA_SB;
        const bf16x8 pf1 = cmp_sm<2>(t0, t1, l, inv, improw, 1, i, g4, tq, j, mb); TA_SB;
        ta_pv(vc, pf1, O); TA_SB; }
}
template <int PASS> __device__ __forceinline__ void cmp_compute2(LAS const unsigned char* kb, const QF& q0, const QF& q1, f32x4 (&O0)[8], f32x4 (&O1)[8], float& l0, float& l1, float inv0, float inv1, LAS float* imp0, LAS float* imp1, int i, int g4, int tq0, int tq1, int j, float mb, bool full) {
    LAS const unsigned char* vb = kb + 16384;
    bf16x8 ka0[4], ka1[4], kb0[4], kb1[4]; f32x4 s0, s1, t0, t1, u0, u1, v0, v1;
    ta_ldk(kb, 0, i, g4, ka0, ka1); ta_ldk(kb, 1, i, g4, kb0, kb1); TA_SB;
    ta_qk(ka0, ka1, q0, s0, s1); ta_qk(kb0, kb1, q0, t0, t1); TA_SB;
    ta_qk(ka0, ka1, q1, u0, u1); ta_qk(kb0, kb1, q1, v0, v1); TA_SB;
    if (PASS == 1) {
        if (full) { (void)cmp_sm<1, true>(s0, s1, l0, inv0, imp0, 0, i, g4, tq0, j, mb); (void)cmp_sm<1, true>(t0, t1, l0, inv0, imp0, 1, i, g4, tq0, j, mb);
                    (void)cmp_sm<1, true>(u0, u1, l1, inv1, imp1, 0, i, g4, tq1, j, mb); (void)cmp_sm<1, true>(v0, v1, l1, inv1, imp1, 1, i, g4, tq1, j, mb); }
        else { (void)cmp_sm<1>(s0, s1, l0, inv0, imp0, 0, i, g4, tq0, j, mb); (void)cmp_sm<1>(t0, t1, l0, inv0, imp0, 1, i, g4, tq0, j, mb);
               (void)cmp_sm<1>(u0, u1, l1, inv1, imp1, 0, i, g4, tq1, j, mb); (void)cmp_sm<1>(v0, v1, l1, inv1, imp1, 1, i, g4, tq1, j, mb); }
        TA_SB; }
    else { bf16x8 va[8], vc[8], pa0, pb0, pa1, pb1;
        ta_ldv(vb, 0, i, g4, va); TA_SB;
        if (full) { pa0 = cmp_sm<2, true>(s0, s1, l0, inv0, imp0, 0, i, g4, tq0, j, mb); pb0 = cmp_sm<2, true>(t0, t1, l0, inv0, imp0, 1, i, g4, tq0, j, mb);
                    pa1 = cmp_sm<2, true>(u0, u1, l1, inv1, imp1, 0, i, g4, tq1, j, mb); pb1 = cmp_sm<2, true>(v0, v1, l1, inv1, imp1, 1, i, g4, tq1, j, mb); }
        else { pa0 = cmp_sm<2>(s0, s1, l0, inv0, imp0, 0, i, g4, tq0, j, mb); pb0 = cmp_sm<2>(t0, t1, l0, inv0, imp0, 1, i, g4, tq0, j, mb);
               pa1 = cmp_sm<2>(u0, u1, l1, inv1, imp1, 0, i, g4, tq1, j, mb); pb1 = cmp_sm<2>(v0, v1, l1, inv1, imp1, 1, i, g4, tq1, j, mb); }
        TA_SB;
        ta_ldv(vb, 1, i, g4, vc); TA_SB;
        ta_pv(va, pa0, O0); ta_pv(vc, pb0, O0); TA_SB;
        ta_pv(va, pa1, O1); ta_pv(vc, pb1, O1); TA_SB; }
}
__device__ __forceinline__ void p4_tiled(const Ctx& C, bool dry = false) {
    const int w = C.wave, lane = C.lane, i = lane & 15, g4 = lane >> 4, tid = C.tid;
    LAS unsigned char* lds = C.lds;
    LAS float* IMP = (LAS float*)(lds + 65536);
    const float mb = WSP(float, WS_MISC)[64];
    constexpr int NT = 4 * 256;
    for (int it = C.bid; it < NT; it += C.G) {
        const int round = it / C.G, base = C.G * round, cntr = (NT - base) < C.G ? (NT - base) : C.G, off = it - base;
        const int tk = base + ((round & 1) ? cntr - 1 - off : off);
        const int qt = 255 - (tk >> 2), bg = tk & 3, b = bg >> 1, g = bg & 1, t0 = 64 * qt;
        const int nvis = (4 * qt + 3) < 1023 ? (4 * qt + 3) : 1023, nb = (nvis + 63) >> 6;
        for (int k = tid; k < 64 * 257; k += 512) IMP[k] = 0.f;
        const int tq0 = t0 + 8 * w + (i >> 2), tq1 = tq0 + 4; const size_t tt0 = (size_t)b * S_ + tq0, tt1 = tt0 + 4; const int hh = g * 4 + (i & 3);
        const QF q0 = load_qf(WSP(bf16_t, WS_QN) + tt0 * 1024 + hh * 128, g4), q1 = load_qf(WSP(bf16_t, WS_QN) + tt1 * 1024 + hh * 128, g4);
        f32x4 O0[8], O1[8]; float l0 = 0.f, l1 = 0.f;
#pragma unroll
        for (int dt = 0; dt < 8; ++dt) { O0[dt] = (f32x4){0.f, 0.f, 0.f, 0.f}; O1[dt] = (f32x4){0.f, 0.f, 0.f, 0.f}; }
        const bf16_t* Kbg = WSP(bf16_t, WS_KC) + (size_t)bg * 1024 * 128; const bf16_t* Vbg = WSP(bf16_t, WS_VCT) + (size_t)bg * 16 * 8192;
        LAS float* imp0 = IMP + (8 * w + (i >> 2)) * 257; LAS float* imp1 = imp0 + 4 * 257;
        __syncthreads();
        ta_issue(lds, 0, Kbg, Vbg, w, lane, true);
        for (int n = 0; n < nb; ++n) {
            asm volatile("s_waitcnt vmcnt(0)" ::: "memory"); __syncthreads();
            if (n + 1 < nb) ta_issue(lds, (n + 1) & 1, Kbg + (size_t)(n + 1) * 64 * 128, Vbg + (size_t)(n + 1) * 8192, w, lane, true);
            LAS const unsigned char* kb = lds + (n & 1) * 32768;
#ifdef MK_P4NOCOMP
            if (!dry)
#endif
            cmp_compute2<1>(kb, q0, q1, O0, O1, l0, l1, 0.f, 0.f, imp0, imp1, i, g4, tq0, tq1, n, mb, 1024 * n + 1039 <= t0);
        }
        l0 += __shfl_xor(l0, 16); l0 += __shfl_xor(l0, 32); l1 += __shfl_xor(l1, 16); l1 += __shfl_xor(l1, 32);
        const float mbi0 = l0 > 0.f ? mb + __builtin_amdgcn_logf(l0) : 1e30f, mbi1 = l1 > 0.f ? mb + __builtin_amdgcn_logf(l1) : 1e30f;
        __syncthreads();
        ta_issue(lds, 0, Kbg, Vbg, w, lane);
        for (int n = 0; n < nb; ++n) {
            asm volatile("s_waitcnt vmcnt(0)" ::: "memory"); __syncthreads();
            if (n + 1 < nb) ta_issue(lds, (n + 1) & 1, Kbg + (size_t)(n + 1) * 64 * 128, Vbg + (size_t)(n + 1) * 8192, w, lane);
            LAS const unsigned char* kb = lds + (n & 1) * 32768;
#ifdef MK_P4NOCOMP
            if (!dry)
#endif
            cmp_compute2<2>(kb, q0, q1, O0, O1, l0, l1, mbi0, mbi1, imp0, imp1, i, g4, tq0, tq1, n, mb, 1024 * n + 1039 <= t0);
        }
        { const float* gates = WSP(float, WS_GATES); const float gc0 = gates[tt0 * 24 + hh * 3 + 0], gc1 = gates[tt1 * 24 + hh * 3 + 0];
          float* ma0 = WSP(float, WS_MIXACC) + tt0 * 1024 + hh * 128 + 4 * g4; float* ma1 = WSP(float, WS_MIXACC) + tt1 * 1024 + hh * 128 + 4 * g4;
#pragma unroll
          for (int dt = 0; dt < 8; ++dt) { const f32x4 v0 = *(const f32x4*)(ma0 + 16 * dt) + O0[dt] * gc0, v1 = *(const f32x4*)(ma1 + 16 * dt) + O1[dt] * gc1; if (!dry) { *(f32x4*)(ma0 + 16 * dt) = v0; *(f32x4*)(ma1 + 16 * dt) = v1; } else { asm volatile("" :: "v"(v0), "v"(v1)); } } }
        __syncthreads();
        const int cur = qt; int* idx = WSP(int, WS_IDX) + ((size_t)bg * S_ + t0 + 8 * w) * 16;
        if (cur <= 15) { for (int q = 0; q < 8; ++q) if (lane < 16) idx[q * 16 + lane] = lane <= cur ? lane : -1; }
        else {
            for (int q0 = 0; q0 < 8; q0 += 2) {
                unsigned key[2][4]; int mypick[2];
#pragma unroll
                for (int u = 0; u < 2; ++u) {
#pragma unroll
                    for (int c = 0; c < 4; ++c) { const int j = lane + 64 * c; const float v = IMP[(8 * w + q0 + u) * 257 + j]; key[u][c] = (j >= 1 && j <= cur - 2) ? ((__float_as_uint(v) & 0xFFFFFF00u) | (unsigned)(255 - j)) : 0u; }
#define SEL_CS(a_, b_) do { const unsigned _h = key[u][a_] > key[u][b_] ? key[u][a_] : key[u][b_], _l = key[u][a_] > key[u][b_] ? key[u][b_] : key[u][a_]; key[u][a_] = _h; key[u][b_] = _l; } while (0)
                    SEL_CS(0, 1); SEL_CS(2, 3); SEL_CS(0, 2); SEL_CS(1, 3); SEL_CS(1, 2);
#undef SEL_CS
                    mypick[u] = lane == 0 ? 0 : (lane == 1 ? cur - 1 : (lane == 2 ? cur : -1)); }
                for (int rd = 0; rd < 13; ++rd) {
#pragma unroll
                    for (int u = 0; u < 2; ++u) {
                        const unsigned M = wave_umax63(key[u][0]); const int jsel = M ? 255 - (int)(M & 255u) : -1;
                        const bool hit = key[u][0] == M && M != 0u;
                        key[u][0] = hit ? key[u][1] : key[u][0]; key[u][1] = hit ? key[u][2] : key[u][1]; key[u][2] = hit ? key[u][3] : key[u][2]; key[u][3] = hit ? 0u : key[u][3];
                        if (lane == 3 + rd) mypick[u] = jsel; }
                }
#pragma unroll
                for (int u = 0; u < 2; ++u) if (lane < 16) idx[(q0 + u) * 16 + lane] = mypick[u];
            }
        }
        __syncthreads();
    }
}

__device__ __forceinline__ void xattn_tiled(const Ctx& C) {
    const int w = C.wave, lane = C.lane, i = lane & 15, g4 = lane >> 4;
    LAS unsigned char* lds = C.lds;
    const float mb = WSP(float, WS_MISC)[65];
    for (int tile = C.bid; tile < NB * 4 * (S_ / 256); tile += C.G) {
        const int qb = tile & 63, hx = (tile >> 6) & 3, b = tile >> 8;
        const bf16_t* Kb = WSP(bf16_t, WS_KX) + (size_t)(b * 4 + hx) * 256 * 128; const bf16_t* Vb = WSP(bf16_t, WS_VXT) + (size_t)(b * 4 + hx) * 4 * 8192;
        __syncthreads();
#pragma unroll
        for (int n = 0; n < 4; ++n) ta_issue(lds, n, Kb + (size_t)n * 64 * 128, Vb + (size_t)n * 8192, w, lane);
        const size_t t0 = (size_t)b * S_ + qb * 256 + 32 * w + i, t1 = t0 + 16;
        const QF q0 = load_qf(WSP(bf16_t, WS_QX) + t0 * 512 + hx * 128, g4), q1 = load_qf(WSP(bf16_t, WS_QX) + t1 * 512 + hx * 128, g4);
        f32x4 O0[8], O1[8]; float l0 = 0.f, l1 = 0.f;
#pragma unroll
        for (int dt = 0; dt < 8; ++dt) { O0[dt] = (f32x4){0.f, 0.f, 0.f, 0.f}; O1[dt] = (f32x4){0.f, 0.f, 0.f, 0.f}; }
        asm volatile("s_waitcnt vmcnt(0)" ::: "memory"); __syncthreads();
        for (int n = 0; n < 4; ++n) { unsigned ko = n * 32768; asm volatile("" : "+s"(ko)); LAS const unsigned char* kb = lds + ko;
            ta_compute2<MODE_NONE>(kb, q0, q1, O0, O1, l0, l1, i, g4, 0, 0, true, true, true, true, 64 * n, mb); }
        l0 += __shfl_xor(l0, 16); l0 += __shfl_xor(l0, 32); l1 += __shfl_xor(l1, 16); l1 += __shfl_xor(l1, 32);
        const float sc0 = l0 > 0.f ? 1.0f / l0 : 0.f, sc1 = l1 > 0.f ? 1.0f / l1 : 0.f;
        unsigned char* d0 = WSP(unsigned char, WS_MIX) + t0 * MIXP + 2048 + hx * 128 + 4 * g4; unsigned char* d1 = WSP(unsigned char, WS_MIX) + t1 * MIXP + 2048 + hx * 128 + 4 * g4;
        const float z0 = sc0 * MIX_SCALE, z1 = sc1 * MIX_SCALE;
#pragma unroll
        for (int dt = 0; dt < 8; ++dt) { *(unsigned*)(d0 + 16 * dt) = pk4_fp8(O0[dt][0] * z0, O0[dt][1] * z0, O0[dt][2] * z0, O0[dt][3] * z0);
            *(unsigned*)(d1 + 16 * dt) = pk4_fp8(O1[dt][0] * z1, O1[dt][1] * z1, O1[dt][2] * z1, O1[dt][3] * z1); }
    }
    __syncthreads();
}
__device__ __forceinline__ void p7_ffn_prep(const Ctx& C, bool dummy = false) {
    const int lane = C.lane, i = lane & 15, g4 = lane >> 4;
    LAS int* cnt = (LAS int*)C.lds; LAS int* basew = (LAS int*)(C.lds + 128); LAS float* lg = (LAS float*)(C.lds + 1024 + C.wave * 2112);
    const bf16_t* WRH = WSP(bf16_t, WS_WRH); const bf16_t* WRL = WSP(bf16_t, WS_WRL);
    unsigned* gcount = (unsigned*)WSP(unsigned, WS_CTL) + CW_GCOUNT + (dummy ? 64 : 0);
    const size_t lofs = dummy ? (WS_PROJ - WS_LIST) / 4 : 0;
    for (int u = C.bid; u < T_ / 128; u += C.G) {
        if (C.tid < 32) cnt[C.tid] = 0;
        __syncthreads();
        const int row = u * 128 + C.wave * 16 + i;
        float ssq = 0.f; { const f32x4* rp = (const f32x4*)(WSP(float, WS_ROWSS) + (size_t)row * 32);
#pragma unroll
          for (int k = 0; k < 8; ++k) { const f32x4 v = rp[k]; ssq += (v[0] + v[1]) + (v[2] + v[3]); } }
        const float rstd = rsqrtf(ssq * (1.0f / D_) + EPS);
        const _Float16* __restrict__ x1 = WSP(_Float16, WS_X1H) + (size_t)row * D_ + 8 * g4; const float* fg = C.ka->in[I_FFG] + 8 * g4; unsigned char* __restrict__ h2 = WSP(unsigned char, WS_H) + (size_t)row * D_ + 8 * g4;
        f32x4 a0 = {0.f, 0.f, 0.f, 0.f}, a1 = {0.f, 0.f, 0.f, 0.f};
        const int rot = ((C.bid >> 3) * 2 + (C.bid & 1)) & 63;
#define P7_RC(c_) (((c_) + rot) & 63)
        f16x8 xq[4];
#pragma unroll
        for (int d = 0; d < 4; ++d) xq[d] = *(const f16x8*)(x1 + 32 * P7_RC(d));
        bf16x8 b0hN = *(const bf16x8*)(WRH + (size_t)i * D_ + 32 * rot + 8 * g4), b1hN = *(const bf16x8*)(WRH + (size_t)(i + 16) * D_ + 32 * rot + 8 * g4), b0lN = *(const bf16x8*)(WRL + (size_t)i * D_ + 32 * rot + 8 * g4), b1lN = *(const bf16x8*)(WRL + (size_t)(i + 16) * D_ + 32 * rot + 8 * g4);
        for (int c4 = 0; c4 < 64; c4 += 4) {
#pragma unroll
          for (int d = 0; d < 4; ++d) { const int cl = c4 + d, c = P7_RC(cl);
            const f32x8 xf = __builtin_convertvector(xq[d], f32x8); const f32x4 xa = {xf[0], xf[1], xf[2], xf[3]}, xb = {xf[4], xf[5], xf[6], xf[7]}, ga = *(const f32x4*)(fg + 32 * c), gb = *(const f32x4*)(fg + 32 * c + 4);
            const bf16x8 b0h = b0hN, b1h = b1hN, b0l = b0lN, b1l = b1lN;
            { const int cx = P7_RC(cl + 4 < 64 ? cl + 4 : 63); xq[d] = *(const f16x8*)(x1 + 32 * cx);
              const int cn = P7_RC(cl < 63 ? cl + 1 : cl); const size_t bn = (size_t)i * D_ + 32 * cn + 8 * g4;
              b0hN = *(const bf16x8*)(WRH + bn); b1hN = *(const bf16x8*)(WRH + bn + (size_t)16 * D_); b0lN = *(const bf16x8*)(WRL + bn); b1lN = *(const bf16x8*)(WRL + bn + (size_t)16 * D_); }
            float h[8]; h[0] = xa[0] * ga[0] * rstd; h[1] = xa[1] * ga[1] * rstd; h[2] = xa[2] * ga[2] * rstd; h[3] = xa[3] * ga[3] * rstd; h[4] = xb[0] * gb[0] * rstd; h[5] = xb[1] * gb[1] * rstd; h[6] = xb[2] * gb[2] * rstd; h[7] = xb[3] * gb[3] * rstd;
            u32x4 hi; hi.x = cvt_pk_bf16(h[0], h[1]); hi.y = cvt_pk_bf16(h[2], h[3]); hi.z = cvt_pk_bf16(h[4], h[5]); hi.w = cvt_pk_bf16(h[6], h[7]);
            { u32x2 w8; w8.x = pk4_fp8(h[0], h[1], h[2], h[3]); w8.y = pk4_fp8(h[4], h[5], h[6], h[7]); *(u32x2*)(h2 + 32 * c) = w8; }
            u32x4 lo; lo.x = cvt_pk_bf16(h[0] - __uint_as_float(hi.x << 16), h[1] - __uint_as_float(hi.x & 0xFFFF0000u)); lo.y = cvt_pk_bf16(h[2] - __uint_as_float(hi.y << 16), h[3] - __uint_as_float(hi.y & 0xFFFF0000u));
            lo.z = cvt_pk_bf16(h[4] - __uint_as_float(hi.z << 16), h[5] - __uint_as_float(hi.z & 0xFFFF0000u)); lo.w = cvt_pk_bf16(h[6] - __uint_as_float(hi.w << 16), h[7] - __uint_as_float(hi.w & 0xFFFF0000u));
            const bf16x8 ah = __builtin_bit_cast(bf16x8, hi), al = __builtin_bit_cast(bf16x8, lo);
            a0 = __builtin_amdgcn_mfma_f32_16x16x32_bf16(ah, b0h, a0, 0, 0, 0); a0 = __builtin_amdgcn_mfma_f32_16x16x32_bf16(ah, b0l, a0, 0, 0, 0); a0 = __builtin_amdgcn_mfma_f32_16x16x32_bf16(al, b0h, a0, 0, 0, 0);
            a1 = __builtin_amdgcn_mfma_f32_16x16x32_bf16(ah, b1h, a1, 0, 0, 0); a1 = __builtin_amdgcn_mfma_f32_16x16x32_bf16(ah, b1l, a1, 0, 0, 0); a1 = __builtin_amdgcn_mfma_f32_16x16x32_bf16(al, b1h, a1, 0, 0, 0);
          }
        }
#pragma unroll
        for (int r = 0; r < 4; ++r) { lg[(4 * g4 + r) * 33 + i] = a0[r]; lg[(4 * g4 + r) * 33 + 16 + i] = a1[r]; }
        int e4[4] = {0, 0, 0, 0}, rk[4] = {0, 0, 0, 0}; float gk[4] = {0.f, 0.f, 0.f, 0.f}; const int tokrow = u * 128 + C.wave * 16 + lane;
        if (lane < 16) {
            float v[32];
#pragma unroll
            for (int e = 0; e < 32; ++e) v[e] = lg[lane * 33 + e] + C.ka->in[I_BR][e];
            float tv[4];
#pragma unroll
            for (int k = 0; k < 4; ++k) { float best = -__builtin_inff(); int be = 0;
#pragma unroll
                for (int e = 0; e < 32; ++e) { const bool taken = (k > 0 && e == e4[0]) || (k > 1 && e == e4[1]) || (k > 2 && e == e4[2]); if (!taken && v[e] > best) { best = v[e]; be = e; } }
                e4[k] = be; tv[k] = best; }
            const float p1 = __expf(tv[1] - tv[0]), p2 = __expf(tv[2] - tv[0]), p3 = __expf(tv[3] - tv[0]); const float inv = 1.0f / (1.0f + p1 + p2 + p3);
            gk[0] = inv; gk[1] = p1 * inv; gk[2] = p2 * inv; gk[3] = p3 * inv;
#pragma unroll
            for (int k = 0; k < 4; ++k) rk[k] = __hip_atomic_fetch_add(cnt + e4[k], 1, __ATOMIC_RELAXED, __HIP_MEMORY_SCOPE_WORKGROUP);
        }
        __syncthreads();
        if (C.tid < 32) basew[C.tid] = (int)__hip_atomic_fetch_add(gcount + C.tid, (unsigned)cnt[C.tid], __ATOMIC_RELAXED, __HIP_MEMORY_SCOPE_AGENT);
        __syncthreads();
        if (lane < 16) {
#pragma unroll
            for (int k = 0; k < 4; ++k) { const size_t li = (size_t)e4[k] * LIST_CAP + basew[e4[k]] + rk[k] + lofs; WSP(int, WS_LIST)[li] = tokrow * 4 + k; WSP(float, WS_LGATE)[li] = gk[k]; } }
        __syncthreads();
    }
}
__device__ __forceinline__ void moe_tables(const Ctx& C, LAS int* tb) {
    if (C.tid < 64) { const unsigned* gcount = (const unsigned*)WSP(unsigned, WS_CTL) + CW_GCOUNT; const int e = C.tid & 31;
        const int c = (int)__hip_atomic_load(gcount + e, __ATOMIC_RELAXED, __HIP_MEMORY_SCOPE_AGENT); const int tiles = (c + 255) >> 8; int incl = tiles;
#pragma unroll
        for (int o = 1; o < 32; o <<= 1) { const int v = __shfl_up(incl, o, 32); if (e >= o) incl += v; }
        if (C.tid < 32) { tb[e] = incl - tiles; tb[33 + e] = c; if (e == 31) tb[32] = incl; } }
    __syncthreads();
}
__device__ __forceinline__ void p10_combine(const Ctx& C, float* dstbase) {
    const size_t gt = (size_t)C.bid * 512 + C.tid, GT = (size_t)C.G * 512; const unsigned char* __restrict__ Y = WSP(unsigned char, WS_Y);
    const _Float16* src = WSP(_Float16, WS_X1H);
    for (size_t idx0 = gt; idx0 < (size_t)T_ * 256; idx0 += 2 * GT) {
        f16x8 xh[2]; u32x2 y[2][4]; bool ok[2];
#pragma unroll
        for (int u = 0; u < 2; ++u) { const size_t idx = idx0 + u * GT; ok[u] = idx < (size_t)T_ * 256; const size_t t = ok[u] ? idx >> 8 : 0; const int c8 = (int)(idx & 255) * 8;
            xh[u] = *(const f16x8*)(src + t * D_ + c8);
#pragma unroll
            for (int k = 0; k < 4; ++k) y[u][k] = *(const u32x2*)(Y + (t * 4 + k) * D_ + c8); }
#pragma unroll
        for (int u = 0; u < 2; ++u) { const size_t idx = idx0 + u * GT; const size_t t = idx >> 8; const int c8 = (int)(idx & 255) * 8; f32x4 sa = {0.f, 0.f, 0.f, 0.f}, sb = {0.f, 0.f, 0.f, 0.f};
#pragma unroll
            for (int k = 0; k < 4; ++k) { const f32x2 y0 = __builtin_amdgcn_cvt_pk_f32_fp8((int)y[u][k].x, false), y1 = __builtin_amdgcn_cvt_pk_f32_fp8((int)y[u][k].x, true), y2 = __builtin_amdgcn_cvt_pk_f32_fp8((int)y[u][k].y, false), y3 = __builtin_amdgcn_cvt_pk_f32_fp8((int)y[u][k].y, true);
                sa[0] += y0.x; sa[1] += y0.y; sa[2] += y1.x; sa[3] += y1.y; sb[0] += y2.x; sb[1] += y2.y; sb[2] += y3.x; sb[3] += y3.y; }
            if (ok[u]) { float* d = dstbase + t * D_ + c8; const f32x8 xf = __builtin_convertvector(xh[u], f32x8); const f32x4 a = {xf[0], xf[1], xf[2], xf[3]}, b = {xf[4], xf[5], xf[6], xf[7]};
                *(f32x4*)d = a + sa * (1.0f / Y_FP8_SCALE); *(f32x4*)(d + 4) = b + sb * (1.0f / Y_FP8_SCALE); } }
    }
}

__device__ __forceinline__ void fresh_tid(Ctx& C) { int t = threadIdx.x; asm volatile("" : "+v"(t)); C.tid = t; C.lane = t & 63; const Args* k = C.ka; asm volatile("" : "+s"(k)); C.ka = k; }
constexpr int N_PHASES = 11;
#ifndef MK_REPEAT
#define MK_REPEAT 0
#endif
#define REP(k) if ((MK_REPEAT >> (k)) & 1)
#ifndef E2_TAIL
#define E2_TAIL 11
#endif
__global__ void __launch_bounds__(512, 2) mk_fwd(Args args) {
    extern __shared__ __attribute__((aligned(16))) unsigned char lds_raw[];
    Ctx C;
    C.ka = (const Args*)__builtin_amdgcn_kernarg_segment_ptr();
    C.out = args.out; C.ws = args.ws; C.lds = (LAS unsigned char*)lds_raw; C.tid = threadIdx.x; C.lane = C.tid & 63; C.wave = __builtin_amdgcn_readfirstlane(C.tid >> 6); C.G = gridDim.x; C.bid = blockIdx.x;
    volatile LAS unsigned* misc = (volatile LAS unsigned*)(C.lds + LDS_MISC);
    if (C.tid < 4) misc[C.tid] = 0u;
    __syncthreads();
    const int lo = args.ph_lo, hi = args.ph_hi;
    XcdBarrier bar; bar.bar = WSP(unsigned, WS_CTL) + CW_BAR; bar.x = 0; bar.st = misc;
    if (hi - lo > 1) bar = xcd_barrier_post(WSP(unsigned, WS_CTL) + CW_BAR, misc);
#define IN(k) (fresh_tid(C), lo <= (k) && (k) < hi)
#define SEAM(k) do { if (IN(k) && IN((k) + 1)) xcd_barrier(bar); } while (0)
    LAS int* tb = (LAS int*)(C.lds + LDS_MISC + 64);
    if (IN(0)) { p0_prologue(C); REP(0) { xcd_barrier(bar); p0_prologue(C); } } SEAM(0);
    if (IN(1)) for (int rep_ = 0; rep_ < 1 + ((MK_REPEAT >> 1) & 1); ++rep_) { if (rep_) xcd_barrier(bar);
        const int nconv = (C.G % 8 == 0 && C.G >= 64) ? ((C.G * 3 / 8) & ~7) : 0, Gg = C.G - nconv;
        if (nconv == 0 || C.bid >= Gg) { const int cb = nconv ? C.bid - Gg : C.bid, cg = nconv ? nconv : C.G;
#ifdef MK_CONV2
            for (int r2 = 0; r2 < MK_CONV2; ++r2) { tjob_deep<2048, 4096, 2>(C, cb, cg, C.ka->in[I_WE1], C.ws + WS_W1T, NEXP); tjob_deep<2048, 2048, 0>(C, cb, cg, C.ka->in[I_WE2], C.ws + WS_W2T, NEXP); }
#endif
            tjob_deep<2048, 4096, 2>(C, cb, cg, C.ka->in[I_WE1], C.ws + WS_W1T, NEXP); tjob_deep<2048, 2048, 0>(C, cb, cg, C.ka->in[I_WE2], C.ws + WS_W2T, nconv ? NEXP - E2_TAIL : NEXP); }
        if (nconv == 0 || C.bid < Gg)
#ifdef MK_GEMM2
        for (int r3 = 0; r3 < 2; ++r3)
#endif
        {
        { pg8::Gemm g{WSP(bf16_t, WS_H8), WSP(bf16_t, WS_WIN8), T_, 3328, D_ / 2}; pg8::StaticOrder S; S.init(T_, 3328, Gg, C.bid); pg8::EpiBf16 E{WSP(bf16_t, WS_PROJ), NPROJ, 1024, 1.0f / W_FP8_SCALE};
          pg8::gemm_phase<pg8::EpiBf16, pg8::StaticOrder, false, true>(C.lds, g, S, E); }
        { pg8::Gemm g{WSP(bf16_t, WS_H), WSP(bf16_t, WS_WIN), T_, 1024, D_}; pg8::StaticOrder S; S.init(T_, 1024, Gg, C.bid); pg8::EpiBf16 E{WSP(bf16_t, WS_PROJ), NPROJ, 0, 1.0f};
          pg8::gemm_phase<pg8::EpiBf16, pg8::StaticOrder, false>(C.lds, g, S, E); }
        { pg8::Gemm g{WSP(bf16_t, WS_MEMN), WSP(bf16_t, WS_WKV), NB * MEMT, 1024, D_ / 2}; pg8::StaticOrder S; S.init(NB * MEMT, 1024, Gg, Gg >= 128 ? C.bid - 64 : C.bid); pg8::EpiBf16 E{WSP(bf16_t, WS_MEMKV), 1024, 0, 1.0f / W_FP8_SCALE};
          pg8::gemm_phase<pg8::EpiBf16, pg8::StaticOrder, false, true>(C.lds, g, S, E); }
        fresh_tid(C); if (nconv) tjob_deep<2048, 2048, 0>(C, C.bid, Gg, C.ka->in[I_WE2] + (size_t)(NEXP - E2_TAIL) * FF * D_, C.ws + WS_W2T + (size_t)(NEXP - E2_TAIL) * FF * D_, E2_TAIL);
        }
    } SEAM(1);
    if (IN(2)) { p2_token_prep(C); REP(2) { xcd_barrier(bar); p2_token_prep(C); } } SEAM(2);
    if (IN(3)) { tile_attn_phase<MODE_WIN>(C); REP(3) { tile_attn_phase<MODE_WIN>(C); } fresh_tid(C); for (int rep_ = 0; rep_ < 1 + ((MK_REPEAT >> 13) & 1); ++rep_) xattn_tiled(C); fresh_tid(C); p3_tasks(C); REP(4) { xcd_barrier(bar); p3_tasks(C); } } SEAM(3);
    if (IN(4)) { REP(11) { p4_tiled(C, true); xcd_barrier(bar); } p4_tiled(C); } SEAM(4);
    if (IN(5)) { tile_attn_phase<MODE_SEL>(C); REP(5) { xcd_barrier(bar);
#ifdef MK_SELDRY
            tile_attn_phase<MODE_SEL, MK_SELDRY>(C);
#else
            tile_attn_phase<MODE_SEL>(C);
#endif
        } } SEAM(5);
    if (IN(6)) for (int rep_ = ((MK_REPEAT >> 6) & 1) ? 0 : 1; rep_ < 2; ++rep_) { pg8::Gemm g{WSP(bf16_t, WS_MIX), WSP(bf16_t, WS_WOUT), T_, D_, MIXP / 2}; pg8::StaticOrder S; S.init(T_, D_, C.G, C.bid); pg8::EpiResF32 E{C.ka, C.ws, D_, rep_ ? WS_ROWSS : WS_PROJ, 1.0f / (MIX_SCALE * W_FP8_SCALE)};
        pg8::gemm_phase<pg8::EpiResF32, pg8::StaticOrder, false, 2>(C.lds, g, S, E); if (!rep_) xcd_barrier(bar); } SEAM(6);
    if (IN(7)) { REP(7) { p7_ffn_prep(C, true); xcd_barrier(bar); } p7_ffn_prep(C); } SEAM(7);
    if (IN(8)) for (int rep_ = 0; rep_ < 1 + ((MK_REPEAT >> 8) & 1); ++rep_) { if (rep_) xcd_barrier(bar); moe_tables(C, tb); pg8::Gemm g{WSP(bf16_t, WS_H), WSP(bf16_t, WS_W1T), 0, 4096, D_ / 2};   pg8::MoeOrder S; S.init_moe(16, C.G, C.bid, tb, C.ws, (LAS int*)(C.lds + LDS_MISC + 2048));
        pg8::EpiGlu E{C.ws};
        pg8::gemm_phase<pg8::EpiGlu, pg8::MoeOrder, true, true>(C.lds, g, S, E); } SEAM(8);
    if (IN(9)) for (int rep_ = 0; rep_ < 1 + ((MK_REPEAT >> 9) & 1); ++rep_) { if (rep_) xcd_barrier(bar); moe_tables(C, tb); pg8::Gemm g{WSP(bf16_t, WS_ACT), WSP(bf16_t, WS_W2T), 0, D_, FF / 2}; pg8::MoeOrder S; S.init_moe(8, C.G, C.bid, tb, C.ws, (LAS int*)(C.lds + LDS_MISC + 2048));
        pg8::EpiScatter E{C.ws, C.ka};
        pg8::gemm_phase<pg8::EpiScatter, pg8::MoeOrder, false, true>(C.lds, g, S, E); } SEAM(9);
    if (IN(10)) { REP(10) { p10_combine(C, WSP(float, WS_PROJ)); xcd_barrier(bar); } p10_combine(C, C.out); }
#undef IN
#undef SEAM
}

extern "C" void kernel_launch(void* const* d_in, const int* in_sizes, int n_in, void* d_out, int out_size, void* d_ws, size_t ws_size, hipStream_t stream) {
    static int grid = 0;
    if (grid == 0) {
        if (n_in != 27 || out_size != T_ * D_ || ws_size < WS_END) { fprintf(stderr, "kernel_launch: unexpected shapes (n_in %d, out %d, ws %zu < %zu)\n", n_in, out_size, ws_size, (size_t)WS_END); grid = -1; return; }
        int dev = 0, cus = 0, per_cu = 0;
        if (hipGetDevice(&dev) != hipSuccess || hipDeviceGetAttribute(&cus, hipDeviceAttributeMultiprocessorCount, dev) != hipSuccess) { grid = -1; return; }
        if (hipFuncSetAttribute((const void*)mk_fwd, hipFuncAttributeMaxDynamicSharedMemorySize, LDS_BYTES) != hipSuccess) { fprintf(stderr, "kernel_launch: hipFuncSetAttribute failed\n"); grid = -1; return; }
        if (hipOccupancyMaxActiveBlocksPerMultiprocessor(&per_cu, (const void*)mk_fwd, 512, LDS_BYTES) != hipSuccess || per_cu < 1) fprintf(stderr, "kernel_launch: occupancy query reports %d\n", per_cu);
        (void)hipGetLastError();
        grid = cus;
    }
    if (grid < 0) return;
    (void)in_sizes;
    if (hipMemsetAsync((char*)d_ws + WS_CTL, 0, CTL_BYTES, stream) != hipSuccess) return;
    Args a{};
    for (int i = 0; i < 27; ++i) a.in[i] = (const float*)d_in[i];
    a.out = (float*)d_out; a.ws = (unsigned char*)d_ws;
#if MK_N_LAUNCHES == 1
    a.ph_lo = 0; a.ph_hi = N_PHASES;
    hipLaunchKernelGGL(mk_fwd, dim3(grid), dim3(512), LDS_BYTES, stream, a);
#else
    for (int p = 0; p < N_PHASES; ++p) { a.ph_lo = p; a.ph_hi = p + 1; hipLaunchKernelGGL(mk_fwd, dim3(grid), dim3(512), LDS_BYTES, stream, a); }
#endif
}
```

```cpp
#include <hip/hip_runtime.h>
#include <cstdio>
#include <cstdint>

#ifndef MK_N_LAUNCHES
#define MK_N_LAUNCHES 1
#endif

#define LAS __attribute__((address_space(3)))
typedef unsigned short bf16_t;
typedef short bf16x8 __attribute__((ext_vector_type(8)));
typedef float f32x4 __attribute__((ext_vector_type(4)));
typedef float f32x2 __attribute__((ext_vector_type(2)));
typedef _Float16 f16x8 __attribute__((ext_vector_type(8)));
typedef float f32x8 __attribute__((ext_vector_type(8)));
typedef unsigned u32x4 __attribute__((ext_vector_type(4)));
typedef unsigned u32x2 __attribute__((ext_vector_type(2)));

constexpr int NB = 2, S_ = 16384, T_ = NB * S_, D_ = 2048, MEMT = 256;
constexpr int NPROJ = 4352;
constexpr int C_UV = 0, C_Q = 1024, C_KV = 2048, C_QX = 3584, C_GATE = 4096;
constexpr int IN_COLS = 4120;
constexpr int NEXP = 32, FF = 2048;
constexpr int LIST_CAP = T_;
constexpr int MAX_TILES = (T_ * 4) / 256 + NEXP;
constexpr float EPS = 1e-6f;

constexpr size_t al256(size_t x) { return (x + 255) & ~(size_t)255; }
constexpr size_t WS_CTL   = 0;
constexpr size_t CTL_BYTES = 65536;
constexpr size_t WS_H     = al256(WS_CTL + CTL_BYTES);
constexpr size_t WS_WIN   = al256(WS_H + (size_t)T_ * D_ * 2);
constexpr size_t WS_WOUT  = al256(WS_WIN + (size_t)NPROJ * D_ * 2);
constexpr size_t WS_W1T   = al256(WS_WOUT + (size_t)D_ * D_ * 2);
constexpr size_t WS_W2T   = al256(WS_W1T + (size_t)NEXP * 4096 * D_ * 2);
constexpr size_t WS_WKV   = al256(WS_W2T + (size_t)NEXP * D_ * FF * 2);
constexpr size_t WS_WRH   = al256(WS_WKV + (size_t)1024 * D_ * 2);
constexpr size_t WS_WRL   = al256(WS_WRH + (size_t)32 * D_ * 2);
constexpr size_t WS_CK1   = al256(WS_WRL + (size_t)32 * D_ * 2);
constexpr size_t WS_CV1   = al256(WS_CK1 + (size_t)128 * 4096 * 2);
constexpr size_t WS_CK2   = al256(WS_CV1 + (size_t)128 * 4096 * 2);
constexpr size_t WS_CV2   = al256(WS_CK2 + (size_t)128 * 128 * 2);
constexpr size_t WS_C1    = al256(WS_CV2 + (size_t)128 * 128 * 2);
constexpr size_t WS_B1G   = al256(WS_C1 + 1024);
constexpr size_t WS_B1L   = al256(WS_B1G + (size_t)NEXP * FF * 4);
constexpr size_t WS_GWS   = al256(WS_B1L + (size_t)NEXP * FF * 4);
constexpr size_t WS_MISC  = al256(WS_GWS + (size_t)4 * 128 * 128 * 2);
constexpr size_t WS_MEMN  = al256(WS_MISC + 1024);
constexpr size_t WS_PROJ  = al256(WS_MEMN + (size_t)512 * D_ * 2);
constexpr size_t WS_MEMKV = al256(WS_PROJ + (size_t)T_ * NPROJ * 2);
constexpr size_t WS_UB    = al256(WS_MEMKV + (size_t)512 * 1024 * 2);
constexpr size_t WS_VTG   = al256(WS_UB + (size_t)T_ * 512 * 2);
constexpr size_t WS_QN    = al256(WS_VTG + (size_t)T_ * 512 * 2);
constexpr size_t WS_QR    = al256(WS_QN + (size_t)T_ * 1024 * 2);
constexpr size_t KVROWS   = (size_t)NB * 2 * S_ + 64;
constexpr size_t WS_KCMP  = al256(WS_QR + (size_t)T_ * 1024 * 2);
constexpr size_t WS_VCMP  = al256(WS_KCMP + KVROWS * 128 * 2);
constexpr size_t WS_KSEL  = al256(WS_VCMP + KVROWS * 128 * 2);
constexpr size_t WS_KWIN  = al256(WS_KSEL + KVROWS * 128 * 2);
constexpr size_t WS_VSELT = al256(WS_KWIN + KVROWS * 128 * 2);
constexpr size_t WS_VWINT = al256(WS_VSELT + KVROWS * 128 * 2);
constexpr size_t WS_KC    = al256(WS_VWINT + KVROWS * 128 * 2);
constexpr size_t WS_VCT   = al256(WS_KC + (size_t)4 * 1024 * 128 * 2);
constexpr size_t WS_KX    = al256(WS_VCT + (size_t)4 * 1024 * 128 * 2);
constexpr size_t WS_VXT   = al256(WS_KX + (size_t)8 * 256 * 128 * 2);
constexpr size_t WS_QX    = al256(WS_VXT + (size_t)8 * 256 * 128 * 2);
constexpr size_t WS_GATES = al256(WS_QX + (size_t)T_ * 512 * 2);
constexpr size_t WS_MIXACC= al256(WS_GATES + (size_t)T_ * 24 * 4);
constexpr size_t WS_MIX   = al256(WS_MIXACC + (size_t)T_ * 1024 * 4);
constexpr size_t WS_IDX   = al256(WS_MIX + (size_t)T_ * D_ * 2);
constexpr size_t WS_ROWSS = al256(WS_IDX + (size_t)4 * S_ * 16 * 4);
constexpr size_t WS_PAIRG = al256(WS_ROWSS + (size_t)T_ * 32 * 4);
constexpr size_t WS_LIST  = al256(WS_PAIRG + (size_t)T_ * 4 * 4);
constexpr size_t WS_LGATE = al256(WS_LIST + (size_t)NEXP * LIST_CAP * 4);
constexpr size_t WS_H8    = al256(WS_LGATE + (size_t)NEXP * LIST_CAP * 4);
constexpr size_t WS_WIN8  = al256(WS_H8 + (size_t)T_ * D_);
constexpr size_t WS_ACT   = al256(WS_WIN8 + (size_t)3328 * D_);
constexpr size_t WS_Y     = al256(WS_ACT + (size_t)MAX_TILES * 256 * FF * 2);
constexpr size_t WS_X1H   = al256(WS_Y + (size_t)T_ * 4 * D_ * 2);
constexpr size_t WS_B2C   = al256(WS_X1H + (size_t)T_ * D_ * 2);
constexpr size_t WS_END   = al256(WS_B2C + (size_t)NEXP * D_ * 4);
constexpr int CW_BAR = 0;
constexpr int CW_GCOUNT = 4096;
constexpr int CW_XSLOT = 4352;

constexpr int LDS_SCRATCH = 139264;
constexpr int LDS_MISC = LDS_SCRATCH;
constexpr int LDS_BYTES = 147456;

__device__ __forceinline__ float bf2f(bf16_t v) { return __uint_as_float(((unsigned)v) << 16); }
__device__ __forceinline__ bf16_t f2bf(float f) { unsigned u = __float_as_uint(f); u += 0x7FFFu + ((u >> 16) & 1u); return (bf16_t)(u >> 16); }
__device__ __forceinline__ unsigned cvt_pk_bf16(float lo, float hi) { unsigned r; asm volatile("v_cvt_pk_bf16_f32 %0, %1, %2" : "=v"(r) : "v"(lo), "v"(hi)); return r; }
__device__ __forceinline__ bf16x8 pack8(float a0, float a1, float a2, float a3, float a4, float a5, float a6, float a7) {
    u32x4 w = {cvt_pk_bf16(a0, a1), cvt_pk_bf16(a2, a3), cvt_pk_bf16(a4, a5), cvt_pk_bf16(a6, a7)}; return __builtin_bit_cast(bf16x8, w); }
__device__ __forceinline__ unsigned pk4_fp8(float a, float b, float c, float d) {
    a = fminf(fmaxf(a, -448.f), 448.f); b = fminf(fmaxf(b, -448.f), 448.f); c = fminf(fmaxf(c, -448.f), 448.f); d = fminf(fmaxf(d, -448.f), 448.f);
    int p = __builtin_amdgcn_cvt_pk_fp8_f32(a, b, 0, false); p = __builtin_amdgcn_cvt_pk_fp8_f32(c, d, p, true); return (unsigned)p; }
typedef int i32x4 __attribute__((ext_vector_type(4)));
typedef int i32x8 __attribute__((ext_vector_type(8)));
constexpr float W_FP8_SCALE = 256.0f;
constexpr int W_FP8_SCALE_E8M0 = 0x77777777;
constexpr float MIX_SCALE = 16.0f;
constexpr int MIXP = 2560;
constexpr float Y_FP8_SCALE = 16.0f;
template <int CTRL> __device__ __forceinline__ float dppf(float v) { return __builtin_bit_cast(float, __builtin_amdgcn_update_dpp(0, __builtin_bit_cast(int, v), CTRL, 0xF, 0xF, true)); }
template <int CTRL> __device__ __forceinline__ unsigned dppu(unsigned v) { return (unsigned)__builtin_amdgcn_update_dpp(0, (int)v, CTRL, 0xF, 0xF, true); }
__device__ __forceinline__ float rdlane(float v, int l) { return __builtin_bit_cast(float, __builtin_amdgcn_readlane(__builtin_bit_cast(int, v), l)); }
__device__ __forceinline__ float wave_sum(float v) {
    v += dppf<0xB1>(v); v += dppf<0x4E>(v); v += dppf<0x141>(v); v += dppf<0x140>(v);
    return (rdlane(v, 0) + rdlane(v, 16)) + (rdlane(v, 32) + rdlane(v, 48)); }
__device__ __forceinline__ unsigned wave_umax(unsigned v) {
    unsigned t;
    t = dppu<0xB1>(v); v = v > t ? v : t; t = dppu<0x4E>(v); v = v > t ? v : t; t = dppu<0x141>(v); v = v > t ? v : t; t = dppu<0x140>(v); v = v > t ? v : t;
    const unsigned a = (unsigned)__builtin_amdgcn_readlane((int)v, 0), b = (unsigned)__builtin_amdgcn_readlane((int)v, 16), c = (unsigned)__builtin_amdgcn_readlane((int)v, 32), d = (unsigned)__builtin_amdgcn_readlane((int)v, 48);
    const unsigned m0 = a > b ? a : b, m1 = c > d ? c : d; return m0 > m1 ? m0 : m1; }
__device__ __forceinline__ unsigned wave_umax63(unsigned v) {
    unsigned t;
    t = dppu<0xB1>(v); v = v > t ? v : t; t = dppu<0x4E>(v); v = v > t ? v : t; t = dppu<0x141>(v); v = v > t ? v : t; t = dppu<0x140>(v); v = v > t ? v : t;
    t = (unsigned)__builtin_amdgcn_update_dpp(0, (int)v, 0x142, 0xA, 0xF, false); v = v > t ? v : t;
    t = (unsigned)__builtin_amdgcn_update_dpp(0, (int)v, 0x143, 0xC, 0xF, false); v = v > t ? v : t;
    return (unsigned)__builtin_amdgcn_readlane((int)v, 63); }
__device__ __forceinline__ float gelu_tanh(float x) {
    const float u = 1.5957691216057308f * (x + 0.044715f * x * x * x);
    return x / (1.0f + __expf(-u)); }
__device__ __forceinline__ float sigmoidf_(float x) { return 1.0f / (1.0f + __expf(-x)); }
#define XB_TMO      128
#define XB_XCNT(j)  (256  + 64 * (j))
#define XB_XSUB(j)  (1280 + 64 * (j))
#define XB_XGEN(j)  (2304 + 64 * (j))
#define XB_TOP      3328
#define XB_TOPGEN   3392
#define XCD_BAR_WORDS 3456
#define XB_SPIN_CAP (1u << 22)

__device__ __forceinline__ unsigned xb_ld(unsigned* p)              { return __hip_atomic_load(p, __ATOMIC_RELAXED, __HIP_MEMORY_SCOPE_AGENT); }
__device__ __forceinline__ unsigned xb_add(unsigned* p, unsigned v) { return __hip_atomic_fetch_add(p, v, __ATOMIC_RELAXED, __HIP_MEMORY_SCOPE_AGENT); }
__device__ __forceinline__ unsigned xb_xcc_id() { return (unsigned)__builtin_amdgcn_s_getreg((3 << 11) | 20) & 0xFu; }
#define XB_SPIN(cond, bar) do { unsigned _sp = 0; while (cond) { __builtin_amdgcn_s_sleep(1); \
    if ((++_sp & 255u) == 0u) { if (xb_ld(&(bar)[XB_TMO])) break; if (_sp > XB_SPIN_CAP) { atomicAdd(&(bar)[XB_TMO], 1u); break; } } } } while (0)

struct XcdBarrier {
    unsigned* bar; unsigned x;
    volatile LAS unsigned* st;
};
__device__ __forceinline__ XcdBarrier xcd_barrier_post(unsigned* bar, volatile LAS unsigned* st) {
    XcdBarrier b; b.bar = bar; b.x = xb_xcc_id(); b.st = st;
    if (threadIdx.x == 0) (void)xb_add(&bar[XB_XCNT(b.x)], 1u);
    return b;
}
__device__ __forceinline__ void xcd_barrier_complete(unsigned* bar, unsigned x, unsigned& nloc, unsigned& nx) {
    const unsigned G = gridDim.x * gridDim.y * gridDim.z;
    unsigned sum, cnt, mine, sp = 0u;
    for (;;) {
        sum = 0u; cnt = 0u; mine = 0u;
#pragma unroll
        for (unsigned j = 0; j < 16; ++j) { const unsigned c = xb_ld(&bar[XB_XCNT(j)]); sum += c; cnt += (c > 0u) ? 1u : 0u; mine = (j == x) ? c : mine; }
        if (sum == G) break;
        __builtin_amdgcn_s_sleep(1);
        if ((++sp & 255u) == 0u) { if (xb_ld(&bar[XB_TMO])) break; if (sp > XB_SPIN_CAP) { atomicAdd(&bar[XB_TMO], 1u); break; } }
    }
    nloc = mine > 0u ? mine : 1u; nx = cnt > 0u ? cnt : 1u;
}
__device__ __forceinline__ void xcd_barrier(const XcdBarrier& b) {
    asm volatile("s_waitcnt vmcnt(0)" ::: "memory");
    __syncthreads();
    if (threadIdx.x == 0) {
        unsigned* bar = b.bar;
        __builtin_amdgcn_s_waitcnt(0);
        unsigned nloc = b.st[0], nx = b.st[1];
        if (nloc == 0u) { xcd_barrier_complete(bar, b.x, nloc, nx); b.st[0] = nloc; b.st[1] = nx; }
        const unsigned old = xb_add(&bar[XB_XSUB(b.x)], 1u);
        const unsigned gen = old / nloc;
        if (old + 1u == (gen + 1u) * nloc) {
            __builtin_amdgcn_fence(__ATOMIC_RELEASE, "agent");
            asm volatile("s_waitcnt vmcnt(0)" ::: "memory");
            const unsigned og = xb_add(&bar[XB_TOP], 1u);
            const unsigned tg = og / nx;
            if (og + 1u == (tg + 1u) * nx) xb_add(&bar[XB_TOPGEN], 1u);
            else XB_SPIN(xb_ld(&bar[XB_TOPGEN]) == tg, bar);
            __builtin_amdgcn_fence(__ATOMIC_ACQUIRE, "agent");
            xb_add(&bar[XB_XGEN(b.x)], 1u);
            asm volatile("s_waitcnt vmcnt(0)" ::: "memory");
        } else {
            XB_SPIN(xb_ld(&bar[XB_XGEN(b.x)]) == gen, bar);
            __builtin_amdgcn_fence(__ATOMIC_ACQUIRE, "agent");
            asm volatile("s_waitcnt vmcnt(0)" ::: "memory");
        }
    }
    __syncthreads();
}

struct Args;
__device__ __forceinline__ const float* args_in(const Args* ka, int k);
namespace pg8 {
constexpr int BM = 256, BK = 64, HALF = 128, HTB = HALF * BK * 2  , STAGE_BYTES = 8 * HTB, NXCD = 8, WGM = 8;
__host__ __device__ __forceinline__ int lds_byte(int r, int c) { const int st = (r >> 4) * 2 + (c >> 5), rr = r & 15, cc = c & 31, ob = rr * 64 + cc * 2; return st * 1024 + (ob ^ (((ob >> 9) & 1) << 5)); }
__host__ __device__ __forceinline__ void stage_rc(int b, int& R, int& C) { const int st = b / 1024, sb = b % 1024, swz = sb ^ (((sb >> 9) & 1) << 5); R = (st >> 1) * 16 + swz / 64; C = (st & 1) * 32 + (swz % 64) / 2; }
__host__ __device__ __forceinline__ int perm32(int rho) { const int n = rho >> 4, i = rho & 15; return 8 * (i >> 2) + 4 * n + (i & 3); }

struct Unit { int pm, pn, pb, e, cnt, pos0; };
struct Gemm { const bf16_t* A; const bf16_t* Bt; int M, N, K; };

struct StaticOrder {
    int nM, nN, nwg, G, c;
    __host__ __device__ void init(int M, int N, int G_, int c_) { nM = M / BM; nN = N / BM; nwg = nM * nN; G = G_; c = c_; }
    __host__ __device__ bool map(int i, int& pm, int& pn) const {
        const int L = i * G + c; if (L >= nwg || c < 0) return false;
        int wgid = L; { const int q = nwg / NXCD, r = nwg % NXCD, xcd = wgid % NXCD, off = wgid / NXCD; wgid = (xcd < r ? xcd * (q + 1) : r * (q + 1) + (xcd - r) * q) + off; }
        const int nig = WGM * nN, gid = wgid / nig, fm = gid * WGM, gsz = (nM - fm) < WGM ? (nM - fm) : WGM;
        pm = fm + ((wgid % nig) % gsz); pn = (wgid % nig) / gsz; return true;
    }
    __device__ __forceinline__ bool next(int i, Unit& u) const { if (!map(i, u.pm, u.pn)) return false; u.pb = u.pn; u.e = 0; u.cnt = 0; u.pos0 = 0; return true; }
    __device__ __forceinline__ int arow(const Unit&, int) const { return 0; }
    __device__ __forceinline__ void tables(LAS unsigned char*, LAS unsigned char*, const Unit&, int, int) const {}
    __device__ __forceinline__ void a_ready(const Unit&) const {}
    __device__ __forceinline__ void done(const Unit&) const {}
};
struct MoeOrder : StaticOrder {
    const LAS int* tb; const unsigned char* ws;
    const LAS int* ul;
    __device__ void init_moe(int nN_, int G_, int c_, const LAS int* tb_, const unsigned char* ws_, LAS int* ul_) { tb = tb_; ws = ws_; ul = ul_; nM = __builtin_amdgcn_readfirstlane(tb_[32]); nN = nN_; nwg = nM * nN; G = G_; c = c_;
        const int k = threadIdx.x;
        if (k < 128) { int pm = -1, pn = 0, e = 0, cnt = 0, pos0 = 0;
            if (map(k, pm, pn)) {
#pragma unroll
                for (int s = 16; s >= 1; s >>= 1) if (tb[e + s] <= pm) e += s;
                cnt = tb[33 + e]; pos0 = (pm - tb[e]) * BM; } else pm = -1;
            ul_[k * 8 + 0] = pm; ul_[k * 8 + 1] = pn; ul_[k * 8 + 2] = e; ul_[k * 8 + 3] = cnt; ul_[k * 8 + 4] = pos0; ul_[k * 8 + 5] = e * nN_ + pn; }
        __syncthreads(); }
    __device__ __forceinline__ bool next(int i, Unit& u) const {
        if (i >= 128) return false;
        const i32x4 a = *(const LAS i32x4*)(ul + i * 8); const int p0 = ul[i * 8 + 4], pb = ul[i * 8 + 5];
        u.pm = __builtin_amdgcn_readfirstlane(a[0]); if (u.pm < 0) return false;
        u.pn = __builtin_amdgcn_readfirstlane(a[1]); u.e = __builtin_amdgcn_readfirstlane(a[2]); u.cnt = __builtin_amdgcn_readfirstlane(a[3]); u.pos0 = __builtin_amdgcn_readfirstlane(p0); u.pb = __builtin_amdgcn_readfirstlane(pb); return true;
    }
    __device__ __forceinline__ void tables(LAS unsigned char* tbl, LAS unsigned char* b2l, const Unit& u, int wid, int lane) const {
        if (wid < 4) { int pos = u.pos0 + 64 * wid + lane; pos = pos < u.cnt ? pos : u.cnt - 1; const int vo = (u.e * LIST_CAP + pos) * 4;
            const __amdgpu_buffer_rsrc_t rl = __builtin_amdgcn_make_buffer_rsrc((void*)(ws + WS_LIST), 0, 0xFFFFFFF0u, 0x00020000);
            __builtin_amdgcn_raw_ptr_buffer_load_lds(rl, (LAS void*)(tbl + wid * 256), 4, vo, 0, 0, 0);
            if (nN == 8) { const __amdgpu_buffer_rsrc_t rg = __builtin_amdgcn_make_buffer_rsrc((void*)(ws + WS_LGATE), 0, 0xFFFFFFF0u, 0x00020000);
                __builtin_amdgcn_raw_ptr_buffer_load_lds(rg, (LAS void*)(tbl + 1024 + wid * 256), 4, vo, 0, 0, 0); }
        } else if (nN == 8) {
            const __amdgpu_buffer_rsrc_t rb = __builtin_amdgcn_make_buffer_rsrc((void*)(ws + WS_B2C), 0, 0xFFFFFFF0u, 0x00020000);
            __builtin_amdgcn_raw_ptr_buffer_load_lds(rb, (LAS void*)(b2l + (wid - 4) * 256), 4, (u.e * D_ + u.pn * BM + 64 * (wid - 4) + lane) * 4, 0, 0, 0);
        } else if (wid < 6) { const __amdgpu_buffer_rsrc_t rb = __builtin_amdgcn_make_buffer_rsrc((void*)(ws + (wid == 4 ? WS_B1G : WS_B1L)), 0, 0xFFFFFFF0u, 0x00020000);
            const int vo = (u.e * FF + u.pn * HALF + lane) * 4;
            __builtin_amdgcn_raw_ptr_buffer_load_lds(rb, (LAS void*)(tbl + 1024 + (wid - 4) * 512), 4, vo, 0, 0, 0);
            __builtin_amdgcn_raw_ptr_buffer_load_lds(rb, (LAS void*)(tbl + 1024 + (wid - 4) * 512 + 256), 4, vo + 256, 0, 0, 0); }
    }
    __device__ __forceinline__ int arow(const Unit& u, int r) const { int pos = u.pos0 + r; pos = pos < u.cnt ? pos : u.cnt - 1; return ((const int*)(ws + WS_LIST))[(size_t)u.e * LIST_CAP + pos] >> 2; }
};

struct EpiBf16 {
    static constexpr bool PERM = true;
    bf16_t* O; int ldc; int colo; float scale;
    __device__ __forceinline__ void operator()(const f32x4 (&acc)[2][2][4][2], const Unit& u, int wr, int wc, int fr, int fq, LAS const unsigned char* tbl, LAS const unsigned char* b2l) const {
        { int t_ = threadIdx.x; asm volatile("" : "+v"(t_)); fr = t_ & 15; fq = (t_ >> 4) & 3; }
        const int row0 = u.pm * BM + wr * 64 + fr; const int col0 = colo + u.pn * BM + wc * 32 + 8 * fq;
#pragma unroll
        for (int ai = 0; ai < 2; ++ai)
#pragma unroll
            for (int m = 0; m < 4; ++m) { bf16_t* rowp = O + (size_t)(row0 + ai * HALF + m * 16) * ldc + col0;
#pragma unroll
                for (int bj = 0; bj < 2; ++bj) { const f32x4 v0 = acc[ai][bj][m][0] * scale, v1 = acc[ai][bj][m][1] * scale;
                    u32x4 w; w.x = cvt_pk_bf16(v0[0], v0[1]); w.y = cvt_pk_bf16(v0[2], v0[3]); w.z = cvt_pk_bf16(v1[0], v1[1]); w.w = cvt_pk_bf16(v1[2], v1[3]);
                    *(u32x4*)(rowp + bj * HALF) = w; } }
    }
};
struct EpiResF32 {
    static constexpr bool PERM = true;
    const Args* ka; unsigned char* ws; int ldc; size_t rowss_off; float scale;
    __device__ __forceinline__ void operator()(const f32x4 (&acc)[2][2][4][2], const Unit& u, int wr, int wc, int fr, int fq, LAS const unsigned char* tbl, LAS const unsigned char* b2l) const {
        const int row0 = u.pm * BM + wr * 64 + fr, col0 = u.pn * BM + wc * 32 + 8 * fq;
        const float* __restrict__ rp = args_in(ka, 0); _Float16* __restrict__ cp = (_Float16*)(ws + WS_X1H); float* rowss = (float*)(ws + rowss_off);
#pragma unroll
        for (int ai = 0; ai < 2; ++ai)
#pragma unroll
            for (int mp = 0; mp < 2; ++mp) { f32x4 r[2][2][2];
#pragma unroll
                for (int mm = 0; mm < 2; ++mm) { const size_t off = (size_t)(row0 + ai * HALF + (2 * mp + mm) * 16) * ldc + col0;
#pragma unroll
                    for (int bj = 0; bj < 2; ++bj)
#pragma unroll
                        for (int n = 0; n < 2; ++n) r[mm][bj][n] = *(const f32x4*)(rp + off + bj * HALF + n * 4); }
#pragma unroll
                for (int mm = 0; mm < 2; ++mm) { const int m = 2 * mp + mm; const int row = row0 + ai * HALF + m * 16; const size_t off = (size_t)row * ldc + col0; float ss = 0.f;
#pragma unroll
                    for (int bj = 0; bj < 2; ++bj) { const f32x4 o0 = r[mm][bj][0] + acc[ai][bj][m][0] * scale, o1 = r[mm][bj][1] + acc[ai][bj][m][1] * scale;
                        ss += ((o0[0] * o0[0] + o0[1] * o0[1]) + (o0[2] * o0[2] + o0[3] * o0[3])) + ((o1[0] * o1[0] + o1[1] * o1[1]) + (o1[2] * o1[2] + o1[3] * o1[3]));
                        f16x8 h;
#pragma unroll
                        for (int j = 0; j < 4; ++j) { h[j] = (_Float16)__builtin_amdgcn_fmed3f(o0[j], -65504.0f, 65504.0f); h[4 + j] = (_Float16)__builtin_amdgcn_fmed3f(o1[j], -65504.0f, 65504.0f); }
                        *(f16x8*)(cp + off + bj * HALF) = h; }
                    ss += __shfl_xor(ss, 16); ss += __shfl_xor(ss, 32);
                    if (fq == 0) rowss[(size_t)row * 32 + u.pn * 4 + wc] = ss; } }
    }
};
struct EpiGlu {
    static constexpr bool PERM = true;
    unsigned char* ws;
    __device__ __forceinline__ void operator()(const f32x4 (&acc)[2][2][4][2], const Unit& u, int wr, int wc, int fr, int fq, LAS const unsigned char* tbl, LAS const unsigned char* b2l) const {
        { int t_ = threadIdx.x; asm volatile("" : "+v"(t_)); fr = t_ & 15; fq = (t_ >> 4) & 3; }
        const int row0 = u.pm * BM + wr * 64 + fr; const int cl = wc * 32 + 8 * fq; const int col0 = u.pn * HALF + cl;
        unsigned char* act = ws + WS_ACT;
        typedef float f32x2_ __attribute__((ext_vector_type(2)));
        f32x4 gb[2], lb[2]; gb[0] = *(LAS const f32x4*)(tbl + 1024 + cl * 4); gb[1] = *(LAS const f32x4*)(tbl + 1024 + cl * 4 + 16); lb[0] = *(LAS const f32x4*)(tbl + 1536 + cl * 4) + 1.0f; lb[1] = *(LAS const f32x4*)(tbl + 1536 + cl * 4 + 16) + 1.0f;
        const f32x2_ sc2 = {1.0f / W_FP8_SCALE, 1.0f / W_FP8_SCALE}, ce2 = {-1.702f * 1.4426950409f, -1.702f * 1.4426950409f}, one2 = {1.0f, 1.0f};
#pragma unroll
        for (int ai = 0; ai < 2; ++ai)
#pragma unroll
            for (int m = 0; m < 4; ++m) { unsigned char* rowp = act + (size_t)(row0 + ai * HALF + m * 16) * FF + col0; f32x2_ o[4];
#pragma unroll
                for (int n = 0; n < 2; ++n)
#pragma unroll
                    for (int h = 0; h < 2; ++h) { const f32x4 ag = acc[ai][0][m][n], al = acc[ai][1][m][n];
                        const f32x2_ a2 = {ag[2 * h], ag[2 * h + 1]}, b2 = {al[2 * h], al[2 * h + 1]}, g2 = {gb[n][2 * h], gb[n][2 * h + 1]}, l2 = {lb[n][2 * h], lb[n][2 * h + 1]};
                        f32x2_ gv = __builtin_elementwise_fma(a2, sc2, g2), lv = __builtin_elementwise_fma(b2, sc2, l2);
                        gv[0] = fminf(gv[0], 7.0f); gv[1] = fminf(gv[1], 7.0f); lv[0] = __builtin_amdgcn_fmed3f(lv[0], -6.0f, 8.0f); lv[1] = __builtin_amdgcn_fmed3f(lv[1], -6.0f, 8.0f);
                        f32x2_ e = gv * ce2; e[0] = __builtin_amdgcn_exp2f(e[0]); e[1] = __builtin_amdgcn_exp2f(e[1]); e = e + one2; e[0] = __builtin_amdgcn_rcpf(e[0]); e[1] = __builtin_amdgcn_rcpf(e[1]);
                        o[n * 2 + h] = (gv * e) * lv; }
                u32x2 w; int p0 = __builtin_amdgcn_cvt_pk_fp8_f32(o[0][0], o[0][1], 0, false); p0 = __builtin_amdgcn_cvt_pk_fp8_f32(o[1][0], o[1][1], p0, true);
                int p1 = __builtin_amdgcn_cvt_pk_fp8_f32(o[2][0], o[2][1], 0, false); p1 = __builtin_amdgcn_cvt_pk_fp8_f32(o[3][0], o[3][1], p1, true); w.x = (unsigned)p0; w.y = (unsigned)p1;
                *(u32x2*)rowp = w; }
    }
};
struct EpiScatter {
    static constexpr bool PERM = true;
    unsigned char* ws; const Args* ka;
    __device__ __forceinline__ void operator()(const f32x4 (&acc)[2][2][4][2], const Unit& u, int wr, int wc, int fr, int fq, LAS const unsigned char* tbl, LAS const unsigned char* b2l) const {
        { int t_ = threadIdx.x; asm volatile("" : "+v"(t_)); fr = t_ & 15; fq = (t_ >> 4) & 3; }
        const int r0 = wr * 64 + fr; const int col0 = u.pn * BM + wc * 32 + 8 * fq;
        unsigned char* Y = ws + WS_Y;
        f32x4 bv[2][2];
#pragma unroll
        for (int bj = 0; bj < 2; ++bj)
#pragma unroll
            for (int n = 0; n < 2; ++n) bv[bj][n] = *(LAS const f32x4*)(b2l + (wc * 32 + 8 * fq + bj * HALF + 4 * n) * 4);
#pragma unroll
        for (int ai = 0; ai < 2; ++ai)
#pragma unroll
            for (int m = 0; m < 4; ++m) { const int row = r0 + ai * HALF + m * 16;
                if (u.pos0 + row < u.cnt) { const int pid = *(LAS const int*)(tbl + row * 4); const float gt = *(LAS const float*)(tbl + 1024 + row * 4) * Y_FP8_SCALE; unsigned char* rowp = Y + (size_t)pid * D_ + col0;
#pragma unroll
                    for (int bj = 0; bj < 2; ++bj) { const f32x4 v0 = (acc[ai][bj][m][0] * (1.0f / W_FP8_SCALE) + bv[bj][0]) * gt, v1 = (acc[ai][bj][m][1] * (1.0f / W_FP8_SCALE) + bv[bj][1]) * gt;
                        u32x2 w; w.x = pk4_fp8(v0[0], v0[1], v0[2], v0[3]); w.y = pk4_fp8(v1[0], v1[1], v1[2], v1[3]);
                        *(u32x2*)(rowp + bj * HALF) = w; } } }
    }
};

template <class Epi, class Sched, bool GATHER, int FP8 = 0  >
__device__ __forceinline__ void gemm_phase(LAS unsigned char* lds, const Gemm g, const Sched& S, const Epi& E) {
    int tid_ = threadIdx.x; asm volatile("" : "+v"(tid_));
    const int tid = tid_, wid = __builtin_amdgcn_readfirstlane(tid >> 6), lane = tid & 63, wr = wid >> 2, wc = wid & 3, fr = lane & 15, fq = lane >> 4;
    const int K = g.K, nt = K / BK;
    const __amdgpu_buffer_rsrc_t rsA = __builtin_amdgcn_make_buffer_rsrc((void*)g.A, 0, 0xFFFFFFF0u, 0x00020000);
    const __amdgpu_buffer_rsrc_t rsB = __builtin_amdgcn_make_buffer_rsrc((void*)g.Bt, 0, 0xFFFFFFF0u, 0x00020000);
    unsigned voffB[2];
#pragma unroll
    for (int i = 0; i < 2; ++i) { int R, C; stage_rc(tid * 16 + i * 8192, R, C); const int Rb = Epi::PERM ? ((R & ~31) + perm32(R & 31)) : R; voffB[i] = (unsigned)(Rb * K + C) * 2u; }
    const unsigned kstep = (unsigned)(BK * 2);
    const unsigned hstep = (unsigned)HALF * (unsigned)K * 2u;
    const unsigned tstep = 2u * hstep;
    const unsigned ldsw = (unsigned)wid * 1024u;
    const int aoff = lds_byte(wr * 64 + fr, fq * 8), boff = lds_byte(wc * 32 + fr, fq * 8);
#define PG8_SA(b, h) (((b) * 2 + (h)) * HTB)
#define PG8_SB(b, h) ((4 + (b) * 2 + (h)) * HTB)
#define PG8_STAGE(bufoff, rs, soff, voff) do { _Pragma("unroll") for (int _i = 0; _i < 2; ++_i) \
        __builtin_amdgcn_raw_ptr_buffer_load_lds(rs, (LAS void*)(lds + (bufoff) + ldsw + _i * 8192), 16, (int)(voff)[_i], (int)(soff), 0, 0); } while (0)
#define PG8_STAGE2(bufoff, rs, soff, o0, o1) do { \
        __builtin_amdgcn_raw_ptr_buffer_load_lds(rs, (LAS void*)(lds + (bufoff) + ldsw), 16, (int)(o0), (int)(soff), 0, 0); \
        __builtin_amdgcn_raw_ptr_buffer_load_lds(rs, (LAS void*)(lds + (bufoff) + ldsw + 8192), 16, (int)(o1), (int)(soff), 0, 0); } while (0)
#define PG8_LDA(dst, b, h) do { _Pragma("unroll") for (int m = 0; m < 4; ++m) _Pragma("unroll") for (int k = 0; k < 2; ++k) dst[m][k] = *(const LAS bf16x8*)(lds + PG8_SA(b, h) + aoff + m * 2048 + k * 1024); } while (0)
#define PG8_LDB(dst, b, h) do { _Pragma("unroll") for (int n = 0; n < 2; ++n) _Pragma("unroll") for (int k = 0; k < 2; ++k) dst[n][k] = *(const LAS bf16x8*)(lds + PG8_SB(b, h) + boff + n * 2048 + k * 1024); } while (0)
#define PG8_MMA(ai, bj, At, Bt) do { __builtin_amdgcn_s_setprio(1); _Pragma("unroll") for (int m = 0; m < 4; ++m) _Pragma("unroll") for (int n = 0; n < 2; ++n) { \
        if (f8now) { const i32x8 _b = __builtin_shufflevector(__builtin_bit_cast(i32x4, Bt[n][0]), __builtin_bit_cast(i32x4, Bt[n][1]), 0, 1, 2, 3, 4, 5, 6, 7); \
                   const i32x8 _a = __builtin_shufflevector(__builtin_bit_cast(i32x4, At[m][0]), __builtin_bit_cast(i32x4, At[m][1]), 0, 1, 2, 3, 4, 5, 6, 7); \
                   acc[ai][bj][m][n] = __builtin_amdgcn_mfma_scale_f32_16x16x128_f8f6f4(_b, _a, acc[ai][bj][m][n], 0, 0, 0, 0, 0, 0); } \
        else { _Pragma("unroll") for (int k = 0; k < 2; ++k) acc[ai][bj][m][n] = __builtin_amdgcn_mfma_f32_16x16x32_bf16(Bt[n][k], At[m][k], acc[ai][bj][m][n], 0, 0, 0); } } \
        __builtin_amdgcn_s_setprio(0); } while (0)
#define PG8_H1(p) (GATHER ? (p) : (p) + hstep)
#define PG8_CV1(i) (GATHER ? cv[1][i] : cv[0][i])
#define PG8_WAIT_V(n) asm volatile("s_waitcnt vmcnt(" #n ")" ::: "memory")
#define PG8_WAIT_L(n) asm volatile("s_waitcnt lgkmcnt(" #n ")" ::: "memory")
#define PG8_BAR __builtin_amdgcn_s_barrier()
#define PG8_SCHED __builtin_amdgcn_sched_barrier(0)
#define PG8_AOFF(dst, un) do { _Pragma("unroll") for (int _i = 0; _i < 2; ++_i) { int _R, _C; stage_rc(tid * 16 + _i * 8192, _R, _C); _Pragma("unroll") for (int _h = 0; _h < 2; ++_h) \
        dst[_h][_i] = GATHER ? (unsigned)S.arow(un, _h * HALF + _R) * (unsigned)(K * 2) + (unsigned)(_C * 2) : (unsigned)((_h * HALF + _R) * K + _C) * 2u; } } while (0)
    Unit cur, nxt; int ui = 0;
    if (!S.next(0, cur)) return;
    f32x4 acc[2][2][4][2];
#pragma unroll
    for (int a = 0; a < 2; ++a)
#pragma unroll
        for (int b = 0; b < 2; ++b)
#pragma unroll
            for (int m = 0; m < 4; ++m)
#pragma unroll
                for (int n = 0; n < 2; ++n) acc[a][b][m][n] = (f32x4){0.f, 0.f, 0.f, 0.f};
    bf16x8 At[4][2], B0[2][2], B1[2][2];
    unsigned cv[2][2];
    PG8_AOFF(cv, cur);
    unsigned cA = GATHER ? 0u : (unsigned)cur.pm * tstep, cB = (unsigned)cur.pb * tstep;
    S.a_ready(cur);
    int tbi = 0;
#define PG8_B2L(tb_) ((tb_) < 2 ? STAGE_BYTES + 6144 + (tb_) * 1024 : LDS_MISC + 6144)
    S.tables(lds + STAGE_BYTES, lds + PG8_B2L(0), cur, wid, lane);
    PG8_STAGE(PG8_SB(0, 0), rsB, cB, voffB); PG8_STAGE2(PG8_SA(0, 0), rsA, cA, cv[0][0], cv[0][1]); PG8_STAGE(PG8_SB(0, 1), rsB, cB + hstep, voffB); PG8_STAGE2(PG8_SA(0, 1), rsA, PG8_H1(cA), PG8_CV1(0), PG8_CV1(1));
    if (wr == 1) PG8_BAR;
    PG8_WAIT_V(4); PG8_BAR;
    PG8_STAGE(PG8_SB(1, 0), rsB, cB + kstep, voffB); PG8_STAGE2(PG8_SA(1, 0), rsA, cA + kstep, cv[0][0], cv[0][1]); PG8_STAGE(PG8_SB(1, 1), rsB, cB + hstep + kstep, voffB);
    PG8_WAIT_V(6); PG8_BAR;
    for (;;) {
        const bool has_next = S.next(ui + 1, nxt);
        const unsigned nA = has_next ? (GATHER ? 0u : (unsigned)nxt.pm * tstep) : cA, nB = has_next ? (unsigned)nxt.pb * tstep : cB;
        const int tbn = tbi == 2 ? 0 : tbi + 1;
        if (has_next) S.tables(lds + STAGE_BYTES + tbn * 2048, lds + PG8_B2L(tbn), nxt, wid, lane);
#define PG8_ITER(F8_) do { \
            const bool last = (t == nt - 2); const bool f8now = (F8_); (void)f8now; \
            const unsigned a1 = cA + (unsigned)(t + 1) * kstep; \
            const unsigned a2 = last ? nA : cA + (unsigned)(t + 2) * kstep, b2 = last ? nB : cB + (unsigned)(t + 2) * kstep; \
            const unsigned a3 = a2 + kstep, b3 = b2 + kstep; \
            if (last && has_next) S.a_ready(nxt); \
            PG8_LDB(B0, 0, 0); PG8_SCHED; PG8_LDA(At, 0, 0); PG8_STAGE2(PG8_SA(1, 1), rsA, PG8_H1(a1), PG8_CV1(0), PG8_CV1(1)); \
            PG8_WAIT_L(8); PG8_BAR; PG8_WAIT_L(0); PG8_MMA(0, 0, At, B0); PG8_BAR; PG8_SCHED; \
            PG8_LDB(B1, 0, 1); PG8_STAGE(PG8_SB(0, 0), rsB, b2, voffB); \
            PG8_BAR; PG8_WAIT_L(0); PG8_MMA(0, 1, At, B1); PG8_BAR; \
            if (GATHER && last && has_next) { const LAS int* _tb = (const LAS int*)(lds + STAGE_BYTES + tbn * 2048); \
                _Pragma("unroll") for (int _i = 0; _i < 2; ++_i) { int _R, _C; stage_rc(tid * 16 + _i * 8192, _R, _C); _Pragma("unroll") for (int _h = 0; _h < 2; ++_h) cv[_h][_i] = (unsigned)(_tb[_h * HALF + _R] >> 2) * (unsigned)(K * 2) + (unsigned)(_C * 2); } \
                PG8_WAIT_L(0); } \
            PG8_LDA(At, 0, 1); PG8_STAGE2(PG8_SA(0, 0), rsA, a2, cv[0][0], cv[0][1]); \
            PG8_BAR; PG8_WAIT_L(0); PG8_MMA(1, 0, At, B0); PG8_BAR; PG8_SCHED; \
            PG8_STAGE(PG8_SB(0, 1), rsB, b2 + hstep, voffB); \
            PG8_WAIT_V(6); PG8_BAR; PG8_MMA(1, 1, At, B1); PG8_BAR; \
            PG8_LDB(B0, 1, 0); PG8_SCHED; PG8_LDA(At, 1, 0); PG8_STAGE2(PG8_SA(0, 1), rsA, PG8_H1(a2), PG8_CV1(0), PG8_CV1(1)); \
            PG8_WAIT_L(8); PG8_BAR; PG8_WAIT_L(0); PG8_MMA(0, 0, At, B0); PG8_BAR; PG8_SCHED; \
            PG8_LDB(B1, 1, 1); PG8_STAGE(PG8_SB(1, 0), rsB, b3, voffB); \
            PG8_BAR; PG8_WAIT_L(0); PG8_MMA(0, 1, At, B1); PG8_BAR; \
            PG8_LDA(At, 1, 1); PG8_STAGE2(PG8_SA(1, 0), rsA, a3, cv[0][0], cv[0][1]); \
            PG8_BAR; PG8_WAIT_L(0); PG8_MMA(1, 0, At, B0); PG8_BAR; PG8_SCHED; \
            PG8_STAGE(PG8_SB(1, 1), rsB, b3 + hstep, voffB); \
            PG8_WAIT_V(6); PG8_BAR; PG8_MMA(1, 1, At, B1); PG8_BAR; \
        } while (0)
        if (FP8 == 2) { for (int t = 0; t < 8; t += 2) PG8_ITER(false); for (int t = 8; t < nt; t += 2) PG8_ITER(true); }
        else { for (int t = 0; t < nt; t += 2) PG8_ITER(FP8 == 1); }
#undef PG8_ITER
        E(acc, cur, wr, wc, fr, fq, lds + STAGE_BYTES + tbi * 2048, lds + PG8_B2L(tbi)); S.done(cur);
#ifdef MK_EPI2
        if (FP8 == 1) { asm volatile("" ::: "memory"); E(acc, cur, wr, wc, fr, fq, lds + STAGE_BYTES + tbi * 2048, lds + PG8_B2L(tbi)); }
#endif
        if (!has_next) break;
#pragma unroll
        for (int a = 0; a < 2; ++a)
#pragma unroll
            for (int b = 0; b < 2; ++b)
#pragma unroll
                for (int m = 0; m < 4; ++m)
#pragma unroll
                    for (int n = 0; n < 2; ++n) acc[a][b][m][n] = (f32x4){0.f, 0.f, 0.f, 0.f};
        cur = nxt; cA = nA; cB = nB; ++ui; tbi = tbn;
    }
    PG8_WAIT_V(0);
    if (wr == 0) PG8_BAR;
    PG8_BAR;
#undef PG8_SA
#undef PG8_SB
#undef PG8_STAGE
#undef PG8_STAGE2
#undef PG8_LDA
#undef PG8_LDB
#undef PG8_MMA
#undef PG8_WAIT_V
#undef PG8_WAIT_L
#undef PG8_BAR
#undef PG8_SCHED
#undef PG8_AOFF
#undef PG8_B2L
#undef PG8_H1
#undef PG8_CV1
}
}
struct Args { const float* in[27]; float* out; unsigned char* ws; int ph_lo, ph_hi; };
__device__ __forceinline__ const float* args_in(const Args* ka, int k) { return ka->in[k]; }
struct Ctx {
    const Args* ka;
    float* out; unsigned char* ws;
    LAS unsigned char* lds; int tid, lane, wave, G, bid;
};
#define WSP(type, off) ((type*)(C.ws + (off)))
enum { I_X = 0, I_MEM, I_POS, I_MIXG, I_MEMG, I_WIN, I_WOUT, I_GWS, I_GBS, I_GVG, I_CPOS, I_CK1, I_CK2, I_CV1, I_CV2, I_NQG, I_NKG, I_WKV, I_XQG, I_XKG, I_FFG, I_WR, I_BR, I_WE1, I_BE1, I_WE2, I_BE2 };

struct TReg { f32x4 v[4]; };
__device__ __forceinline__ int tt_idx(int k, int n) { return k * 65 + 8 * (k >> 5) + n; }
constexpr int TT_TILE_BYTES = (128 * 65 + 32) * 4;
__device__ __forceinline__ void tt_load(TReg& R, const float* src, int N, int ld, int k0, int n0, int tid) {
    const int kr = tid >> 4, nc = (tid & 15) * 4;
#pragma unroll
    for (int rep = 0; rep < 4; ++rep) { R.v[rep] = (f32x4){0.f, 0.f, 0.f, 0.f}; if (n0 + nc < N) R.v[rep] = *(const f32x4*)(src + (size_t)(k0 + kr + 32 * rep) * ld + n0 + nc); } }
__device__ __forceinline__ void tt_put(const TReg& R, LAS float* tile, int tid) {
    const int kr = tid >> 4, nc = (tid & 15) * 4;
#pragma unroll
    for (int rep = 0; rep < 4; ++rep) { LAS float* p = tile + tt_idx(kr + 32 * rep, nc); p[0] = R.v[rep][0]; p[1] = R.v[rep][1]; p[2] = R.v[rep][2]; p[3] = R.v[rep][3]; } }
__device__ __forceinline__ void tt_finish(LAS const float* tile, bf16_t* dst, int ldd, int k0, int n0, int N, int map, bool fp8, int tid) {
    const int n = tid >> 3; const int ns = n0 + n;
    if (ns < N) { int r = ns;
        if (map == 1) r = ns < 3584 ? ns : (ns < 3608 ? C_GATE + (ns - 3584) : C_QX + (ns - 3608));
        else if (map == 2) { const int j = ns >> 1, par = ns & 1; r = 256 * (j >> 7) + 128 * par + (j & 127); }
        else if (map == 3) { const int no = ns + 1024; r = (no < 3584 ? no : (no < 3608 ? C_GATE + (no - 3584) : C_QX + (no - 3608))) - 1024; }
        if (map == 4) {
            unsigned char* rowp = (unsigned char*)dst + (size_t)r * MIXP;
            if (k0 < 512) { const int kc = (tid & 7) * 8;
#pragma unroll
                for (int rep = 0; rep < 2; ++rep) { const int kk = kc + 64 * rep; float f[8];
#pragma unroll
                    for (int j = 0; j < 8; ++j) f[j] = tile[tt_idx(kk + j, n)] * W_FP8_SCALE;
                    u32x4 w; w.x = cvt_pk_bf16(f[0], f[1]); w.y = cvt_pk_bf16(f[2], f[3]); w.z = cvt_pk_bf16(f[4], f[5]); w.w = cvt_pk_bf16(f[6], f[7]);
                    *(u32x4*)(rowp + 2 * (k0 + kk)) = w; }
            } else { const int kk = (tid & 7) * 16; float f[16];
#pragma unroll
                for (int j = 0; j < 16; ++j) f[j] = tile[tt_idx(kk + j, n)] * W_FP8_SCALE;
                u32x4 w; w.x = pk4_fp8(f[0], f[1], f[2], f[3]); w.y = pk4_fp8(f[4], f[5], f[6], f[7]); w.z = pk4_fp8(f[8], f[9], f[10], f[11]); w.w = pk4_fp8(f[12], f[13], f[14], f[15]);
                *(u32x4*)(rowp + 1024 + (k0 - 512) + kk) = w; }
        } else if (fp8) { const int kk = (tid & 7) * 16; float f[16];
#pragma unroll
            for (int j = 0; j < 16; ++j) f[j] = tile[tt_idx(kk + j, n)] * W_FP8_SCALE;
            u32x4 w; w.x = pk4_fp8(f[0], f[1], f[2], f[3]); w.y = pk4_fp8(f[4], f[5], f[6], f[7]); w.z = pk4_fp8(f[8], f[9], f[10], f[11]); w.w = pk4_fp8(f[12], f[13], f[14], f[15]);
            *(u32x4*)((unsigned char*)dst + (size_t)r * ldd + k0 + kk) = w;
        } else { const int kc = (tid & 7) * 8;
#pragma unroll
            for (int rep = 0; rep < 2; ++rep) { const int kk = kc + 64 * rep; float f[8];
#pragma unroll
                for (int j = 0; j < 8; ++j) f[j] = tile[tt_idx(kk + j, n)];
                u32x4 w; w.x = cvt_pk_bf16(f[0], f[1]); w.y = cvt_pk_bf16(f[2], f[3]); w.z = cvt_pk_bf16(f[4], f[5]); w.w = cvt_pk_bf16(f[6], f[7]);
                *(u32x4*)(dst + (size_t)r * ldd + k0 + kk) = w; } } }
}
__device__ __forceinline__ void ttb_load(TReg& R, const float* src, int ld, int k0, int n0, int tid) {
    const int kr = tid >> 4, nq = tid & 15;
#pragma unroll
    for (int rep = 0; rep < 4; ++rep) R.v[rep] = *(const f32x4*)(src + (size_t)(k0 + 4 * kr + rep) * ld + n0 + 4 * nq); }
__device__ __forceinline__ void ttb_put(const TReg& R, LAS unsigned* tile, int tid) {
    const int kr = tid >> 4, nq = tid & 15;
#pragma unroll
    for (int c = 0; c < 4; ++c) { const int n = 4 * nq + c;
        tile[n * 32 + (kr ^ (n & 31))] = pk4_fp8(R.v[0][c] * W_FP8_SCALE, R.v[1][c] * W_FP8_SCALE, R.v[2][c] * W_FP8_SCALE, R.v[3][c] * W_FP8_SCALE); } }
__device__ __forceinline__ void ttb_finish(LAS const unsigned* tile, unsigned char* dst, int ldd, int k0, int n0, int map, int tid) {
    const int n = tid >> 3, kq = tid & 7, m = n & 31, ns = n0 + n; int r = ns;
    if (map == 2) { const int j = ns >> 1, par = ns & 1; r = 256 * (j >> 7) + 128 * par + (j & 127); }
    const u32x4 g = *(LAS const u32x4*)(tile + n * 32 + 4 * (kq ^ (m >> 2)));
    const unsigned a0 = (m & 1) ? g.y : g.x, a1 = (m & 1) ? g.x : g.y, a2 = (m & 1) ? g.w : g.z, a3 = (m & 1) ? g.z : g.w;
    u32x4 w; w.x = (m & 2) ? a2 : a0; w.y = (m & 2) ? a3 : a1; w.z = (m & 2) ? a0 : a2; w.w = (m & 2) ? a1 : a3;
    *(u32x4*)(dst + (size_t)r * ldd + k0 + 16 * kq) = w;
}
template <int K_, int N_, int MAP_> __device__ __forceinline__ void tjob_b(const Ctx& C, int bid, int G, const float* src, unsigned char* dstb, int nbatch) {
    constexpr int kt = K_ / 128, ntile = N_ / 64, per = kt * ntile; const int tot = per * nbatch;
    TReg R0, R1, R2, R3; int kbuf = 0;
#define TB_LOAD(R_, t_) do { const int _t = (t_); if (_t < tot) { const int _b = _t / per, _r = _t % per; ttb_load(R_, src + (size_t)_b * K_ * N_, N_, (_r % kt) * 128, (_r / kt) * 64, C.tid); } } while (0)
#define TB_STEP(R_, t_) do { const int _u = (t_); if (_u < tot) { LAS unsigned* tile = (LAS unsigned*)(C.lds + kbuf * 8192); ttb_put(R_, tile, C.tid); TB_LOAD(R_, _u + 4 * G); __syncthreads(); \
        { const int _b = _u / per, _r = _u % per; ttb_finish(tile, dstb + (size_t)_b * K_ * (MAP_ == 2 ? 4096 : N_), K_, (_r % kt) * 128, (_r / kt) * 64, MAP_, C.tid); } kbuf ^= 1; } } while (0)
    TB_LOAD(R0, bid); TB_LOAD(R1, bid + G); TB_LOAD(R2, bid + 2 * G); TB_LOAD(R3, bid + 3 * G);
    for (int t = bid; t < tot; t += 4 * G) { TB_STEP(R0, t); TB_STEP(R1, t + G); TB_STEP(R2, t + 2 * G); TB_STEP(R3, t + 3 * G); }
    __syncthreads();
#undef TB_LOAD
#undef TB_STEP
}
template <int K_, int N_, int MAP_> __device__ __forceinline__ void tjob_deep(const Ctx& C, int bid, int G, const float* src, unsigned char* dstb, int nbatch) {
    constexpr int kt = K_ / 128, ntile = N_ / 64, per = kt * ntile; const int tot = per * nbatch;
    TReg R0, R1, R2, R3; int kbuf = 0;
#define TD_LOAD(R_, t_) do { const int _t = (t_); if (_t < tot) { const int _b = _t / per, _r = _t % per; tt_load(R_, src + (size_t)_b * K_ * N_, N_, N_, (_r % kt) * 128, (_r / kt) * 64, C.tid); } } while (0)
#define TD_STEP(R_, t_) do { const int _u = (t_); if (_u < tot) { LAS float* tile = (LAS float*)(C.lds + kbuf * TT_TILE_BYTES); tt_put(R_, tile, C.tid); TD_LOAD(R_, _u + 4 * G); __syncthreads(); \
        { const int _b = _u / per, _r = _u % per; tt_finish(tile, (bf16_t*)(dstb + (size_t)_b * K_ * (MAP_ == 2 ? 4096 : N_)), K_, (_r % kt) * 128, (_r / kt) * 64, N_, MAP_, true, C.tid); } kbuf ^= 1; } } while (0)
    TD_LOAD(R0, bid); TD_LOAD(R1, bid + G); TD_LOAD(R2, bid + 2 * G); TD_LOAD(R3, bid + 3 * G);
    for (int t = bid; t < tot; t += 4 * G) { TD_STEP(R0, t); TD_STEP(R1, t + G); TD_STEP(R2, t + 2 * G); TD_STEP(R3, t + 3 * G); }
    __syncthreads();
#undef TD_LOAD
#undef TD_STEP
}
__device__ __forceinline__ void p0_prologue(const Ctx& C) {
    int base = 0;
#define TJOB(IN_, DST_, K_, N_, BATCH_, MAP_, FP8_) TJOBX(IN_, DST_, K_, N_, N_, 0, BATCH_, MAP_, FP8_)
#define TJOBX(IN_, DST_, K_, N_, LD_, COLOFF_, BATCH_, MAP_, FP8_) do { constexpr int kt = (K_) / 128, ntile = ((N_) + 63) / 64, per = kt * ntile, tot = per * (BATCH_); \
        const int first = (C.bid - base % C.G + C.G) % C.G; const float* srcb = C.ka->in[IN_] + (COLOFF_); TReg R; int kbuf = 0; \
        if (first < tot) { const int b = first / per, r = first % per; tt_load(R, srcb + (size_t)b * (K_) * (LD_), (N_), (LD_), (r % kt) * 128, (r / kt) * 64, C.tid); } \
        for (int t = first; t < tot; t += C.G, kbuf ^= 1) { LAS float* tile = (LAS float*)(C.lds + kbuf * TT_TILE_BYTES); \
            tt_put(R, tile, C.tid); \
            { const int tn = t + C.G; if (tn < tot) { const int b = tn / per, r = tn % per; tt_load(R, srcb + (size_t)b * (K_) * (LD_), (N_), (LD_), (r % kt) * 128, (r / kt) * 64, C.tid); } } \
            __syncthreads(); \
            { const int b = t / per, r = t % per; \
              tt_finish(tile, (bf16_t*)(C.ws + (DST_) + (size_t)b * (K_) * ((MAP_) == 2 ? 4096 : (N_)) * ((FP8_) ? 1 : 2)), (K_), (r % kt) * 128, (r / kt) * 64, (N_), (MAP_), (FP8_), C.tid); } } \
        __syncthreads(); base += tot; } while (0)
      TJOBX(I_WIN, WS_WIN, 2048, 1024, IN_COLS, 0, 1, 0, false); TJOBX(I_WIN, WS_WIN8, 2048, IN_COLS - 1024, IN_COLS, 1024, 1, 3, true); TJOB(I_WOUT, WS_WOUT, 2048, 2048, 1, 4, false);
    TJOB(I_WKV, WS_WKV, 2048, 1024, 1, 0, true); TJOB(I_CK1, WS_CK1, 4096, 128, 1, 0, false); TJOB(I_CV1, WS_CV1, 4096, 128, 1, 0, false); TJOB(I_CK2, WS_CK2, 128, 128, 1, 0, false); TJOB(I_CV2, WS_CV2, 128, 128, 1, 0, false);
#undef TJOB
#undef TJOBX
    const int gw = C.bid * 8 + C.wave, NWV = C.G * 8, lane = C.lane;
    for (int row = gw; row < T_ + NB * MEMT; row += NWV) {
        const bool ismem = row >= T_; const float* src = ismem ? C.ka->in[I_MEM] + (size_t)(row - T_) * D_ : C.ka->in[I_X] + (size_t)row * D_;
        const float* gv = ismem ? C.ka->in[I_MEMG] : C.ka->in[I_MIXG]; bf16_t* dst = WSP(bf16_t, WS_H) + (size_t)row * D_; unsigned char* d8 = ismem ? WSP(unsigned char, WS_MEMN) + (size_t)(row - T_) * D_ : WSP(unsigned char, WS_H8) + (size_t)row * D_;
        f32x4 v[8]; float ss = 0.f;
#pragma unroll
        for (int c = 0; c < 8; ++c) { v[c] = *(const f32x4*)(src + c * 256 + lane * 4); ss += (v[c][0] * v[c][0] + v[c][1] * v[c][1]) + (v[c][2] * v[c][2] + v[c][3] * v[c][3]); }
        ss = wave_sum(ss); const float rs = rsqrtf(ss * (1.0f / D_) + EPS);
#pragma unroll
        for (int c = 0; c < 8; ++c) { const f32x4 g4 = *(const f32x4*)(gv + c * 256 + lane * 4); const float h0 = v[c][0] * rs * g4[0], h1 = v[c][1] * rs * g4[1], h2 = v[c][2] * rs * g4[2], h3 = v[c][3] * rs * g4[3];
            if (!ismem) { u32x2 w; w.x = cvt_pk_bf16(h0, h1); w.y = cvt_pk_bf16(h2, h3); *(u32x2*)(dst + c * 256 + lane * 4) = w; }
            *(unsigned*)(d8 + c * 256 + lane * 4) = pk4_fp8(h0, h1, h2, h3); }
    }
    const size_t gt = (size_t)C.bid * 512 + C.tid, GT = (size_t)C.G * 512;
    for (size_t i = gt; i < (size_t)32 * D_; i += GT) {
        const int e = (int)(i / D_), k = (int)(i % D_); const float w = C.ka->in[I_WR][(size_t)k * 32 + e]; const bf16_t hi = f2bf(w); WSP(bf16_t, WS_WRH)[i] = hi; WSP(bf16_t, WS_WRL)[i] = f2bf(w - bf2f(hi)); }
    for (size_t i = gt; i < (size_t)NEXP * D_; i += GT) WSP(float, WS_B2C)[i] = C.ka->in[I_BE2][i];
    for (size_t i = gt; i < (size_t)NEXP * FF; i += GT) {
        const int e = (int)(i / FF), j = (int)(i % FF); WSP(float, WS_B1G)[i] = C.ka->in[I_BE1][(size_t)e * 4096 + 2 * j]; WSP(float, WS_B1L)[i] = C.ka->in[I_BE1][(size_t)e * 4096 + 2 * j + 1]; }
    for (size_t i = gt; i < (size_t)4 * 128 * 128; i += GT) {
        const int s = (int)(i & 127), t = (int)((i >> 7) & 127); WSP(bf16_t, WS_GWS)[i] = s <= t ? f2bf(C.ka->in[I_GWS][i]) : (bf16_t)0; }
    if (C.bid == 0) {
        if (C.tid < 64) WSP(float, WS_MISC)[C.tid] = (float)pow(10000.0, -(double)C.tid / 64.0);
        if (C.wave == 1) {
            float a = fmaxf(fabsf(C.ka->in[I_NQG][lane]), fabsf(C.ka->in[I_NQG][lane + 64])), b = fmaxf(fabsf(C.ka->in[I_NKG][lane]), fabsf(C.ka->in[I_NKG][lane + 64]));
            float c = fmaxf(fabsf(C.ka->in[I_XQG][lane]), fabsf(C.ka->in[I_XQG][lane + 64])), d = fmaxf(fabsf(C.ka->in[I_XKG][lane]), fabsf(C.ka->in[I_XKG][lane + 64]));
            for (int o = 32; o >= 1; o >>= 1) { a = fmaxf(a, __shfl_xor(a, o)); b = fmaxf(b, __shfl_xor(b, o)); c = fmaxf(c, __shfl_xor(c, o)); d = fmaxf(d, __shfl_xor(d, o)); }
            if (lane == 0) { WSP(float, WS_MISC)[64] = 11.313708499f * a * b * 1.4426950409f; WSP(float, WS_MISC)[65] = 11.313708499f * c * d * 1.4426950409f; } }
    }
    for (int job = C.bid; job < 64; job += C.G) { const int m = job >> 5, j = job & 31;
        const float* w1 = m == 0 ? C.ka->in[I_CK1] : C.ka->in[I_CV1]; const float* pos = C.ka->in[I_CPOS]; LAS float* red = (LAS float*)C.lds;
        const int o = C.tid & 127, part = C.tid >> 7; float s = 0.f; const int k0 = j * 128 + part * 32;
#pragma unroll
        for (int kk = 0; kk < 32; ++kk) s += pos[k0 + kk] * w1[(size_t)(k0 + kk) * 128 + o];
        __syncthreads(); red[C.tid] = s; __syncthreads();
        if (C.tid < 128) ((float*)(C.ws + WS_CTL + 32768))[(m * 32 + j) * 128 + o] = (red[o] + red[128 + o]) + (red[256 + o] + red[384 + o]);
    }
    __syncthreads();
}
__device__ __forceinline__ float row16_sum(float v) { v += dppf<0xB1>(v); v += dppf<0x4E>(v); v += dppf<0x141>(v); v += dppf<0x140>(v); return v; }
__device__ __forceinline__ void unpack8(const u32x4 w, float (&f)[8]) {
    f[0] = __uint_as_float(w.x << 16); f[1] = __uint_as_float(w.x & 0xFFFF0000u); f[2] = __uint_as_float(w.y << 16); f[3] = __uint_as_float(w.y & 0xFFFF0000u);
    f[4] = __uint_as_float(w.z << 16); f[5] = __uint_as_float(w.z & 0xFFFF0000u); f[6] = __uint_as_float(w.w << 16); f[7] = __uint_as_float(w.w & 0xFFFF0000u); }
__device__ __forceinline__ u32x4 pack8u(const float (&f)[8]) { u32x4 w; w.x = cvt_pk_bf16(f[0], f[1]); w.y = cvt_pk_bf16(f[2], f[3]); w.z = cvt_pk_bf16(f[4], f[5]); w.w = cvt_pk_bf16(f[6], f[7]); return w; }
__device__ __forceinline__ u32x4 ror8(const u32x4 w) { u32x4 o; o.x = dppu<0x128>(w.x); o.y = dppu<0x128>(w.y); o.z = dppu<0x128>(w.z); o.w = dppu<0x128>(w.w); return o; }
__device__ __forceinline__ void p2_token_prep(const Ctx& C) {
    const int gw = C.bid * 8 + C.wave, NWV = C.G * 8, L = C.lane, r = L & 15, rowid = L >> 4, rp = r ^ 8;
    if (C.bid == 0 && C.tid < 256) { const float* cp = (const float*)(C.ws + WS_CTL + 32768) + (C.tid >> 7) * 32 * 128 + (C.tid & 127); float s = 0.f;
        for (int j = 0; j < 32; ++j) s += cp[j * 128];
        WSP(float, WS_C1)[C.tid] = s; }
    const bf16_t* PROJ = WSP(bf16_t, WS_PROJ);
    LAS bf16_t* TS = (LAS bf16_t*)C.lds; LAS bf16_t* TW = (LAS bf16_t*)(C.lds + 32768); LAS bf16_t* TG = (LAS bf16_t*)(C.lds + 65536);
    LAS float* cs = (LAS float*)(C.lds + 131072 + C.wave * 512);
    const float inv = WSP(float, WS_MISC)[L];
    float qgo[8], qgp[8], kgo[8], kgp[8], xgo[8], gvo[8];
#pragma unroll
    for (int j = 0; j < 8; ++j) { qgo[j] = C.ka->in[I_NQG][8 * r + j]; qgp[j] = C.ka->in[I_NQG][8 * rp + j]; kgo[j] = C.ka->in[I_NKG][8 * r + j]; kgp[j] = C.ka->in[I_NKG][8 * rp + j];
        xgo[j] = C.ka->in[I_XQG][8 * r + j]; gvo[j] = C.ka->in[I_GVG][rowid * 128 + 8 * r + j]; }
    const float sgn = r < 8 ? -1.0f : 1.0f;
    for (int unit = C.bid; unit < T_ / 64; unit += C.G) {
      for (int tl = 0; tl < 8; ++tl) {
        const int tok = 8 * C.wave + tl, t = unit * 64 + tok;
        const bf16_t* pr = PROJ + (size_t)t * NPROJ + 8 * L; const int b = t / S_, s = t % S_;
        u32x4 ld[8];
#pragma unroll
        for (int m = 0; m < 8; ++m) ld[m] = *(const u32x4*)(pr + 512 * m);
        { const float ang = (float)((const int*)C.ka->in[I_POS])[t] * inv; float sn, c; sincosf(ang, &sn, &c); cs[L] = c; cs[64 + L] = sn; }
        float cw[8], sw[8];
        { const f32x4 c0 = *(const LAS f32x4*)(cs + 8 * (r & 7)), c1 = *(const LAS f32x4*)(cs + 8 * (r & 7) + 4), s0 = *(const LAS f32x4*)(cs + 64 + 8 * (r & 7)), s1 = *(const LAS f32x4*)(cs + 64 + 8 * (r & 7) + 4);
#pragma unroll
          for (int j = 0; j < 4; ++j) { cw[j] = c0[j]; cw[4 + j] = c1[j]; sw[j] = s0[j] * sgn; sw[4 + j] = s1[j] * sgn; } }
        float f[8], fp[8], o[8];
        { unpack8(ld[0], f);
#pragma unroll
          for (int j = 0; j < 8; ++j) o[j] = gelu_tanh(f[j]);
          *(u32x4*)(WSP(bf16_t, WS_UB) + (size_t)t * 512 + 128 * rowid + 8 * r) = pack8u(o); }
        { unpack8(ld[1], f); float ss = 0.f;
#pragma unroll
          for (int j = 0; j < 8; ++j) { f[j] = gelu_tanh(f[j]); ss += f[j] * f[j]; }
          const float rn = rsqrtf(row16_sum(ss) * (1.0f / 128.0f) + EPS);
          LAS bf16_t* vt = TG + (rowid * 128 + 8 * r) * 64 + tok;
#pragma unroll
          for (int j = 0; j < 8; ++j) vt[j * 64] = f2bf(f[j] * rn * gvo[j]); }
#pragma unroll
        for (int m = 2; m < 4; ++m) { unpack8(ld[m], f); unpack8(ror8(ld[m]), fp); float ss = 0.f;
#pragma unroll
            for (int j = 0; j < 8; ++j) ss += f[j] * f[j];
            const float rn = rsqrtf(row16_sum(ss) * (1.0f / 128.0f) + EPS); const int h = 4 * (m - 2) + rowid;
#pragma unroll
            for (int j = 0; j < 8; ++j) { f[j] *= rn * qgo[j]; o[j] = f[j] * cw[j] + fp[j] * rn * qgp[j] * sw[j]; }
            *(u32x4*)(WSP(bf16_t, WS_QN) + (size_t)t * 1024 + h * 128 + 8 * r) = pack8u(f);
            *(u32x4*)(WSP(bf16_t, WS_QR) + (size_t)t * 1024 + h * 128 + 8 * r) = pack8u(o); }
        { const size_t rowkv = ((size_t)(b * 2 + (rowid & 1)) * S_ + s) * 128 + 8 * r; *(u32x4*)(WSP(bf16_t, rowid < 2 ? WS_KCMP : WS_VCMP) + rowkv) = ld[4]; }
#pragma unroll
        for (int m = 5; m < 7; ++m) { unpack8(ld[m], f); unpack8(ror8(ld[m]), fp); float ss = 0.f;
#pragma unroll
            for (int j = 0; j < 8; ++j) ss += f[j] * f[j];
            const float rn = rsqrtf(row16_sum(ss) * (1.0f / 128.0f) + EPS); const int g = rowid & 1;
            if (rowid < 2) {
#pragma unroll
                for (int j = 0; j < 8; ++j) o[j] = f[j] * rn * kgo[j] * cw[j] + fp[j] * rn * kgp[j] * sw[j];
                *(u32x4*)(WSP(bf16_t, m == 5 ? WS_KSEL : WS_KWIN) + ((size_t)(b * 2 + g) * S_ + s) * 128 + 8 * r) = pack8u(o);
            } else { LAS bf16_t* d = (m == 5 ? TS : TW) + (g * 128 + 8 * r) * 64 + tok;
                const u32x4 wv = ld[m];
                d[0] = (bf16_t)(wv.x & 0xFFFFu); d[64] = (bf16_t)(wv.x >> 16); d[128] = (bf16_t)(wv.y & 0xFFFFu); d[192] = (bf16_t)(wv.y >> 16);
                d[256] = (bf16_t)(wv.z & 0xFFFFu); d[320] = (bf16_t)(wv.z >> 16); d[384] = (bf16_t)(wv.w & 0xFFFFu); d[448] = (bf16_t)(wv.w >> 16); } }
        { unpack8(ld[7], f); float ss = 0.f;
#pragma unroll
          for (int j = 0; j < 8; ++j) ss += f[j] * f[j];
          const float rn = rsqrtf(row16_sum(ss) * (1.0f / 128.0f) + EPS);
#pragma unroll
          for (int j = 0; j < 8; ++j) o[j] = f[j] * rn * xgo[j];
          *(u32x4*)(WSP(bf16_t, WS_QX) + (size_t)t * 512 + rowid * 128 + 8 * r) = pack8u(o); }
        if (L < 24) WSP(float, WS_GATES)[(size_t)t * 24 + L] = sigmoidf_(bf2f(PROJ[(size_t)t * NPROJ + C_GATE + L]));
      }
      __syncthreads();
      { const int t0 = unit * 64, b = t0 / S_, s0 = t0 % S_;
#pragma unroll
        for (int k = 0; k < 4; ++k) { const int c = C.tid + 512 * k, g = c >> 10;
            const size_t dst = ((size_t)(b * 2 + g) * 256 + (s0 >> 6)) * 8192 + (size_t)(c & 1023) * 8;
            *(u32x4*)(WSP(bf16_t, WS_VSELT) + dst) = *(const LAS u32x4*)(TS + c * 8); *(u32x4*)(WSP(bf16_t, WS_VWINT) + dst) = *(const LAS u32x4*)(TW + c * 8); }
#pragma unroll
        for (int k = 0; k < 8; ++k) { const int c = C.tid + 512 * k, row = c >> 3, ch = c & 7;
            *(u32x4*)(WSP(bf16_t, WS_VTG) + ((size_t)(t0 >> 7) * 512 + row) * 128 + ((t0 >> 6) & 1) * 64 + ch * 8) = *(const LAS u32x4*)(TG + c * 8); } }
      __syncthreads();
    }
    const int i = C.lane;
    const float mg0 = C.ka->in[I_XKG][i], mg1 = C.ka->in[I_XKG][i + 64];
    for (int m = gw; m < NB * MEMT; m += NWV) { const bf16_t* pr = WSP(bf16_t, WS_MEMKV) + (size_t)m * 1024; const int b = m / MEMT, mm = m % MEMT;
#pragma unroll
        for (int h = 0; h < 4; ++h) { const float a = bf2f(pr[h * 128 + i]), bb = bf2f(pr[h * 128 + 64 + i]); const float r = rsqrtf(wave_sum(a * a + bb * bb) * (1.0f / 128.0f) + EPS);
            bf16_t* k = WSP(bf16_t, WS_KX) + ((size_t)(b * 4 + h) * 256 + mm) * 128; k[i] = f2bf(a * r * mg0); k[i + 64] = f2bf(bb * r * mg1);
            bf16_t* v = WSP(bf16_t, WS_VXT) + ((size_t)(b * 4 + h) * 4 + (mm >> 6)) * 128 * 64 + (mm & 63); v[(size_t)i * 64] = pr[512 + h * 128 + i]; v[(size_t)(i + 64) * 64] = pr[512 + h * 128 + 64 + i]; } }
}

struct QF { bf16x8 f[4]; };
enum { MODE_NONE = 0, MODE_WIN = 1, MODE_CMP = 2, MODE_SEL = 3 };
__device__ __forceinline__ QF load_qf(const bf16_t* qrow, int g) { QF q;
#pragma unroll
    for (int ks = 0; ks < 4; ++ks) q.f[ks] = *(const bf16x8*)(qrow + 32 * ks + 8 * g);
    return q; }
template <int MODE> __device__ __forceinline__ void qk_group(const QF& q, const bf16_t* Kblk, int kg, int i, int g, int tq, int kbase, float c2, float mb, float (&p)[8]) {
    f32x4 s0 = {0.f, 0.f, 0.f, 0.f}, s1 = {0.f, 0.f, 0.f, 0.f};
    const bf16_t* k0 = Kblk + (size_t)(32 * kg + 8 * (i >> 2) + (i & 3)) * 128 + 8 * g;
#pragma unroll
    for (int ks = 0; ks < 4; ++ks) { const bf16x8 a0 = *(const bf16x8*)(k0 + 32 * ks), a1 = *(const bf16x8*)(k0 + 4 * 128 + 32 * ks);
        s0 = __builtin_amdgcn_mfma_f32_16x16x32_bf16(a0, q.f[ks], s0, 0, 0, 0); s1 = __builtin_amdgcn_mfma_f32_16x16x32_bf16(a1, q.f[ks], s1, 0, 0, 0); }
#pragma unroll
    for (int r = 0; r < 8; ++r) { const int key = kbase + 32 * kg + 8 * g + r; const float sv = r < 4 ? s0[r & 3] : s1[r & 3];
        bool valid = true;
        if (MODE == MODE_WIN) valid = (key <= tq) && (key > tq - 512);
        if (MODE == MODE_CMP) valid = (16 * key + 31 <= tq);
        if (MODE == MODE_SEL) valid = (key <= tq);
        p[r] = valid ? __builtin_amdgcn_exp2f(sv * c2 - mb) : 0.f; }
}
__device__ __forceinline__ void pv_group(const float (&p)[8], const bf16_t* VTblk, int kg, int i, int g, f32x4 (&O)[8]) {
    const bf16x8 pf = pack8(p[0], p[1], p[2], p[3], p[4], p[5], p[6], p[7]);
    const bf16_t* v0 = VTblk + (size_t)i * 64 + 32 * kg + 8 * g;
#pragma unroll
    for (int dt = 0; dt < 8; ++dt) { const bf16x8 vt = *(const bf16x8*)(v0 + (size_t)dt * 16 * 64); O[dt] = __builtin_amdgcn_mfma_f32_16x16x32_bf16(vt, pf, O[dt], 0, 0, 0); }
}
template <int MODE> __device__ __forceinline__ void attn_block(const QF& q, const bf16_t* Kblk, const bf16_t* VTblk, f32x4 (&O)[8], float& l, int i, int g, int tq, int kbase, float c2, float mb) {
#pragma unroll
    for (int kg = 0; kg < 2; ++kg) { float p[8]; qk_group<MODE>(q, Kblk, kg, i, g, tq, kbase, c2, mb, p);
        l += ((p[0] + p[1]) + (p[2] + p[3])) + ((p[4] + p[5]) + (p[6] + p[7]));
        pv_group(p, VTblk, kg, i, g, O); }
}
constexpr float C2_ = 0.08838834764831845f * 1.4426950408889634f;
__device__ __forceinline__ void compress_coop(const Ctx& C) {
    const int w = C.wave, lane = C.lane, i = lane & 15, g4 = lane >> 4, half = w >> 2, kq = w & 3;
    LAS float* part = (LAS float*)C.lds;
    for (int pair = C.bid; pair < 256; pair += C.G) {
        const int task = pair * 2 + half;
        const int kv = task >> 8, bg = (task >> 6) & 3, rt = task & 63, n = 16 * rt + i;
        const bf16_t* src = WSP(bf16_t, kv ? WS_VCMP : WS_KCMP) + (size_t)bg * S_ * 128;
        const bf16_t* w1T = WSP(bf16_t, kv ? WS_CV1 : WS_CK1);
        const bf16_t* brow = src + (size_t)(16 * n) * 128 + 8 * g4 + 1024 * kq;
        const bf16_t* arow = w1T + (size_t)i * 4096 + 8 * g4 + 1024 * kq;
        f32x4 acc[8];
#pragma unroll
        for (int ot = 0; ot < 8; ++ot) acc[ot] = (f32x4){0.f, 0.f, 0.f, 0.f};
        bf16x8 bN = *(const bf16x8*)brow, aN[8], bM = *(const bf16x8*)(brow + 32), aM[8];
#pragma unroll
        for (int ot = 0; ot < 8; ++ot) { aN[ot] = *(const bf16x8*)(arow + (size_t)ot * 16 * 4096); aM[ot] = *(const bf16x8*)(arow + (size_t)ot * 16 * 4096 + 32); }
        for (int ks = 0; ks < 32; ++ks) { const bf16x8 bfr = bN; bf16x8 a[8];
#pragma unroll
            for (int ot = 0; ot < 8; ++ot) { a[ot] = aN[ot]; aN[ot] = aM[ot]; }
            bN = bM;
            const int kn = ks + 2 < 32 ? ks + 2 : 31;
            bM = *(const bf16x8*)(brow + 32 * kn);
#pragma unroll
            for (int ot = 0; ot < 8; ++ot) aM[ot] = *(const bf16x8*)(arow + (size_t)ot * 16 * 4096 + 32 * kn);
#pragma unroll
            for (int ot = 0; ot < 8; ++ot) acc[ot] = __builtin_amdgcn_mfma_f32_16x16x32_bf16(a[ot], bfr, acc[ot], 0, 0, 0); }
#pragma unroll
        for (int ot = 0; ot < 8; ++ot) *(LAS f32x4*)(part + (((half * 4 + kq) * 8 + ot) * 64 + lane) * 4) = acc[ot];
        __syncthreads();
        if (kq == 0) {
#pragma unroll
            for (int ot = 0; ot < 8; ++ot) { acc[ot] = *(const LAS f32x4*)(part + (((half * 4 + 0) * 8 + ot) * 64 + lane) * 4);
#pragma unroll
                for (int qq = 1; qq < 4; ++qq) acc[ot] += *(const LAS f32x4*)(part + (((half * 4 + qq) * 8 + ot) * 64 + lane) * 4); }
            const float* c1 = WSP(float, WS_C1) + kv * 128;
#pragma unroll
            for (int ot = 0; ot < 8; ++ot) { const f32x4 cb = *(const f32x4*)(c1 + 16 * ot + 4 * g4);
#pragma unroll
                for (int r = 0; r < 4; ++r) acc[ot][r] = gelu_tanh(acc[ot][r] + cb[r]); }
            const bf16_t* w2T = WSP(bf16_t, kv ? WS_CV2 : WS_CK2);
            f32x4 acc2[8];
#pragma unroll
            for (int ot = 0; ot < 8; ++ot) acc2[ot] = (f32x4){0.f, 0.f, 0.f, 0.f};
#pragma unroll
            for (int ks2 = 0; ks2 < 4; ++ks2) {
                const bf16x8 pf = pack8(acc[2 * ks2][0], acc[2 * ks2][1], acc[2 * ks2][2], acc[2 * ks2][3], acc[2 * ks2 + 1][0], acc[2 * ks2 + 1][1], acc[2 * ks2 + 1][2], acc[2 * ks2 + 1][3]);
#pragma unroll
                for (int o2t = 0; o2t < 8; ++o2t) { const bf16_t* wr = w2T + (size_t)(16 * o2t + i) * 128 + 32 * ks2 + 4 * g4;
                    const u32x2 lo = *(const u32x2*)wr, hi = *(const u32x2*)(wr + 16); const u32x4 wv = {lo.x, lo.y, hi.x, hi.y};
                    acc2[o2t] = __builtin_amdgcn_mfma_f32_16x16x32_bf16(__builtin_bit_cast(bf16x8, wv), pf, acc2[o2t], 0, 0, 0); } }
            const bool pad = (n == 1023);
            if (kv == 0) {
                float ss = 0.f;
#pragma unroll
                for (int o2t = 0; o2t < 8; ++o2t) ss += (acc2[o2t][0] * acc2[o2t][0] + acc2[o2t][1] * acc2[o2t][1]) + (acc2[o2t][2] * acc2[o2t][2] + acc2[o2t][3] * acc2[o2t][3]);
                ss += __shfl_xor(ss, 16); ss += __shfl_xor(ss, 32);
                const float r = pad ? 0.f : rsqrtf(ss * (1.0f / 128.0f) + EPS);
                bf16_t* dst = WSP(bf16_t, WS_KC) + ((size_t)bg * 1024 + n) * 128;
                const float* nkg = C.ka->in[I_NKG] + 4 * g4; f32x4 kgv[8];
#pragma unroll
                for (int o2t = 0; o2t < 8; ++o2t) kgv[o2t] = *(const f32x4*)(nkg + 16 * o2t);
#pragma unroll
                for (int o2t = 0; o2t < 8; ++o2t) { const f32x4 kg = kgv[o2t]; u32x2 wv;
                    wv.x = cvt_pk_bf16(acc2[o2t][0] * r * kg[0], acc2[o2t][1] * r * kg[1]); wv.y = cvt_pk_bf16(acc2[o2t][2] * r * kg[2], acc2[o2t][3] * r * kg[3]);
                    *(u32x2*)(dst + 16 * o2t + 4 * g4) = wv; }
            } else {
                bf16_t* dst = WSP(bf16_t, WS_VCT) + ((size_t)bg * 16 + (n >> 6)) * 128 * 64 + (n & 63);
#pragma unroll
                for (int o2t = 0; o2t < 8; ++o2t)
#pragma unroll
                    for (int r = 0; r < 4; ++r) dst[(size_t)(16 * o2t + 4 * g4 + r) * 64] = pad ? (bf16_t)0 : f2bf(acc2[o2t][r]);
            }
        }
        __syncthreads();
    }
}
__device__ __forceinline__ void gmlp_task(const Ctx& C, int task) {
    const int i = C.lane & 15, g4 = C.lane >> 4;
    const int tt = task & 7, gg = (task >> 3) & 3, ch = task >> 5;
    const bf16_t* arow = WSP(bf16_t, WS_VTG) + ((size_t)(ch * 4 + gg) * 128 + i) * 128 + 8 * g4;
    const bf16_t* brow = WSP(bf16_t, WS_GWS) + ((size_t)gg * 128 + 16 * tt + i) * 128 + 8 * g4;
    f32x4 acc[8];
#pragma unroll
    for (int dt = 0; dt < 8; ++dt) acc[dt] = (f32x4){0.f, 0.f, 0.f, 0.f};
    bf16x8 bfr[4], af[4][8];
#pragma unroll
    for (int ks = 0; ks < 4; ++ks) { bfr[ks] = *(const bf16x8*)(brow + 32 * ks);
#pragma unroll
        for (int dt = 0; dt < 8; ++dt) af[ks][dt] = *(const bf16x8*)(arow + (size_t)dt * 16 * 128 + 32 * ks); }
    const int tok = ch * 128 + 16 * tt + i; const float bs = C.ka->in[I_GBS][gg * 128 + 16 * tt + i];
    const bf16_t* ub = WSP(bf16_t, WS_UB) + (size_t)tok * 512 + gg * 128 + 4 * g4; bf16_t* mix = (bf16_t*)(WSP(unsigned char, WS_MIX) + (size_t)tok * MIXP) + gg * 128 + 4 * g4;
    u32x2 uq[8];
#pragma unroll
    for (int dt = 0; dt < 8; ++dt) uq[dt] = *(const u32x2*)(ub + 16 * dt);
#pragma unroll
    for (int ks = 0; ks < 4; ++ks)
#pragma unroll
        for (int dt = 0; dt < 8; ++dt) acc[dt] = __builtin_amdgcn_mfma_f32_16x16x32_bf16(af[ks][dt], bfr[ks], acc[dt], 0, 0, 0);
#pragma unroll
    for (int dt = 0; dt < 8; ++dt) { const u32x2 uu = uq[dt];
        const float u0 = __uint_as_float(uu.x << 16), u1 = __uint_as_float(uu.x & 0xFFFF0000u), u2 = __uint_as_float(uu.y << 16), u3 = __uint_as_float(uu.y & 0xFFFF0000u);
        u32x2 w; w.x = cvt_pk_bf16(MIX_SCALE * u0 * (acc[dt][0] + bs), MIX_SCALE * u1 * (acc[dt][1] + bs)); w.y = cvt_pk_bf16(MIX_SCALE * u2 * (acc[dt][2] + bs), MIX_SCALE * u3 * (acc[dt][3] + bs));
        *(u32x2*)(mix + 16 * dt) = w; }
}
__device__ __forceinline__ void window_task(const Ctx& C, int task) {
    const int i = C.lane & 15, g4 = C.lane >> 4;
    const int qt = task & 1023, h = (task >> 10) & 7, b = task >> 13, bg = b * 2 + (h >> 2);
    const int t0 = 16 * qt, tq = t0 + i; const size_t t = (size_t)b * S_ + tq;
    const float mb = WSP(float, WS_MISC)[64];
    const QF qf = load_qf(WSP(bf16_t, WS_QR) + t * 1024 + h * 128, g4);
    f32x4 O[8];
#pragma unroll
    for (int dt = 0; dt < 8; ++dt) O[dt] = (f32x4){0.f, 0.f, 0.f, 0.f};
    float l = 0.f;
    const int blo = (t0 - 511 > 0 ? t0 - 511 : 0) >> 6, bhi = (t0 + 15) >> 6;
    for (int blk = blo; blk <= bhi; ++blk)
        attn_block<MODE_WIN>(qf, WSP(bf16_t, WS_KWIN) + ((size_t)bg * S_ + 64 * blk) * 128, WSP(bf16_t, WS_VWINT) + ((size_t)bg * 256 + blk) * 8192, O, l, i, g4, tq, 64 * blk, C2_, mb);
    l += __shfl_xor(l, 16); l += __shfl_xor(l, 32);
    const float sc = (l > 0.f ? 1.0f / l : 0.f) * WSP(float, WS_GATES)[t * 24 + h * 3 + 2];
    float* dst = WSP(float, WS_MIXACC) + t * 1024 + h * 128 + 4 * g4;
#pragma unroll
    for (int dt = 0; dt < 8; ++dt) *(f32x4*)(dst + 16 * dt) = O[dt] * sc;
}
__device__ __forceinline__ void xattn_task(const Ctx& C, int task) {
    const int i = C.lane & 15, g4 = C.lane >> 4;
    const int qt = task & 1023, hx = (task >> 10) & 3, b = task >> 12;
    const int tq = 16 * qt + i; const size_t t = (size_t)b * S_ + tq;
    const float mb = WSP(float, WS_MISC)[65];
    const QF qf = load_qf(WSP(bf16_t, WS_QX) + t * 512 + hx * 128, g4);
    f32x4 O[8];
#pragma unroll
    for (int dt = 0; dt < 8; ++dt) O[dt] = (f32x4){0.f, 0.f, 0.f, 0.f};
    float l = 0.f;
    for (int blk = 0; blk < 4; ++blk)
        attn_block<MODE_NONE>(qf, WSP(bf16_t, WS_KX) + ((size_t)(b * 4 + hx) * 256 + 64 * blk) * 128, WSP(bf16_t, WS_VXT) + ((size_t)(b * 4 + hx) * 4 + blk) * 8192, O, l, i, g4, tq, 64 * blk, C2_, mb);
    l += __shfl_xor(l, 16); l += __shfl_xor(l, 32);
    const float sc = l > 0.f ? 1.0f / l : 0.f;
    bf16_t* dst = WSP(bf16_t, WS_MIX) + t * D_ + 1536 + hx * 128 + 4 * g4;
#pragma unroll
    for (int dt = 0; dt < 8; ++dt) { u32x2 w; w.x = cvt_pk_bf16(O[dt][0] * sc, O[dt][1] * sc); w.y = cvt_pk_bf16(O[dt][2] * sc, O[dt][3] * sc); *(u32x2*)(dst + 16 * dt) = w; }
}
constexpr int P3_NX = NB * 4 * 1024, P3_NG = 256 * 4 * 8;
#ifndef MK_REPEAT
#define MK_REPEAT 0
#endif
__device__ __forceinline__ void p3_tasks(const Ctx& C) {
    for (int rep = 0; rep < 1 + ((MK_REPEAT >> 12) & 1); ++rep) compress_coop(C);
    const int gw = C.bid * 8 + C.wave, NWV = C.G * 8;
    for (int rep = 0; rep < 1 + ((MK_REPEAT >> 14) & 1); ++rep) for (int task = gw; task < P3_NG; task += NWV) gmlp_task(C, task);
}

__device__ __forceinline__ void p4_compressed(const Ctx& C) {
    const int gw = C.bid * 8 + C.wave, NWV = C.G * 8, lane = C.lane, i = lane & 15, g4 = lane >> 4;
    LAS float* imp = (LAS float*)(C.lds + C.wave * 16448);
    const float mb = WSP(float, WS_MISC)[64];
    const int NTASK = 4 * 1024;
    for (int task = gw; task < NTASK; task += NWV) {
        const int round = task / NWV, base = NWV * round, cntr = (NTASK - base) < NWV ? (NTASK - base) : NWV, off = task - base;
        const int tk = base + ((round & 1) ? cntr - 1 - off : off);
        const int qt = 1023 - (tk >> 2), bg = tk & 3, b = bg >> 1, g = bg & 1;
        const int t0 = 16 * qt, tq = t0 + i; const size_t t = (size_t)b * S_ + tq;
        for (int k = lane; k < 16 * 257; k += 64) imp[k] = 0.f;
        const int nb = (qt + 63) >> 6;
        const bf16_t* KC = WSP(bf16_t, WS_KC) + (size_t)bg * 1024 * 128; const bf16_t* VCT = WSP(bf16_t, WS_VCT) + (size_t)bg * 16 * 8192;
        float invl[4];
#pragma unroll
        for (int r = 0; r < 4; ++r) { const QF qf = load_qf(WSP(bf16_t, WS_QN) + t * 1024 + (g * 4 + r) * 128, g4); float l = 0.f;
            for (int blk = 0; blk < nb; ++blk)
#pragma unroll
                for (int kg = 0; kg < 2; ++kg) { float p[8]; qk_group<MODE_CMP>(qf, KC + (size_t)blk * 64 * 128, kg, i, g4, tq, 64 * blk, C2_, mb, p); l += ((p[0] + p[1]) + (p[2] + p[3])) + ((p[4] + p[5]) + (p[6] + p[7])); }
            l += __shfl_xor(l, 16); l += __shfl_xor(l, 32); invl[r] = l > 0.f ? 1.0f / l : 0.f; }
#pragma unroll
        for (int r = 0; r < 4; ++r) { const QF qf = load_qf(WSP(bf16_t, WS_QN) + t * 1024 + (g * 4 + r) * 128, g4);
            f32x4 O[8];
#pragma unroll
            for (int dt = 0; dt < 8; ++dt) O[dt] = (f32x4){0.f, 0.f, 0.f, 0.f};
            for (int blk = 0; blk < nb; ++blk)
#pragma unroll
                for (int kg = 0; kg < 2; ++kg) { float p[8]; qk_group<MODE_CMP>(qf, KC + (size_t)blk * 64 * 128, kg, i, g4, tq, 64 * blk, C2_, mb, p);
#pragma unroll
                    for (int j = 0; j < 8; ++j) p[j] *= invl[r];
                    LAS float* ip = imp + i * 257 + 16 * blk + 8 * kg + 2 * g4;
                    __hip_atomic_fetch_add(ip, 2.0f * (p[0] + p[1] + p[2]) + p[3], __ATOMIC_RELAXED, __HIP_MEMORY_SCOPE_WORKGROUP);
                    __hip_atomic_fetch_add(ip + 1, p[3] + 2.0f * (p[4] + p[5] + p[6]) + p[7], __ATOMIC_RELAXED, __HIP_MEMORY_SCOPE_WORKGROUP);
                    __hip_atomic_fetch_add(ip + 2, p[7], __ATOMIC_RELAXED, __HIP_MEMORY_SCOPE_WORKGROUP);
                    pv_group(p, VCT + (size_t)blk * 8192, kg, i, g4, O); }
            const float gate = WSP(float, WS_GATES)[t * 24 + (g * 4 + r) * 3 + 0];
            float* dst = WSP(float, WS_MIXACC) + t * 1024 + (g * 4 + r) * 128 + 4 * g4;
#pragma unroll
            for (int dt = 0; dt < 8; ++dt) { const f32x4 old = *(const f32x4*)(dst + 16 * dt); *(f32x4*)(dst + 16 * dt) = old + O[dt] * gate; } }
        const int cur = t0 >> 6; int* idx = WSP(int, WS_IDX) + ((size_t)bg * S_ + t0) * 16;
        if (cur <= 15) { for (int q = 0; q < 16; ++q) if (lane < 16) idx[q * 16 + lane] = lane <= cur ? lane : -1; }
        else {
            for (int q = 0; q < 16; ++q) {
                unsigned key[4];
#pragma unroll
                for (int c = 0; c < 4; ++c) { const int j = lane + 64 * c; const float v = imp[q * 257 + j]; key[c] = (j >= 1 && j <= cur - 2) ? ((__float_as_uint(v) & 0xFFFFFF00u) | (unsigned)(255 - j)) : 0u; }
                int mypick = lane == 0 ? 0 : (lane == 1 ? cur - 1 : (lane == 2 ? cur : -1));
                for (int rd = 0; rd < 13; ++rd) {
                    unsigned m = key[0] > key[1] ? key[0] : key[1]; const unsigned m2 = key[2] > key[3] ? key[2] : key[3]; m = m > m2 ? m : m2;
                    const unsigned M = wave_umax(m); const int jsel = M ? 255 - (int)(M & 255u) : -1;
#pragma unroll
                    for (int c = 0; c < 4; ++c) if (key[c] == M) key[c] = 0u;
                    if (lane == 3 + rd) mypick = jsel;
                }
                if (lane < 16) idx[q * 16 + lane] = mypick;
            }
        }
    }
}

__device__ __forceinline__ void p5_selected(const Ctx& C) {
    const int gw = C.bid * 8 + C.wave, NWV = C.G * 8, lane = C.lane, i = lane & 15, g4 = lane >> 4;
    const float mb = WSP(float, WS_MISC)[64];
    for (int task = gw; task < 4 * S_; task += NWV) {
        const int bg = task / S_, tq = task % S_, b = bg >> 1, g = bg & 1; const size_t t = (size_t)b * S_ + tq;
        const int idxv = lane < 16 ? WSP(int, WS_IDX)[((size_t)bg * S_ + tq) * 16 + lane] : -1;
        QF qf;
        if (i < 4) qf = load_qf(WSP(bf16_t, WS_QR) + t * 1024 + (g * 4 + i) * 128, g4);
        else {
#pragma unroll
            for (int ks = 0; ks < 4; ++ks) qf.f[ks] = (bf16x8){0, 0, 0, 0, 0, 0, 0, 0}; }
        f32x4 O[8];
#pragma unroll
        for (int dt = 0; dt < 8; ++dt) O[dt] = (f32x4){0.f, 0.f, 0.f, 0.f};
        float l = 0.f;
        for (int k = 0; k < 16; ++k) { const int j = __builtin_amdgcn_readlane(idxv, k); if (j < 0) continue;
            attn_block<MODE_SEL>(qf, WSP(bf16_t, WS_KSEL) + ((size_t)bg * S_ + 64 * j) * 128, WSP(bf16_t, WS_VSELT) + ((size_t)bg * 256 + j) * 8192, O, l, i, g4, tq, 64 * j, C2_, mb); }
        l += __shfl_xor(l, 16); l += __shfl_xor(l, 32);
        if (i < 4) { const int h = g * 4 + i; const float sc = (l > 0.f ? 1.0f / l : 0.f) * WSP(float, WS_GATES)[t * 24 + h * 3 + 1];
            const float* ma = WSP(float, WS_MIXACC) + t * 1024 + h * 128 + 4 * g4; bf16_t* dst = WSP(bf16_t, WS_MIX) + t * D_ + 512 + h * 128 + 4 * g4;
#pragma unroll
            for (int dt = 0; dt < 8; ++dt) { const f32x4 v = *(const f32x4*)(ma + 16 * dt) + O[dt] * sc; u32x2 w; w.x = cvt_pk_bf16(v[0], v[1]); w.y = cvt_pk_bf16(v[2], v[3]); *(u32x2*)(dst + 16 * dt) = w; } }
    }
}
__device__ __forceinline__ int ta_swk(int r) { return (((r >> 3) & 3) << 2) | (r & 3); }
__device__ __forceinline__ void ta_issue(LAS unsigned char* lds, int bufi, const bf16_t* Kb, const bf16_t* Vb, int w, int lane, bool konly = false) {
    LAS unsigned char* kb = lds + bufi * 32768; LAS unsigned char* vb = kb + 16384;
#pragma unroll
    for (int q = 0; q < 2; ++q) { const int r = 8 * w + 4 * q + (lane >> 4), s = lane & 15;
        __builtin_amdgcn_global_load_lds((const unsigned*)(Kb + (size_t)r * 128 + ((s ^ ta_swk(r)) * 8)), (LAS unsigned*)(kb + (8 * w + 4 * q) * 256), 16, 0, 0); }
    if (konly) return;
#pragma unroll
    for (int q = 0; q < 2; ++q) { const int d = 16 * w + 8 * q + (lane >> 3), s = lane & 7;
        __builtin_amdgcn_global_load_lds((const unsigned*)(Vb + (size_t)d * 64 + ((s ^ ((d >> 1) & 7)) * 8)), (LAS unsigned*)(vb + (16 * w + 8 * q) * 128), 16, 0, 0); }
}
#define TA_SB __builtin_amdgcn_sched_barrier(0)
__device__ __forceinline__ void ta_ldk(LAS const unsigned char* kb, int kg, int i, int g4, bf16x8 (&a0)[4], bf16x8 (&a1)[4]) {
    LAS const unsigned char* kr = kb + (32 * kg + 8 * (i >> 2) + (i & 3)) * 256;
#pragma unroll
    for (int ks = 0; ks < 4; ++ks) { const int co = ((4 * ks + g4) ^ i) * 16; a0[ks] = *(LAS const bf16x8*)(kr + co); a1[ks] = *(LAS const bf16x8*)(kr + 4 * 256 + co); } }
__device__ __forceinline__ void ta_ldv(LAS const unsigned char* vb, int kg, int i, int g4, bf16x8 (&vt)[8]) {
    LAS const unsigned char* vr = vb + i * 128 + (((4 * kg + g4) ^ ((i >> 1) & 7)) * 16);
#pragma unroll
    for (int dt = 0; dt < 8; ++dt) vt[dt] = *(LAS const bf16x8*)(vr + dt * 16 * 128); }
__device__ __forceinline__ void ta_qk(const bf16x8 (&a0)[4], const bf16x8 (&a1)[4], const QF& q, f32x4& s0, f32x4& s1) {
    s0 = (f32x4){0.f, 0.f, 0.f, 0.f}; s1 = (f32x4){0.f, 0.f, 0.f, 0.f};
#pragma unroll
    for (int ks = 0; ks < 4; ++ks) { s0 = __builtin_amdgcn_mfma_f32_16x16x32_bf16(a0[ks], q.f[ks], s0, 0, 0, 0); s1 = __builtin_amdgcn_mfma_f32_16x16x32_bf16(a1[ks], q.f[ks], s1, 0, 0, 0); } }
template <int MODE, bool FULL = false> __device__ __forceinline__ bf16x8 ta_sm(const f32x4 s0, const f32x4 s1, float& l, int kg, int g4, int tq, bool colvalid, int kbase, float mb) {
    float p[8];
#pragma unroll
    for (int r = 0; r < 8; ++r) { const int key = kbase + 32 * kg + 8 * g4 + r; const float sv = r < 4 ? s0[r & 3] : s1[r & 3];
        bool valid = colvalid && (key <= tq);
        if (MODE == MODE_WIN) valid = valid && (key > tq - 512);
        if (MODE == MODE_NONE || FULL) valid = true;
        p[r] = valid ? __builtin_amdgcn_exp2f(sv * C2_ - mb) : 0.f; }
    l += ((p[0] + p[1]) + (p[2] + p[3])) + ((p[4] + p[5]) + (p[6] + p[7]));
    return pack8(p[0], p[1], p[2], p[3], p[4], p[5], p[6], p[7]); }
__device__ __forceinline__ void ta_pv(const bf16x8 (&vt)[8], const bf16x8 pf, f32x4 (&O)[8]) {
#pragma unroll
    for (int dt = 0; dt < 8; ++dt) O[dt] = __builtin_amdgcn_mfma_f32_16x16x32_bf16(vt[dt], pf, O[dt], 0, 0, 0); }
template <int MODE> __device__ __forceinline__ void ta_compute_pinned(LAS const unsigned char* kb, const QF& q, f32x4 (&O)[8], float& l, int i, int g4, int tq, bool colvalid, int kbase, float mb) {
    LAS const unsigned char* vb = kb + 16384;
    bf16x8 ka0[4], ka1[4], kb0[4], kb1[4], va[8], vc[8]; f32x4 s0, s1, t0, t1;
    ta_ldk(kb, 0, i, g4, ka0, ka1); TA_SB; ta_ldk(kb, 1, i, g4, kb0, kb1); TA_SB;
    ta_qk(ka0, ka1, q, s0, s1); TA_SB;
    ta_ldv(vb, 0, i, g4, va); TA_SB;
    ta_qk(kb0, kb1, q, t0, t1); TA_SB;
    const bf16x8 pf0 = ta_sm<MODE>(s0, s1, l, 0, g4, tq, colvalid, kbase, mb); TA_SB;
    ta_ldv(vb, 1, i, g4, vc); TA_SB;
    ta_pv(va, pf0, O); TA_SB;
    const bf16x8 pf1 = ta_sm<MODE>(t0, t1, l, 1, g4, tq, colvalid, kbase, mb); TA_SB;
    ta_pv(vc, pf1, O); TA_SB;
}
template <int MODE, bool FULL = false> __device__ __forceinline__ void ta_compute_plain(LAS const unsigned char* kb, const QF& q, f32x4 (&O)[8], float& l, int i, int g4, int tq, bool colvalid, int kbase, float mb) {
    LAS const unsigned char* vb = kb + 16384;
#pragma unroll
    for (int kg = 0; kg < 2; ++kg) {
        bf16x8 a0[4], a1[4], vt[8]; f32x4 s0, s1;
        ta_ldk(kb, kg, i, g4, a0, a1); ta_qk(a0, a1, q, s0, s1);
        const bf16x8 pf = ta_sm<MODE, FULL>(s0, s1, l, kg, g4, tq, colvalid, kbase, mb);
        ta_ldv(vb, kg, i, g4, vt); ta_pv(vt, pf, O);
    }
}
template <int MODE, bool FULL = false> __device__ __forceinline__ void ta_compute2(LAS const unsigned char* kb, const QF& q0, const QF& q1, f32x4 (&O0)[8], f32x4 (&O1)[8], float& l0, float& l1, int i, int g4, int tq0, int tq1, bool n0, bool n1, bool cv0, bool cv1, int kbase, float mb, bool full = false  ) {
    LAS const unsigned char* vb = kb + 16384;
    const float m0 = cv0 ? mb : 1e30f, m1 = cv1 ? mb : 1e30f;
    bf16x8 ka0[4], ka1[4], kb0[4], kb1[4], va[8], vc[8]; f32x4 s0, s1, t0, t1, u0, u1, v0, v1; bf16x8 pa0, pb0, pa1, pb1;
    ta_ldk(kb, 0, i, g4, ka0, ka1); ta_ldk(kb, 1, i, g4, kb0, kb1); TA_SB;
    if (n0) { ta_qk(ka0, ka1, q0, s0, s1); ta_qk(kb0, kb1, q0, t0, t1); } TA_SB;
    if (n1) { ta_qk(ka0, ka1, q1, u0, u1); ta_qk(kb0, kb1, q1, v0, v1); } TA_SB;
    ta_ldv(vb, 0, i, g4, va); TA_SB;
    if (n0) { if (full) { pa0 = ta_sm<MODE, true>(s0, s1, l0, 0, g4, tq0, true, kbase, m0); pb0 = ta_sm<MODE, true>(t0, t1, l0, 1, g4, tq0, true, kbase, m0); }
              else { pa0 = ta_sm<MODE, FULL>(s0, s1, l0, 0, g4, tq0, cv0, kbase, mb); pb0 = ta_sm<MODE, FULL>(t0, t1, l0, 1, g4, tq0, cv0, kbase, mb); } } TA_SB;
    if (n1) { if (full) { pa1 = ta_sm<MODE, true>(u0, u1, l1, 0, g4, tq1, true, kbase, m1); pb1 = ta_sm<MODE, true>(v0, v1, l1, 1, g4, tq1, true, kbase, m1); }
              else { pa1 = ta_sm<MODE, FULL>(u0, u1, l1, 0, g4, tq1, cv1, kbase, mb); pb1 = ta_sm<MODE, FULL>(v0, v1, l1, 1, g4, tq1, cv1, kbase, mb); } } TA_SB;
    ta_ldv(vb, 1, i, g4, vc); TA_SB;
    if (n0) { ta_pv(va, pa0, O0); ta_pv(vc, pb0, O0); } TA_SB;
    if (n1) { ta_pv(va, pa1, O1); ta_pv(vc, pb1, O1); } TA_SB;
}
template <int MODE> __device__ __forceinline__ void ta_compute(LAS const unsigned char* kb, const QF& q, f32x4 (&O)[8], float& l, int i, int g4, int tq, bool colvalid, int kbase, float mb) {
    if (MODE == MODE_SEL) ta_compute_pinned<MODE>(kb, q, O, l, i, g4, tq, colvalid, kbase, mb); else ta_compute_plain<MODE>(kb, q, O, l, i, g4, tq, colvalid, kbase, mb);
}
template <int MODE, int DRY = 0  > __device__ __forceinline__ void tile_attn_phase(const Ctx& C) {
    const int w = C.wave, lane = C.lane, i = lane & 15, g4 = lane >> 4, tid = C.tid;
    LAS unsigned char* lds = C.lds;
    LAS unsigned* MASK = (LAS unsigned*)(lds + 131072);
    LAS int* USED = (LAS int*)(lds + LDS_MISC + 512);
    LAS int* WCNT = (LAS int*)(lds + LDS_MISC + 512 + 1024);
    const float mb = WSP(float, WS_MISC)[64];
    const bf16_t* Kall = WSP(bf16_t, MODE == MODE_SEL ? WS_KSEL : WS_KWIN); const bf16_t* VTall = WSP(bf16_t, MODE == MODE_SEL ? WS_VSELT : WS_VWINT);
    constexpr int NT = 4 * 256;
    for (int it = C.bid; it < NT; it += C.G) {
        const int round = it / C.G, base = C.G * round, cntr = (NT - base) < C.G ? (NT - base) : C.G, off = it - base;
        const int tk = base + ((round & 1) ? cntr - 1 - off : off);
        const int qt = 255 - (tk >> 2), bg = tk & 3, b = bg >> 1, g = bg & 1, t0 = 64 * qt;
        int nblk, blo = 0;
        if (MODE == MODE_SEL) {
            for (int k = tid; k < 2048; k += 512) MASK[k] = 0u;
            __syncthreads();
            const int* idx = WSP(int, WS_IDX) + ((size_t)bg * S_ + t0) * 16;
#pragma unroll
            for (int e = tid; e < 1024; e += 512) { const int j = idx[e]; const int qq = e >> 4; if (j >= 0) __hip_atomic_fetch_or(MASK + j * 8 + (qq >> 3), 1u << (qq & 7), __ATOMIC_RELAXED, __HIP_MEMORY_SCOPE_WORKGROUP); }
            __syncthreads();
            bool any = false; unsigned long long bal = 0ull;
            if (tid < 256) { unsigned o = 0u;
#pragma unroll
                for (int k = 0; k < 8; ++k) o |= MASK[tid * 8 + k];
                any = o != 0u; bal = __ballot(any); if (lane == 0) WCNT[w] = __popcll(bal); }
            __syncthreads();
            if (tid < 256 && any) { int bs = 0;
#pragma unroll
                for (int k = 0; k < 4; ++k) bs += (k < w) ? WCNT[k] : 0;
                USED[bs + __popcll(bal & ((1ull << lane) - 1ull))] = tid; }
            nblk = WCNT[0] + WCNT[1] + WCNT[2] + WCNT[3];
            __syncthreads();
            if (32 * w < nblk) {
                const int cb = 32 * w, cn = (nblk - cb) < 32 ? (nblk - cb) : 32;
                const int id = lane < cn ? USED[cb + lane] : 0; unsigned h1 = 0u, h2 = 0u;
                { const u32x4 ma = *(LAS const u32x4*)(MASK + id * 8), mc = *(LAS const u32x4*)(MASK + id * 8 + 4);
#pragma unroll
                  for (int k = 0; k < 8; ++k) { const unsigned m = k < 4 ? ma[k & 3] : mc[k & 3]; const unsigned a = (m & 0x0Fu) ? 1u : 0u, c = (m & 0xF0u) ? 1u : 0u; h1 |= (a | c) << k; h2 |= (a & c) << k; } }
                unsigned long long alive = __ballot(lane < cn); int k = 0;
                while (alive) {
                    const int l1 = __builtin_ctzll(alive); alive &= alive - 1ull;
                    const unsigned a1 = __builtin_amdgcn_readlane(h1, l1), a2 = __builtin_amdgcn_readlane(h2, l1); const int id1 = __builtin_amdgcn_readlane(id, l1); int id2 = -1;
                    if (alive) {
                        const bool c4 = (h2 & a2) != 0u, c3 = ((h2 & a1) | (h1 & a2)) != 0u, c2 = ((h2 | a2) | (h1 & a1)) != 0u;
                        const unsigned long long m1 = __ballot(!c2) & alive, m2 = __ballot(!c3) & alive, m3 = __ballot(!c4) & alive;
                        const unsigned long long pick = m1 ? m1 : (m2 ? m2 : (m3 ? m3 : alive));
                        const int l2 = __builtin_ctzll(pick); alive &= ~(1ull << l2); id2 = __builtin_amdgcn_readlane(id, l2); }
                    if (lane == 0) { USED[cb + k] = id1; if (id2 >= 0) USED[cb + k + 1] = id2; }
                    k += 2; }
            }
            __syncthreads();
        } else { blo = (t0 - 511 > 0 ? t0 - 511 : 0) >> 6; nblk = qt - blo + 1; __syncthreads(); }
        const int tq0 = t0 + 8 * w + (i >> 2), tq1 = tq0 + 4; const size_t tt0 = (size_t)b * S_ + tq0, tt1 = tt0 + 4; const int hh = g * 4 + (i & 3);
        const QF q0 = load_qf(WSP(bf16_t, WS_QR) + tt0 * 1024 + hh * 128, g4), q1 = load_qf(WSP(bf16_t, WS_QR) + tt1 * 1024 + hh * 128, g4);
        f32x4 O0[8], O1[8]; float l0 = 0.f, l1 = 0.f;
#pragma unroll
        for (int dt = 0; dt < 8; ++dt) { O0[dt] = (f32x4){0.f, 0.f, 0.f, 0.f}; O1[dt] = (f32x4){0.f, 0.f, 0.f, 0.f}; }
        const bf16_t* Kbg = Kall + (size_t)bg * S_ * 128; const bf16_t* Vbg = VTall + (size_t)bg * 256 * 8192;
#define TA_BLK(n_) (MODE == MODE_SEL ? USED[n_] : blo + (n_))
#define TA_ISSUE(n_) do { if (DRY == 2) break; const int _j = TA_BLK(n_); ta_issue(lds, (n_) & 3, Kbg + (size_t)_j * 64 * 128, Vbg + (size_t)_j * 8192, w, lane); } while (0)
#define TA_DO(n_) do { if (DRY == 1) break; const int _j = TA_BLK(n_); const unsigned _m = MODE == MODE_SEL ? (unsigned)__builtin_amdgcn_readfirstlane((int)MASK[_j * 8 + w]) : 0xFFu; unsigned _ko = ((n_) & 3) * 32768; asm volatile("" : "+s"(_ko)); LAS const unsigned char* _kb = lds + _ko;   \
            if (_m) ta_compute2<MODE>(_kb, q0, q1, O0, O1, l0, l1, i, g4, tq0, tq1, (_m & 0x0Fu) != 0u, (_m & 0xF0u) != 0u, ((_m >> (i >> 2)) & 1u) != 0u, ((_m >> (4 + (i >> 2))) & 1u) != 0u, 64 * _j, mb, MODE == MODE_SEL ? _j < qt : (_j < qt && _j > qt - 8)); } while (0)
        if (MODE == MODE_SEL) {
            TA_ISSUE(0); if (nblk > 1) TA_ISSUE(1);
            for (int n = 0; n < nblk; n += 2) {
                asm volatile("s_waitcnt vmcnt(0)" ::: "memory"); __syncthreads();
                if (n + 2 < nblk) TA_ISSUE(n + 2);
                if (n + 3 < nblk) TA_ISSUE(n + 3);
                TA_DO(n);
                if (n + 1 < nblk) TA_DO(n + 1);
            }
        } else {
            TA_ISSUE(0);
            for (int n = 0; n < nblk; ++n) {
                asm volatile("s_waitcnt vmcnt(0)" ::: "memory"); __syncthreads();
                if (n + 1 < nblk) TA_ISSUE(n + 1);
                TA_DO(n);
            }
        }
#undef TA_ISSUE
#undef TA_DO
#undef TA_BLK
        l0 += __shfl_xor(l0, 16); l0 += __shfl_xor(l0, 32); l1 += __shfl_xor(l1, 16); l1 += __shfl_xor(l1, 32);
        const float* gates = WSP(float, WS_GATES);
        const float sc0 = (l0 > 0.f ? 1.0f / l0 : 0.f) * gates[tt0 * 24 + hh * 3 + (MODE == MODE_SEL ? 1 : 2)], sc1 = (l1 > 0.f ? 1.0f / l1 : 0.f) * gates[tt1 * 24 + hh * 3 + (MODE == MODE_SEL ? 1 : 2)];
        float* ma0 = WSP(float, WS_MIXACC) + tt0 * 1024 + hh * 128 + 4 * g4; float* ma1 = WSP(float, WS_MIXACC) + tt1 * 1024 + hh * 128 + 4 * g4;
        if (DRY) { asm volatile("" :: "v"(sc0), "v"(sc1));
#pragma unroll
            for (int dt = 0; dt < 8; ++dt) asm volatile("" :: "v"(O0[dt]), "v"(O1[dt]));
        } else if (MODE == MODE_SEL) {
            unsigned char* d0 = WSP(unsigned char, WS_MIX) + tt0 * MIXP + 1024 + hh * 128 + 4 * g4; unsigned char* d1 = WSP(unsigned char, WS_MIX) + tt1 * MIXP + 1024 + hh * 128 + 4 * g4;
#pragma unroll
            for (int dt = 0; dt < 8; ++dt) { const f32x4 v0 = (*(const f32x4*)(ma0 + 16 * dt) + O0[dt] * sc0) * MIX_SCALE, v1 = (*(const f32x4*)(ma1 + 16 * dt) + O1[dt] * sc1) * MIX_SCALE;
                *(unsigned*)(d0 + 16 * dt) = pk4_fp8(v0[0], v0[1], v0[2], v0[3]); *(unsigned*)(d1 + 16 * dt) = pk4_fp8(v1[0], v1[1], v1[2], v1[3]); }
        } else {
#pragma unroll
            for (int dt = 0; dt < 8; ++dt) { *(f32x4*)(ma0 + 16 * dt) = O0[dt] * sc0; *(f32x4*)(ma1 + 16 * dt) = O1[dt] * sc1; }
        }
        __syncthreads();
    }
}

template <int PASS, bool FULL = false> __device__ __forceinline__ bf16x8 cmp_sm(const f32x4 s0, const f32x4 s1, float& l, float mbi  , LAS float* improw, int kg, int i, int g4, int tq, int j, float mb) {
    float p[8];
#pragma unroll
    for (int r = 0; r < 8; ++r) { const int key = 64 * j + 32 * kg + 8 * g4 + r; const float sv = r < 4 ? s0[r & 3] : s1[r & 3];
        const float e = __builtin_amdgcn_exp2f(sv * C2_ - (PASS == 1 ? mb : mbi));
        p[r] = (FULL || 16 * key + 31 <= tq) ? e : 0.f; }
    if (PASS == 1) { l += ((p[0] + p[1]) + (p[2] + p[3])) + ((p[4] + p[5]) + (p[6] + p[7])); return (bf16x8){0, 0, 0, 0, 0, 0, 0, 0}; }
    float ia = 2.0f * (p[0] + p[1] + p[2]) + p[3], ib = p[3] + 2.0f * (p[4] + p[5] + p[6]) + p[7], ic = p[7];
    ia += dppf<0xB1>(ia); ia += dppf<0x4E>(ia); ib += dppf<0xB1>(ib); ib += dppf<0x4E>(ib); ic += dppf<0xB1>(ic); ic += dppf<0x4E>(ic);
    if ((i & 3) == 0) { LAS float* ip = improw + 16 * j + 8 * kg + 2 * g4;
        __hip_atomic_fetch_add(ip, ia, __ATOMIC_RELAXED, __HIP_MEMORY_SCOPE_WORKGROUP); __hip_atomic_fetch_add(ip + 1, ib, __ATOMIC_RELAXED, __HIP_MEMORY_SCOPE_WORKGROUP); __hip_atomic_fetch_add(ip + 2, ic, __ATOMIC_RELAXED, __HIP_MEMORY_SCOPE_WORKGROUP); }
    return pack8(p[0], p[1], p[2], p[3], p[4], p[5], p[6], p[7]);
}
template <int PASS> __device__ __forceinline__ void cmp_compute(LAS const unsigned char* kb, const QF& q, f32x4 (&O)[8], float& l, float inv, LAS float* improw, int i, int g4, int tq, int j, float mb) {
    LAS const unsigned char* vb = kb + 16384;
    bf16x8 ka0[4], ka1[4], kb0[4], kb1[4]; f32x4 s0, s1, t0, t1;
    ta_ldk(kb, 0, i, g4, ka0, ka1); TA_SB; ta_ldk(kb, 1, i, g4, kb0, kb1); TA_SB;
    ta_qk(ka0, ka1, q, s0, s1); TA_SB;
    if (PASS == 1) { ta_qk(kb0, kb1, q, t0, t1); TA_SB; (void)cmp_sm<1>(s0, s1, l, inv, improw, 0, i, g4, tq, j, mb); (void)cmp_sm<1>(t0, t1, l, inv, improw, 1, i, g4, tq, j, mb); TA_SB; }
    else { bf16x8 va[8], vc[8];
        ta_ldv(vb, 0, i, g4, va); TA_SB;
        ta_qk(kb0, kb1, q, t0, t1); TA_SB;
        const bf16x8 pf0 = cmp_sm<2>(s0, s1, l, inv, improw, 0, i, g4, tq, j, mb); TA_SB;
        ta_ldv(vb, 1, i, g4, vc); TA_SB;
        ta_pv(va, pf0, O); TA_SB;
        const bf16x8 pf1 = cmp_sm<2>(t0, t1, l, inv, improw, 1, i, g4, tq, j, mb); TA_SB;
        ta_pv(vc, pf1, O); TA_SB; }
}
template <int PASS> __device__ __forceinline__ void cmp_compute2(LAS const unsigned char* kb, const QF& q0, const QF& q1, f32x4 (&O0)[8], f32x4 (&O1)[8], float& l0, float& l1, float inv0, float inv1, LAS float* imp0, LAS float* imp1, int i, int g4, int tq0, int tq1, int j, float mb, bool full) {
    LAS const unsigned char* vb = kb + 16384;
    bf16x8 ka0[4], ka1[4], kb0[4], kb1[4]; f32x4 s0, s1, t0, t1, u0, u1, v0, v1;
    ta_ldk(kb, 0, i, g4, ka0, ka1); ta_ldk(kb, 1, i, g4, kb0, kb1); TA_SB;
    ta_qk(ka0, ka1, q0, s0, s1); ta_qk(kb0, kb1, q0, t0, t1); TA_SB;
    ta_qk(ka0, ka1, q1, u0, u1); ta_qk(kb0, kb1, q1, v0, v1); TA_SB;
    if (PASS == 1) {
        if (full) { (void)cmp_sm<1, true>(s0, s1, l0, inv0, imp0, 0, i, g4, tq0, j, mb); (void)cmp_sm<1, true>(t0, t1, l0, inv0, imp0, 1, i, g4, tq0, j, mb);
                    (void)cmp_sm<1, true>(u0, u1, l1, inv1, imp1, 0, i, g4, tq1, j, mb); (void)cmp_sm<1, true>(v0, v1, l1, inv1, imp1, 1, i, g4, tq1, j, mb); }
        else { (void)cmp_sm<1>(s0, s1, l0, inv0, imp0, 0, i, g4, tq0, j, mb); (void)cmp_sm<1>(t0, t1, l0, inv0, imp0, 1, i, g4, tq0, j, mb);
               (void)cmp_sm<1>(u0, u1, l1, inv1, imp1, 0, i, g4, tq1, j, mb); (void)cmp_sm<1>(v0, v1, l1, inv1, imp1, 1, i, g4, tq1, j, mb); }
        TA_SB; }
    else { bf16x8 va[8], vc[8], pa0, pb0, pa1, pb1;
        ta_ldv(vb, 0, i, g4, va); TA_SB;
        if (full) { pa0 = cmp_sm<2, true>(s0, s1, l0, inv0, imp0, 0, i, g4, tq0, j, mb); pb0 = cmp_sm<2, true>(t0, t1, l0, inv0, imp0, 1, i, g4, tq0, j, mb);
                    pa1 = cmp_sm<2, true>(u0, u1, l1, inv1, imp1, 0, i, g4, tq1, j, mb); pb1 = cmp_sm<2, true>(v0, v1, l1, inv1, imp1, 1, i, g4, tq1, j, mb); }
        else { pa0 = cmp_sm<2>(s0, s1, l0, inv0, imp0, 0, i, g4, tq0, j, mb); pb0 = cmp_sm<2>(t0, t1, l0, inv0, imp0, 1, i, g4, tq0, j, mb);
               pa1 = cmp_sm<2>(u0, u1, l1, inv1, imp1, 0, i, g4, tq1, j, mb); pb1 = cmp_sm<2>(v0, v1, l1, inv1, imp1, 1, i, g4, tq1, j, mb); }
        TA_SB;
        ta_ldv(vb, 1, i, g4, vc); TA_SB;
        ta_pv(va, pa0, O0); ta_pv(vc, pb0, O0); TA_SB;
        ta_pv(va, pa1, O1); ta_pv(vc, pb1, O1); TA_SB; }
}
__device__ __forceinline__ void p4_tiled(const Ctx& C, bool dry = false) {
    const int w = C.wave, lane = C.lane, i = lane & 15, g4 = lane >> 4, tid = C.tid;
    LAS unsigned char* lds = C.lds;
    LAS float* IMP = (LAS float*)(lds + 65536);
    const float mb = WSP(float, WS_MISC)[64];
    constexpr int NT = 4 * 256;
    for (int it = C.bid; it < NT; it += C.G) {
        const int round = it / C.G, base = C.G * round, cntr = (NT - base) < C.G ? (NT - base) : C.G, off = it - base;
        const int tk = base + ((round & 1) ? cntr - 1 - off : off);
        const int qt = 255 - (tk >> 2), bg = tk & 3, b = bg >> 1, g = bg & 1, t0 = 64 * qt;
        const int nvis = (4 * qt + 3) < 1023 ? (4 * qt + 3) : 1023, nb = (nvis + 63) >> 6;
        for (int k = tid; k < 64 * 257; k += 512) IMP[k] = 0.f;
        const int tq0 = t0 + 8 * w + (i >> 2), tq1 = tq0 + 4; const size_t tt0 = (size_t)b * S_ + tq0, tt1 = tt0 + 4; const int hh = g * 4 + (i & 3);
        const QF q0 = load_qf(WSP(bf16_t, WS_QN) + tt0 * 1024 + hh * 128, g4), q1 = load_qf(WSP(bf16_t, WS_QN) + tt1 * 1024 + hh * 128, g4);
        f32x4 O0[8], O1[8]; float l0 = 0.f, l1 = 0.f;
#pragma unroll
        for (int dt = 0; dt < 8; ++dt) { O0[dt] = (f32x4){0.f, 0.f, 0.f, 0.f}; O1[dt] = (f32x4){0.f, 0.f, 0.f, 0.f}; }
        const bf16_t* Kbg = WSP(bf16_t, WS_KC) + (size_t)bg * 1024 * 128; const bf16_t* Vbg = WSP(bf16_t, WS_VCT) + (size_t)bg * 16 * 8192;
        LAS float* imp0 = IMP + (8 * w + (i >> 2)) * 257; LAS float* imp1 = imp0 + 4 * 257;
        __syncthreads();
        ta_issue(lds, 0, Kbg, Vbg, w, lane, true);
        for (int n = 0; n < nb; ++n) {
            asm volatile("s_waitcnt vmcnt(0)" ::: "memory"); __syncthreads();
            if (n + 1 < nb) ta_issue(lds, (n + 1) & 1, Kbg + (size_t)(n + 1) * 64 * 128, Vbg + (size_t)(n + 1) * 8192, w, lane, true);
            LAS const unsigned char* kb = lds + (n & 1) * 32768;
#ifdef MK_P4NOCOMP
            if (!dry)
#endif
            cmp_compute2<1>(kb, q0, q1, O0, O1, l0, l1, 0.f, 0.f, imp0, imp1, i, g4, tq0, tq1, n, mb, 1024 * n + 1039 <= t0);
        }
        l0 += __shfl_xor(l0, 16); l0 += __shfl_xor(l0, 32); l1 += __shfl_xor(l1, 16); l1 += __shfl_xor(l1, 32);
        const float mbi0 = l0 > 0.f ? mb + __builtin_amdgcn_logf(l0) : 1e30f, mbi1 = l1 > 0.f ? mb + __builtin_amdgcn_logf(l1) : 1e30f;
        __syncthreads();
        ta_issue(lds, 0, Kbg, Vbg, w, lane);
        for (int n = 0; n < nb; ++n) {
            asm volatile("s_waitcnt vmcnt(0)" ::: "memory"); __syncthreads();
            if (n + 1 < nb) ta_issue(lds, (n + 1) & 1, Kbg + (size_t)(n + 1) * 64 * 128, Vbg + (size_t)(n + 1) * 8192, w, lane);
            LAS const unsigned char* kb = lds + (n & 1) * 32768;
#ifdef MK_P4NOCOMP
            if (!dry)
#endif
            cmp_compute2<2>(kb, q0, q1, O0, O1, l0, l1, mbi0, mbi1, imp0, imp1, i, g4, tq0, tq1, n, mb, 1024 * n + 1039 <= t0);
        }
        { const float* gates = WSP(float, WS_GATES); const float gc0 = gates[tt0 * 24 + hh * 3 + 0], gc1 = gates[tt1 * 24 + hh * 3 + 0];
          float* ma0 = WSP(float, WS_MIXACC) + tt0 * 1024 + hh * 128 + 4 * g4; float* ma1 = WSP(float, WS_MIXACC) + tt1 * 1024 + hh * 128 + 4 * g4;
#pragma unroll
          for (int dt = 0; dt < 8; ++dt) { const f32x4 v0 = *(const f32x4*)(ma0 + 16 * dt) + O0[dt] * gc0, v1 = *(const f32x4*)(ma1 + 16 * dt) + O1[dt] * gc1; if (!dry) { *(f32x4*)(ma0 + 16 * dt) = v0; *(f32x4*)(ma1 + 16 * dt) = v1; } else { asm volatile("" :: "v"(v0), "v"(v1)); } } }
        __syncthreads();
        const int cur = qt; int* idx = WSP(int, WS_IDX) + ((size_t)bg * S_ + t0 + 8 * w) * 16;
        if (cur <= 15) { for (int q = 0; q < 8; ++q) if (lane < 16) idx[q * 16 + lane] = lane <= cur ? lane : -1; }
        else {
            for (int q0 = 0; q0 < 8; q0 += 2) {
                unsigned key[2][4]; int mypick[2];
#pragma unroll
                for (int u = 0; u < 2; ++u) {
#pragma unroll
                    for (int c = 0; c < 4; ++c) { const int j = lane + 64 * c; const float v = IMP[(8 * w + q0 + u) * 257 + j]; key[u][c] = (j >= 1 && j <= cur - 2) ? ((__float_as_uint(v) & 0xFFFFFF00u) | (unsigned)(255 - j)) : 0u; }
#define SEL_CS(a_, b_) do { const unsigned _h = key[u][a_] > key[u][b_] ? key[u][a_] : key[u][b_], _l = key[u][a_] > key[u][b_] ? key[u][b_] : key[u][a_]; key[u][a_] = _h; key[u][b_] = _l; } while (0)
                    SEL_CS(0, 1); SEL_CS(2, 3); SEL_CS(0, 2); SEL_CS(1, 3); SEL_CS(1, 2);
#undef SEL_CS
                    mypick[u] = lane == 0 ? 0 : (lane == 1 ? cur - 1 : (lane == 2 ? cur : -1)); }
                for (int rd = 0; rd < 13; ++rd) {
#pragma unroll
                    for (int u = 0; u < 2; ++u) {
                        const unsigned M = wave_umax63(key[u][0]); const int jsel = M ? 255 - (int)(M & 255u) : -1;
                        const bool hit = key[u][0] == M && M != 0u;
                        key[u][0] = hit ? key[u][1] : key[u][0]; key[u][1] = hit ? key[u][2] : key[u][1]; key[u][2] = hit ? key[u][3] : key[u][2]; key[u][3] = hit ? 0u : key[u][3];
                        if (lane == 3 + rd) mypick[u] = jsel; }
                }
#pragma unroll
                for (int u = 0; u < 2; ++u) if (lane < 16) idx[(q0 + u) * 16 + lane] = mypick[u];
            }
        }
        __syncthreads();
    }
}

__device__ __forceinline__ void xattn_tiled(const Ctx& C) {
    const int w = C.wave, lane = C.lane, i = lane & 15, g4 = lane >> 4;
    LAS unsigned char* lds = C.lds;
    const float mb = WSP(float, WS_MISC)[65];
    for (int tile = C.bid; tile < NB * 4 * (S_ / 256); tile += C.G) {
        const int qb = tile & 63, hx = (tile >> 6) & 3, b = tile >> 8;
        const bf16_t* Kb = WSP(bf16_t, WS_KX) + (size_t)(b * 4 + hx) * 256 * 128; const bf16_t* Vb = WSP(bf16_t, WS_VXT) + (size_t)(b * 4 + hx) * 4 * 8192;
        __syncthreads();
#pragma unroll
        for (int n = 0; n < 4; ++n) ta_issue(lds, n, Kb + (size_t)n * 64 * 128, Vb + (size_t)n * 8192, w, lane);
        const size_t t0 = (size_t)b * S_ + qb * 256 + 32 * w + i, t1 = t0 + 16;
        const QF q0 = load_qf(WSP(bf16_t, WS_QX) + t0 * 512 + hx * 128, g4), q1 = load_qf(WSP(bf16_t, WS_QX) + t1 * 512 + hx * 128, g4);
        f32x4 O0[8], O1[8]; float l0 = 0.f, l1 = 0.f;
#pragma unroll
        for (int dt = 0; dt < 8; ++dt) { O0[dt] = (f32x4){0.f, 0.f, 0.f, 0.f}; O1[dt] = (f32x4){0.f, 0.f, 0.f, 0.f}; }
        asm volatile("s_waitcnt vmcnt(0)" ::: "memory"); __syncthreads();
        for (int n = 0; n < 4; ++n) { unsigned ko = n * 32768; asm volatile("" : "+s"(ko)); LAS const unsigned char* kb = lds + ko;
            ta_compute2<MODE_NONE>(kb, q0, q1, O0, O1, l0, l1, i, g4, 0, 0, true, true, true, true, 64 * n, mb); }
        l0 += __shfl_xor(l0, 16); l0 += __shfl_xor(l0, 32); l1 += __shfl_xor(l1, 16); l1 += __shfl_xor(l1, 32);
        const float sc0 = l0 > 0.f ? 1.0f / l0 : 0.f, sc1 = l1 > 0.f ? 1.0f / l1 : 0.f;
        unsigned char* d0 = WSP(unsigned char, WS_MIX) + t0 * MIXP + 2048 + hx * 128 + 4 * g4; unsigned char* d1 = WSP(unsigned char, WS_MIX) + t1 * MIXP + 2048 + hx * 128 + 4 * g4;
        const float z0 = sc0 * MIX_SCALE, z1 = sc1 * MIX_SCALE;
#pragma unroll
        for (int dt = 0; dt < 8; ++dt) { *(unsigned*)(d0 + 16 * dt) = pk4_fp8(O0[dt][0] * z0, O0[dt][1] * z0, O0[dt][2] * z0, O0[dt][3] * z0);
            *(unsigned*)(d1 + 16 * dt) = pk4_fp8(O1[dt][0] * z1, O1[dt][1] * z1, O1[dt][2] * z1, O1[dt][3] * z1); }
    }
    __syncthreads();
}
__device__ __forceinline__ void p7_ffn_prep(const Ctx& C, bool dummy = false) {
    const int lane = C.lane, i = lane & 15, g4 = lane >> 4;
    LAS int* cnt = (LAS int*)C.lds; LAS int* basew = (LAS int*)(C.lds + 128); LAS float* lg = (LAS float*)(C.lds + 1024 + C.wave * 2112);
    const bf16_t* WRH = WSP(bf16_t, WS_WRH); const bf16_t* WRL = WSP(bf16_t, WS_WRL);
    unsigned* gcount = (unsigned*)WSP(unsigned, WS_CTL) + CW_GCOUNT + (dummy ? 64 : 0);
    const size_t lofs = dummy ? (WS_PROJ - WS_LIST) / 4 : 0;
    for (int u = C.bid; u < T_ / 128; u += C.G) {
        if (C.tid < 32) cnt[C.tid] = 0;
        __syncthreads();
        const int row = u * 128 + C.wave * 16 + i;
        float ssq = 0.f; { const f32x4* rp = (const f32x4*)(WSP(float, WS_ROWSS) + (size_t)row * 32);
#pragma unroll
          for (int k = 0; k < 8; ++k) { const f32x4 v = rp[k]; ssq += (v[0] + v[1]) + (v[2] + v[3]); } }
        const float rstd = rsqrtf(ssq * (1.0f / D_) + EPS);
        const _Float16* __restrict__ x1 = WSP(_Float16, WS_X1H) + (size_t)row * D_ + 8 * g4; const float* fg = C.ka->in[I_FFG] + 8 * g4; unsigned char* __restrict__ h2 = WSP(unsigned char, WS_H) + (size_t)row * D_ + 8 * g4;
        f32x4 a0 = {0.f, 0.f, 0.f, 0.f}, a1 = {0.f, 0.f, 0.f, 0.f};
        const int rot = ((C.bid >> 3) * 2 + (C.bid & 1)) & 63;
#define P7_RC(c_) (((c_) + rot) & 63)
        f16x8 xq[4];
#pragma unroll
        for (int d = 0; d < 4; ++d) xq[d] = *(const f16x8*)(x1 + 32 * P7_RC(d));
        bf16x8 b0hN = *(const bf16x8*)(WRH + (size_t)i * D_ + 32 * rot + 8 * g4), b1hN = *(const bf16x8*)(WRH + (size_t)(i + 16) * D_ + 32 * rot + 8 * g4), b0lN = *(const bf16x8*)(WRL + (size_t)i * D_ + 32 * rot + 8 * g4), b1lN = *(const bf16x8*)(WRL + (size_t)(i + 16) * D_ + 32 * rot + 8 * g4);
        for (int c4 = 0; c4 < 64; c4 += 4) {
#pragma unroll
          for (int d = 0; d < 4; ++d) { const int cl = c4 + d, c = P7_RC(cl);
            const f32x8 xf = __builtin_convertvector(xq[d], f32x8); const f32x4 xa = {xf[0], xf[1], xf[2], xf[3]}, xb = {xf[4], xf[5], xf[6], xf[7]}, ga = *(const f32x4*)(fg + 32 * c), gb = *(const f32x4*)(fg + 32 * c + 4);
            const bf16x8 b0h = b0hN, b1h = b1hN, b0l = b0lN, b1l = b1lN;
            { const int cx = P7_RC(cl + 4 < 64 ? cl + 4 : 63); xq[d] = *(const f16x8*)(x1 + 32 * cx);
              const int cn = P7_RC(cl < 63 ? cl + 1 : cl); const size_t bn = (size_t)i * D_ + 32 * cn + 8 * g4;
              b0hN = *(const bf16x8*)(WRH + bn); b1hN = *(const bf16x8*)(WRH + bn + (size_t)16 * D_); b0lN = *(const bf16x8*)(WRL + bn); b1lN = *(const bf16x8*)(WRL + bn + (size_t)16 * D_); }
            float h[8]; h[0] = xa[0] * ga[0] * rstd; h[1] = xa[1] * ga[1] * rstd; h[2] = xa[2] * ga[2] * rstd; h[3] = xa[3] * ga[3] * rstd; h[4] = xb[0] * gb[0] * rstd; h[5] = xb[1] * gb[1] * rstd; h[6] = xb[2] * gb[2] * rstd; h[7] = xb[3] * gb[3] * rstd;
            u32x4 hi; hi.x = cvt_pk_bf16(h[0], h[1]); hi.y = cvt_pk_bf16(h[2], h[3]); hi.z = cvt_pk_bf16(h[4], h[5]); hi.w = cvt_pk_bf16(h[6], h[7]);
            { u32x2 w8; w8.x = pk4_fp8(h[0], h[1], h[2], h[3]); w8.y = pk4_fp8(h[4], h[5], h[6], h[7]); *(u32x2*)(h2 + 32 * c) = w8; }
            u32x4 lo; lo.x = cvt_pk_bf16(h[0] - __uint_as_float(hi.x << 16), h[1] - __uint_as_float(hi.x & 0xFFFF0000u)); lo.y = cvt_pk_bf16(h[2] - __uint_as_float(hi.y << 16), h[3] - __uint_as_float(hi.y & 0xFFFF0000u));
            lo.z = cvt_pk_bf16(h[4] - __uint_as_float(hi.z << 16), h[5] - __uint_as_float(hi.z & 0xFFFF0000u)); lo.w = cvt_pk_bf16(h[6] - __uint_as_float(hi.w << 16), h[7] - __uint_as_float(hi.w & 0xFFFF0000u));
            const bf16x8 ah = __builtin_bit_cast(bf16x8, hi), al = __builtin_bit_cast(bf16x8, lo);
            a0 = __builtin_amdgcn_mfma_f32_16x16x32_bf16(ah, b0h, a0, 0, 0, 0); a0 = __builtin_amdgcn_mfma_f32_16x16x32_bf16(ah, b0l, a0, 0, 0, 0); a0 = __builtin_amdgcn_mfma_f32_16x16x32_bf16(al, b0h, a0, 0, 0, 0);
            a1 = __builtin_amdgcn_mfma_f32_16x16x32_bf16(ah, b1h, a1, 0, 0, 0); a1 = __builtin_amdgcn_mfma_f32_16x16x32_bf16(ah, b1l, a1, 0, 0, 0); a1 = __builtin_amdgcn_mfma_f32_16x16x32_bf16(al, b1h, a1, 0, 0, 0);
          }
        }
#pragma unroll
        for (int r = 0; r < 4; ++r) { lg[(4 * g4 + r) * 33 + i] = a0[r]; lg[(4 * g4 + r) * 33 + 16 + i] = a1[r]; }
        int e4[4] = {0, 0, 0, 0}, rk[4] = {0, 0, 0, 0}; float gk[4] = {0.f, 0.f, 0.f, 0.f}; const int tokrow = u * 128 + C.wave * 16 + lane;
        if (lane < 16) {
            float v[32];
#pragma unroll
            for (int e = 0; e < 32; ++e) v[e] = lg[lane * 33 + e] + C.ka->in[I_BR][e];
            float tv[4];
#pragma unroll
            for (int k = 0; k < 4; ++k) { float best = -__builtin_inff(); int be = 0;
#pragma unroll
                for (int e = 0; e < 32; ++e) { const bool taken = (k > 0 && e == e4[0]) || (k > 1 && e == e4[1]) || (k > 2 && e == e4[2]); if (!taken && v[e] > best) { best = v[e]; be = e; } }
                e4[k] = be; tv[k] = best; }
            const float p1 = __expf(tv[1] - tv[0]), p2 = __expf(tv[2] - tv[0]), p3 = __expf(tv[3] - tv[0]); const float inv = 1.0f / (1.0f + p1 + p2 + p3);
            gk[0] = inv; gk[1] = p1 * inv; gk[2] = p2 * inv; gk[3] = p3 * inv;
#pragma unroll
            for (int k = 0; k < 4; ++k) rk[k] = __hip_atomic_fetch_add(cnt + e4[k], 1, __ATOMIC_RELAXED, __HIP_MEMORY_SCOPE_WORKGROUP);
        }
        __syncthreads();
        if (C.tid < 32) basew[C.tid] = (int)__hip_atomic_fetch_add(gcount + C.tid, (unsigned)cnt[C.tid], __ATOMIC_RELAXED, __HIP_MEMORY_SCOPE_AGENT);
        __syncthreads();
        if (lane < 16) {
#pragma unroll
            for (int k = 0; k < 4; ++k) { const size_t li = (size_t)e4[k] * LIST_CAP + basew[e4[k]] + rk[k] + lofs; WSP(int, WS_LIST)[li] = tokrow * 4 + k; WSP(float, WS_LGATE)[li] = gk[k]; } }
        __syncthreads();
    }
}
__device__ __forceinline__ void moe_tables(const Ctx& C, LAS int* tb) {
    if (C.tid < 64) { const unsigned* gcount = (const unsigned*)WSP(unsigned, WS_CTL) + CW_GCOUNT; const int e = C.tid & 31;
        const int c = (int)__hip_atomic_load(gcount + e, __ATOMIC_RELAXED, __HIP_MEMORY_SCOPE_AGENT); const int tiles = (c + 255) >> 8; int incl = tiles;
#pragma unroll
        for (int o = 1; o < 32; o <<= 1) { const int v = __shfl_up(incl, o, 32); if (e >= o) incl += v; }
        if (C.tid < 32) { tb[e] = incl - tiles; tb[33 + e] = c; if (e == 31) tb[32] = incl; } }
    __syncthreads();
}
__device__ __forceinline__ void p10_combine(const Ctx& C, float* dstbase) {
    const size_t gt = (size_t)C.bid * 512 + C.tid, GT = (size_t)C.G * 512; const unsigned char* __restrict__ Y = WSP(unsigned char, WS_Y);
    const _Float16* src = WSP(_Float16, WS_X1H);
    for (size_t idx0 = gt; idx0 < (size_t)T_ * 256; idx0 += 2 * GT) {
        f16x8 xh[2]; u32x2 y[2][4]; bool ok[2];
#pragma unroll
        for (int u = 0; u < 2; ++u) { const size_t idx = idx0 + u * GT; ok[u] = idx < (size_t)T_ * 256; const size_t t = ok[u] ? idx >> 8 : 0; const int c8 = (int)(idx & 255) * 8;
            xh[u] = *(const f16x8*)(src + t * D_ + c8);
#pragma unroll
            for (int k = 0; k < 4; ++k) y[u][k] = *(const u32x2*)(Y + (t * 4 + k) * D_ + c8); }
#pragma unroll
        for (int u = 0; u < 2; ++u) { const size_t idx = idx0 + u * GT; const size_t t = idx >> 8; const int c8 = (int)(idx & 255) * 8; f32x4 sa = {0.f, 0.f, 0.f, 0.f}, sb = {0.f, 0.f, 0.f, 0.f};
#pragma unroll
            for (int k = 0; k < 4; ++k) { const f32x2 y0 = __builtin_amdgcn_cvt_pk_f32_fp8((int)y[u][k].x, false), y1 = __builtin_amdgcn_cvt_pk_f32_fp8((int)y[u][k].x, true), y2 = __builtin_amdgcn_cvt_pk_f32_fp8((int)y[u][k].y, false), y3 = __builtin_amdgcn_cvt_pk_f32_fp8((int)y[u][k].y, true);
                sa[0] += y0.x; sa[1] += y0.y; sa[2] += y1.x; sa[3] += y1.y; sb[0] += y2.x; sb[1] += y2.y; sb[2] += y3.x; sb[3] += y3.y; }
            if (ok[u]) { float* d = dstbase + t * D_ + c8; const f32x8 xf = __builtin_convertvector(xh[u], f32x8); const f32x4 a = {xf[0], xf[1], xf[2], xf[3]}, b = {xf[4], xf[5], xf[6], xf[7]};
                *(f32x4*)d = a + sa * (1.0f / Y_FP8_SCALE); *(f32x4*)(d + 4) = b + sb * (1.0f / Y_FP8_SCALE); } }
    }
}

__device__ __forceinline__ void fresh_tid(Ctx& C) { int t = threadIdx.x; asm volatile("" : "+v"(t)); C.tid = t; C.lane = t & 63; const Args* k = C.ka; asm volatile("" : "+s"(k)); C.ka = k; }
constexpr int N_PHASES = 11;
#ifndef MK_REPEAT
#define MK_REPEAT 0
#endif
#define REP(k) if ((MK_REPEAT >> (k)) & 1)
#ifndef E2_TAIL
#define E2_TAIL 11
#endif
__global__ void __launch_bounds__(512, 2) mk_fwd(Args args) {
    extern __shared__ __attribute__((aligned(16))) unsigned char lds_raw[];
    Ctx C;
    C.ka = (const Args*)__builtin_amdgcn_kernarg_segment_ptr();
    C.out = args.out; C.ws = args.ws; C.lds = (LAS unsigned char*)lds_raw; C.tid = threadIdx.x; C.lane = C.tid & 63; C.wave = __builtin_amdgcn_readfirstlane(C.tid >> 6); C.G = gridDim.x; C.bid = blockIdx.x;
    volatile LAS unsigned* misc = (volatile LAS unsigned*)(C.lds + LDS_MISC);
    if (C.tid < 4) misc[C.tid] = 0u;
    __syncthreads();
    const int lo = args.ph_lo, hi = args.ph_hi;
    XcdBarrier bar; bar.bar = WSP(unsigned, WS_CTL) + CW_BAR; bar.x = 0; bar.st = misc;
    if (hi - lo > 1) bar = xcd_barrier_post(WSP(unsigned, WS_CTL) + CW_BAR, misc);
#define IN(k) (fresh_tid(C), lo <= (k) && (k) < hi)
#define SEAM(k) do { if (IN(k) && IN((k) + 1)) xcd_barrier(bar); } while (0)
    LAS int* tb = (LAS int*)(C.lds + LDS_MISC + 64);
    if (IN(0)) { p0_prologue(C); REP(0) { xcd_barrier(bar); p0_prologue(C); } } SEAM(0);
    if (IN(1)) for (int rep_ = 0; rep_ < 1 + ((MK_REPEAT >> 1) & 1); ++rep_) { if (rep_) xcd_barrier(bar);
        const int nconv = (C.G % 8 == 0 && C.G >= 64) ? ((C.G * 3 / 8) & ~7) : 0, Gg = C.G - nconv;
        if (nconv == 0 || C.bid >= Gg) { const int cb = nconv ? C.bid - Gg : C.bid, cg = nconv ? nconv : C.G;
#ifdef MK_CONV2
            for (int r2 = 0; r2 < MK_CONV2; ++r2) { tjob_b<2048, 4096, 2>(C, cb, cg, C.ka->in[I_WE1], C.ws + WS_W1T, NEXP); tjob_b<2048, 2048, 0>(C, cb, cg, C.ka->in[I_WE2], C.ws + WS_W2T, NEXP); }
#endif
            tjob_b<2048, 4096, 2>(C, cb, cg, C.ka->in[I_WE1], C.ws + WS_W1T, NEXP); tjob_b<2048, 2048, 0>(C, cb, cg, C.ka->in[I_WE2], C.ws + WS_W2T, nconv ? NEXP - E2_TAIL : NEXP); }
        if (nconv == 0 || C.bid < Gg)
#ifdef MK_GEMM2
        for (int r3 = 0; r3 < 2; ++r3)
#endif
        {
        { pg8::Gemm g{WSP(bf16_t, WS_H8), WSP(bf16_t, WS_WIN8), T_, 3328, D_ / 2}; pg8::StaticOrder S; S.init(T_, 3328, Gg, C.bid); pg8::EpiBf16 E{WSP(bf16_t, WS_PROJ), NPROJ, 1024, 1.0f / W_FP8_SCALE};
          pg8::gemm_phase<pg8::EpiBf16, pg8::StaticOrder, false, true>(C.lds, g, S, E); }
        { pg8::Gemm g{WSP(bf16_t, WS_H), WSP(bf16_t, WS_WIN), T_, 1024, D_}; pg8::StaticOrder S; S.init(T_, 1024, Gg, C.bid); pg8::EpiBf16 E{WSP(bf16_t, WS_PROJ), NPROJ, 0, 1.0f};
          pg8::gemm_phase<pg8::EpiBf16, pg8::StaticOrder, false>(C.lds, g, S, E); }
        { pg8::Gemm g{WSP(bf16_t, WS_MEMN), WSP(bf16_t, WS_WKV), NB * MEMT, 1024, D_ / 2}; pg8::StaticOrder S; S.init(NB * MEMT, 1024, Gg, Gg >= 128 ? C.bid - 64 : C.bid); pg8::EpiBf16 E{WSP(bf16_t, WS_MEMKV), 1024, 0, 1.0f / W_FP8_SCALE};
          pg8::gemm_phase<pg8::EpiBf16, pg8::StaticOrder, false, true>(C.lds, g, S, E); }
        fresh_tid(C); if (nconv) tjob_b<2048, 2048, 0>(C, C.bid, Gg, C.ka->in[I_WE2] + (size_t)(NEXP - E2_TAIL) * FF * D_, C.ws + WS_W2T + (size_t)(NEXP - E2_TAIL) * FF * D_, E2_TAIL);
        }
    } SEAM(1);
    if (IN(2)) { p2_token_prep(C); REP(2) { xcd_barrier(bar); p2_token_prep(C); } } SEAM(2);
    if (IN(3)) { tile_attn_phase<MODE_WIN>(C); REP(3) { tile_attn_phase<MODE_WIN>(C); } fresh_tid(C); for (int rep_ = 0; rep_ < 1 + ((MK_REPEAT >> 13) & 1); ++rep_) xattn_tiled(C); fresh_tid(C); p3_tasks(C); REP(4) { xcd_barrier(bar); p3_tasks(C); } } SEAM(3);
    if (IN(4)) { REP(11) { p4_tiled(C, true); xcd_barrier(bar); } p4_tiled(C); } SEAM(4);
    if (IN(5)) { tile_attn_phase<MODE_SEL>(C); REP(5) { xcd_barrier(bar);
#ifdef MK_SELDRY
            tile_attn_phase<MODE_SEL, MK_SELDRY>(C);
#else
            tile_attn_phase<MODE_SEL>(C);
#endif
        } } SEAM(5);
    if (IN(6)) for (int rep_ = ((MK_REPEAT >> 6) & 1) ? 0 : 1; rep_ < 2; ++rep_) { pg8::Gemm g{WSP(bf16_t, WS_MIX), WSP(bf16_t, WS_WOUT), T_, D_, MIXP / 2}; pg8::StaticOrder S; S.init(T_, D_, C.G, C.bid); pg8::EpiResF32 E{C.ka, C.ws, D_, rep_ ? WS_ROWSS : WS_PROJ, 1.0f / (MIX_SCALE * W_FP8_SCALE)};
        pg8::gemm_phase<pg8::EpiResF32, pg8::StaticOrder, false, 2>(C.lds, g, S, E); if (!rep_) xcd_barrier(bar); } SEAM(6);
    if (IN(7)) { REP(7) { p7_ffn_prep(C, true); xcd_barrier(bar); } p7_ffn_prep(C); } SEAM(7);
    if (IN(8)) for (int rep_ = 0; rep_ < 1 + ((MK_REPEAT >> 8) & 1); ++rep_) { if (rep_) xcd_barrier(bar); moe_tables(C, tb); pg8::Gemm g{WSP(bf16_t, WS_H), WSP(bf16_t, WS_W1T), 0, 4096, D_ / 2};   pg8::MoeOrder S; S.init_moe(16, C.G, C.bid, tb, C.ws, (LAS int*)(C.lds + LDS_MISC + 2048));
        pg8::EpiGlu E{C.ws};
        pg8::gemm_phase<pg8::EpiGlu, pg8::MoeOrder, true, true>(C.lds, g, S, E); } SEAM(8);
    if (IN(9)) for (int rep_ = 0; rep_ < 1 + ((MK_REPEAT >> 9) & 1); ++rep_) { if (rep_) xcd_barrier(bar); moe_tables(C, tb); pg8::Gemm g{WSP(bf16_t, WS_ACT), WSP(bf16_t, WS_W2T), 0, D_, FF / 2}; pg8::MoeOrder S; S.init_moe(8, C.G, C.bid, tb, C.ws, (LAS int*)(C.lds + LDS_MISC + 2048));
        pg8::EpiScatter E{C.ws, C.ka};
        pg8::gemm_phase<pg8::EpiScatter, pg8::MoeOrder, false, true>(C.lds, g, S, E); } SEAM(9);
    if (IN(10)) { REP(10) { p10_combine(C, WSP(float, WS_PROJ)); xcd_barrier(bar); } p10_combine(C, C.out); }
#undef IN
#undef SEAM
}

extern "C" void kernel_launch(void* const* d_in, const int* in_sizes, int n_in, void* d_out, int out_size, void* d_ws, size_t ws_size, hipStream_t stream) {
    static int grid = 0;
    if (grid == 0) {
        if (n_in != 27 || out_size != T_ * D_ || ws_size < WS_END) { fprintf(stderr, "kernel_launch: unexpected shapes (n_in %d, out %d, ws %zu < %zu)\n", n_in, out_size, ws_size, (size_t)WS_END); grid = -1; return; }
        int dev = 0, cus = 0, per_cu = 0;
        if (hipGetDevice(&dev) != hipSuccess || hipDeviceGetAttribute(&cus, hipDeviceAttributeMultiprocessorCount, dev) != hipSuccess) { grid = -1; return; }
        if (hipFuncSetAttribute((const void*)mk_fwd, hipFuncAttributeMaxDynamicSharedMemorySize, LDS_BYTES) != hipSuccess) { fprintf(stderr, "kernel_launch: hipFuncSetAttribute failed\n"); grid = -1; return; }
        if (hipOccupancyMaxActiveBlocksPerMultiprocessor(&per_cu, (const void*)mk_fwd, 512, LDS_BYTES) != hipSuccess || per_cu < 1) fprintf(stderr, "kernel_launch: occupancy query reports %d\n", per_cu);
        (void)hipGetLastError();
        grid = cus;
    }
    if (grid < 0) return;
    (void)in_sizes;
    if (hipMemsetAsync((char*)d_ws + WS_CTL, 0, CTL_BYTES, stream) != hipSuccess) return;
    Args a{};
    for (int i = 0; i < 27; ++i) a.in[i] = (const float*)d_in[i];
    a.out = (float*)d_out; a.ws = (unsigned char*)d_ws;
#if MK_N_LAUNCHES == 1
    a.ph_lo = 0; a.ph_hi = N_PHASES;
    hipLaunchKernelGGL(mk_fwd, dim3(grid), dim3(512), LDS_BYTES, stream, a);
#else
    for (int p = 0; p < N_PHASES; ++p) { a.ph_lo = p; a.ph_hi = p + 1; hipLaunchKernelGGL(mk_fwd, dim3(grid), dim3(512), LDS_BYTES, stream, a); }
#endif
}
```

```cpp
#include <hip/hip_runtime.h>
#include <cstdio>
#include <cstdint>

#ifndef MK_N_LAUNCHES
#define MK_N_LAUNCHES 1
#endif

#define LAS __attribute__((address_space(3)))
typedef unsigned short bf16_t;
typedef short bf16x8 __attribute__((ext_vector_type(8)));
typedef float f32x4 __attribute__((ext_vector_type(4)));
typedef float f32x2 __attribute__((ext_vector_type(2)));
typedef _Float16 f16x8 __attribute__((ext_vector_type(8)));
typedef float f32x8 __attribute__((ext_vector_type(8)));
typedef unsigned u32x4 __attribute__((ext_vector_type(4)));
typedef unsigned u32x2 __attribute__((ext_vector_type(2)));

constexpr int NB = 2, S_ = 16384, T_ = NB * S_, D_ = 2048, MEMT = 256;
constexpr int NPROJ = 4352;
constexpr int C_UV = 0, C_Q = 1024, C_KV = 2048, C_QX = 3584, C_GATE = 4096;
constexpr int IN_COLS = 4120;
constexpr int NEXP = 32, FF = 2048;
constexpr int LIST_CAP = T_;
constexpr int MAX_TILES = (T_ * 4) / 256 + NEXP;
constexpr float EPS = 1e-6f;

constexpr size_t al256(size_t x) { return (x + 255) & ~(size_t)255; }
constexpr size_t WS_CTL   = 0;
constexpr size_t CTL_BYTES = 65536;
constexpr size_t WS_H     = al256(WS_CTL + CTL_BYTES);
constexpr size_t WS_WIN   = al256(WS_H + (size_t)T_ * D_ * 2);
constexpr size_t WS_WOUT  = al256(WS_WIN + (size_t)NPROJ * D_ * 2);
constexpr size_t WS_W1T   = al256(WS_WOUT + (size_t)D_ * D_ * 2);
constexpr size_t WS_W2T   = al256(WS_W1T + (size_t)NEXP * 4096 * D_ * 2);
constexpr size_t WS_WKV   = al256(WS_W2T + (size_t)NEXP * D_ * FF * 2);
constexpr size_t WS_WRH   = al256(WS_WKV + (size_t)1024 * D_ * 2);
constexpr size_t WS_WRL   = al256(WS_WRH + (size_t)32 * D_ * 2);
constexpr size_t WS_CK1   = al256(WS_WRL + (size_t)32 * D_ * 2);
constexpr size_t WS_CV1   = al256(WS_CK1 + (size_t)128 * 4096 * 2);
constexpr size_t WS_CK2   = al256(WS_CV1 + (size_t)128 * 4096 * 2);
constexpr size_t WS_CV2   = al256(WS_CK2 + (size_t)128 * 128 * 2);
constexpr size_t WS_C1    = al256(WS_CV2 + (size_t)128 * 128 * 2);
constexpr size_t WS_B1G   = al256(WS_C1 + 1024);
constexpr size_t WS_B1L   = al256(WS_B1G + (size_t)NEXP * FF * 4);
constexpr size_t WS_GWS   = al256(WS_B1L + (size_t)NEXP * FF * 4);
constexpr size_t WS_MISC  = al256(WS_GWS + (size_t)4 * 128 * 128 * 2);
constexpr size_t WS_MEMN  = al256(WS_MISC + 1024);
constexpr size_t WS_PROJ  = al256(WS_MEMN + (size_t)512 * D_ * 2);
constexpr size_t WS_MEMKV = al256(WS_PROJ + (size_t)T_ * NPROJ * 2);
constexpr size_t WS_UB    = al256(WS_MEMKV + (size_t)512 * 1024 * 2);
constexpr size_t WS_VTG   = al256(WS_UB + (size_t)T_ * 512 * 2);
constexpr size_t WS_QN    = al256(WS_VTG + (size_t)T_ * 512 * 2);
constexpr size_t WS_QR    = al256(WS_QN + (size_t)T_ * 1024 * 2);
constexpr size_t KVROWS   = (size_t)NB * 2 * S_ + 64;
constexpr size_t WS_KCMP  = al256(WS_QR + (size_t)T_ * 1024 * 2);
constexpr size_t WS_VCMP  = al256(WS_KCMP + KVROWS * 128 * 2);
constexpr size_t WS_KSEL  = al256(WS_VCMP + KVROWS * 128 * 2);
constexpr size_t WS_KWIN  = al256(WS_KSEL + KVROWS * 128 * 2);
constexpr size_t WS_VSELT = al256(WS_KWIN + KVROWS * 128 * 2);
constexpr size_t WS_VWINT = al256(WS_VSELT + KVROWS * 128 * 2);
constexpr size_t WS_KC    = al256(WS_VWINT + KVROWS * 128 * 2);
constexpr size_t WS_VCT   = al256(WS_KC + (size_t)4 * 1024 * 128 * 2);
constexpr size_t WS_KX    = al256(WS_VCT + (size_t)4 * 1024 * 128 * 2);
constexpr size_t WS_VXT   = al256(WS_KX + (size_t)8 * 256 * 128 * 2);
constexpr size_t WS_QX    = al256(WS_VXT + (size_t)8 * 256 * 128 * 2);
constexpr size_t WS_GATES = al256(WS_QX + (size_t)T_ * 512 * 2);
constexpr size_t WS_MIXACC= al256(WS_GATES + (size_t)T_ * 24 * 4);
constexpr size_t WS_MIX   = al256(WS_MIXACC + (size_t)T_ * 1024 * 4);
constexpr size_t WS_IDX   = al256(WS_MIX + (size_t)T_ * D_ * 2);
constexpr size_t WS_ROWSS = al256(WS_IDX + (size_t)4 * S_ * 16 * 4);
constexpr size_t WS_PAIRG = al256(WS_ROWSS + (size_t)T_ * 32 * 4);
constexpr size_t WS_LIST  = al256(WS_PAIRG + (size_t)T_ * 4 * 4);
constexpr size_t WS_LGATE = al256(WS_LIST + (size_t)NEXP * LIST_CAP * 4);
constexpr size_t WS_H8    = al256(WS_LGATE + (size_t)NEXP * LIST_CAP * 4);
constexpr size_t WS_WIN8  = al256(WS_H8 + (size_t)T_ * D_);
constexpr size_t WS_ACT   = al256(WS_WIN8 + (size_t)3328 * D_);
constexpr size_t WS_Y     = al256(WS_ACT + (size_t)MAX_TILES * 256 * FF * 2);
constexpr size_t WS_X1H   = al256(WS_Y + (size_t)T_ * 4 * D_ * 2);
constexpr size_t WS_B2C   = al256(WS_X1H + (size_t)T_ * D_ * 2);
constexpr size_t WS_END   = al256(WS_B2C + (size_t)NEXP * D_ * 4);
constexpr int CW_BAR = 0;
constexpr int CW_GCOUNT = 4096;
constexpr int CW_XSLOT = 4352;

constexpr int LDS_SCRATCH = 139264;
constexpr int LDS_MISC = LDS_SCRATCH;
constexpr int LDS_BYTES = 147456;

__device__ __forceinline__ float bf2f(bf16_t v) { return __uint_as_float(((unsigned)v) << 16); }
__device__ __forceinline__ bf16_t f2bf(float f) { unsigned u = __float_as_uint(f); u += 0x7FFFu + ((u >> 16) & 1u); return (bf16_t)(u >> 16); }
__device__ __forceinline__ unsigned cvt_pk_bf16(float lo, float hi) { unsigned r; asm volatile("v_cvt_pk_bf16_f32 %0, %1, %2" : "=v"(r) : "v"(lo), "v"(hi)); return r; }
__device__ __forceinline__ bf16x8 pack8(float a0, float a1, float a2, float a3, float a4, float a5, float a6, float a7) {
    u32x4 w = {cvt_pk_bf16(a0, a1), cvt_pk_bf16(a2, a3), cvt_pk_bf16(a4, a5), cvt_pk_bf16(a6, a7)}; return __builtin_bit_cast(bf16x8, w); }
__device__ __forceinline__ unsigned pk4_fp8(float a, float b, float c, float d) {
    a = fminf(fmaxf(a, -448.f), 448.f); b = fminf(fmaxf(b, -448.f), 448.f); c = fminf(fmaxf(c, -448.f), 448.f); d = fminf(fmaxf(d, -448.f), 448.f);
    int p = __builtin_amdgcn_cvt_pk_fp8_f32(a, b, 0, false); p = __builtin_amdgcn_cvt_pk_fp8_f32(c, d, p, true); return (unsigned)p; }
typedef int i32x4 __attribute__((ext_vector_type(4)));
typedef int i32x8 __attribute__((ext_vector_type(8)));
constexpr float W_FP8_SCALE = 256.0f;
constexpr int W_FP8_SCALE_E8M0 = 0x77777777;
constexpr float MIX_SCALE = 16.0f;
constexpr int MIXP = 2560;
constexpr float Y_FP8_SCALE = 16.0f;
template <int CTRL> __device__ __forceinline__ float dppf(float v) { return __builtin_bit_cast(float, __builtin_amdgcn_update_dpp(0, __builtin_bit_cast(int, v), CTRL, 0xF, 0xF, true)); }
template <int CTRL> __device__ __forceinline__ unsigned dppu(unsigned v) { return (unsigned)__builtin_amdgcn_update_dpp(0, (int)v, CTRL, 0xF, 0xF, true); }
__device__ __forceinline__ float rdlane(float v, int l) { return __builtin_bit_cast(float, __builtin_amdgcn_readlane(__builtin_bit_cast(int, v), l)); }
__device__ __forceinline__ float wave_sum(float v) {
    v += dppf<0xB1>(v); v += dppf<0x4E>(v); v += dppf<0x141>(v); v += dppf<0x140>(v);
    return (rdlane(v, 0) + rdlane(v, 16)) + (rdlane(v, 32) + rdlane(v, 48)); }
__device__ __forceinline__ unsigned wave_umax(unsigned v) {
    unsigned t;
    t = dppu<0xB1>(v); v = v > t ? v : t; t = dppu<0x4E>(v); v = v > t ? v : t; t = dppu<0x141>(v); v = v > t ? v : t; t = dppu<0x140>(v); v = v > t ? v : t;
    const unsigned a = (unsigned)__builtin_amdgcn_readlane((int)v, 0), b = (unsigned)__builtin_amdgcn_readlane((int)v, 16), c = (unsigned)__builtin_amdgcn_readlane((int)v, 32), d = (unsigned)__builtin_amdgcn_readlane((int)v, 48);
    const unsigned m0 = a > b ? a : b, m1 = c > d ? c : d; return m0 > m1 ? m0 : m1; }
__device__ __forceinline__ unsigned wave_umax63(unsigned v) {
    unsigned t;
    t = dppu<0xB1>(v); v = v > t ? v : t; t = dppu<0x4E>(v); v = v > t ? v : t; t = dppu<0x141>(v); v = v > t ? v : t; t = dppu<0x140>(v); v = v > t ? v : t;
    t = (unsigned)__builtin_amdgcn_update_dpp(0, (int)v, 0x142, 0xA, 0xF, false); v = v > t ? v : t;
    t = (unsigned)__builtin_amdgcn_update_dpp(0, (int)v, 0x143, 0xC, 0xF, false); v = v > t ? v : t;
    return (unsigned)__builtin_amdgcn_readlane((int)v, 63); }
__device__ __forceinline__ float gelu_tanh(float x) {
    const float u = 1.5957691216057308f * (x + 0.044715f * x * x * x);
    return x / (1.0f + __expf(-u)); }
__device__ __forceinline__ float sigmoidf_(float x) { return 1.0f / (1.0f + __expf(-x)); }
#define XB_TMO      128
#define XB_XCNT(j)  (256  + 64 * (j))
#define XB_XSUB(j)  (1280 + 64 * (j))
#define XB_XGEN(j)  (2304 + 64 * (j))
#define XB_TOP      3328
#define XB_TOPGEN   3392
#define XCD_BAR_WORDS 3456
#define XB_SPIN_CAP (1u << 22)

__device__ __forceinline__ unsigned xb_ld(unsigned* p)              { return __hip_atomic_load(p, __ATOMIC_RELAXED, __HIP_MEMORY_SCOPE_AGENT); }
__device__ __forceinline__ unsigned xb_add(unsigned* p, unsigned v) { return __hip_atomic_fetch_add(p, v, __ATOMIC_RELAXED, __HIP_MEMORY_SCOPE_AGENT); }
__device__ __forceinline__ unsigned xb_xcc_id() { return (unsigned)__builtin_amdgcn_s_getreg((3 << 11) | 20) & 0xFu; }
#define XB_SPIN(cond, bar) do { unsigned _sp = 0; while (cond) { __builtin_amdgcn_s_sleep(1); \
    if ((++_sp & 255u) == 0u) { if (xb_ld(&(bar)[XB_TMO])) break; if (_sp > XB_SPIN_CAP) { atomicAdd(&(bar)[XB_TMO], 1u); break; } } } } while (0)

struct XcdBarrier {
    unsigned* bar; unsigned x;
    volatile LAS unsigned* st;
};
__device__ __forceinline__ XcdBarrier xcd_barrier_post(unsigned* bar, volatile LAS unsigned* st) {
    XcdBarrier b; b.bar = bar; b.x = xb_xcc_id(); b.st = st;
    if (threadIdx.x == 0) (void)xb_add(&bar[XB_XCNT(b.x)], 1u);
    return b;
}
__device__ __forceinline__ void xcd_barrier_complete(unsigned* bar, unsigned x, unsigned& nloc, unsigned& nx) {
    const unsigned G = gridDim.x * gridDim.y * gridDim.z;
    unsigned sum, cnt, mine, sp = 0u;
    for (;;) {
        sum = 0u; cnt = 0u; mine = 0u;
#pragma unroll
        for (unsigned j = 0; j < 16; ++j) { const unsigned c = xb_ld(&bar[XB_XCNT(j)]); sum += c; cnt += (c > 0u) ? 1u : 0u; mine = (j == x) ? c : mine; }
        if (sum == G) break;
        __builtin_amdgcn_s_sleep(1);
        if ((++sp & 255u) == 0u) { if (xb_ld(&bar[XB_TMO])) break; if (sp > XB_SPIN_CAP) { atomicAdd(&bar[XB_TMO], 1u); break; } }
    }
    nloc = mine > 0u ? mine : 1u; nx = cnt > 0u ? cnt : 1u;
}
__device__ __forceinline__ void xcd_barrier(const XcdBarrier& b) {
    asm volatile("s_waitcnt vmcnt(0)" ::: "memory");
    __syncthreads();
    if (threadIdx.x == 0) {
        unsigned* bar = b.bar;
        __builtin_amdgcn_s_waitcnt(0);
        unsigned nloc = b.st[0], nx = b.st[1];
        if (nloc == 0u) { xcd_barrier_complete(bar, b.x, nloc, nx); b.st[0] = nloc; b.st[1] = nx; }
        const unsigned old = xb_add(&bar[XB_XSUB(b.x)], 1u);
        const unsigned gen = old / nloc;
        if (old + 1u == (gen + 1u) * nloc) {
            __builtin_amdgcn_fence(__ATOMIC_RELEASE, "agent");
            asm volatile("s_waitcnt vmcnt(0)" ::: "memory");
            const unsigned og = xb_add(&bar[XB_TOP], 1u);
            const unsigned tg = og / nx;
            if (og + 1u == (tg + 1u) * nx) xb_add(&bar[XB_TOPGEN], 1u);
            else XB_SPIN(xb_ld(&bar[XB_TOPGEN]) == tg, bar);
            __builtin_amdgcn_fence(__ATOMIC_ACQUIRE, "agent");
            xb_add(&bar[XB_XGEN(b.x)], 1u);
            asm volatile("s_waitcnt vmcnt(0)" ::: "memory");
        } else {
            XB_SPIN(xb_ld(&bar[XB_XGEN(b.x)]) == gen, bar);
            __builtin_amdgcn_fence(__ATOMIC_ACQUIRE, "agent");
            asm volatile("s_waitcnt vmcnt(0)" ::: "memory");
        }
    }
    __syncthreads();
}

struct Args;
__device__ __forceinline__ const float* args_in(const Args* ka, int k);
namespace pg8 {
constexpr int BM = 256, BK = 64, HALF = 128, HTB = HALF * BK * 2  , STAGE_BYTES = 8 * HTB, NXCD = 8, WGM = 8;
__host__ __device__ __forceinline__ int lds_byte(int r, int c) { const int st = (r >> 4) * 2 + (c >> 5), rr = r & 15, cc = c & 31, ob = rr * 64 + cc * 2; return st * 1024 + (ob ^ (((ob >> 9) & 1) << 5)); }
__host__ __device__ __forceinline__ void stage_rc(int b, int& R, int& C) { const int st = b / 1024, sb = b % 1024, swz = sb ^ (((sb >> 9) & 1) << 5); R = (st >> 1) * 16 + swz / 64; C = (st & 1) * 32 + (swz % 64) / 2; }
__host__ __device__ __forceinline__ int perm32(int rho) { const int n = rho >> 4, i = rho & 15; return 8 * (i >> 2) + 4 * n + (i & 3); }

struct Unit { int pm, pn, pb, e, cnt, pos0; };
struct Gemm { const bf16_t* A; const bf16_t* Bt; int M, N, K; };

struct StaticOrder {
    int nM, nN, nwg, G, c;
    __host__ __device__ void init(int M, int N, int G_, int c_) { nM = M / BM; nN = N / BM; nwg = nM * nN; G = G_; c = c_; }
    __host__ __device__ bool map(int i, int& pm, int& pn) const {
        const int L = i * G + c; if (L >= nwg || c < 0) return false;
        int wgid = L; { const int q = nwg / NXCD, r = nwg % NXCD, xcd = wgid % NXCD, off = wgid / NXCD; wgid = (xcd < r ? xcd * (q + 1) : r * (q + 1) + (xcd - r) * q) + off; }
        const int nig = WGM * nN, gid = wgid / nig, fm = gid * WGM, gsz = (nM - fm) < WGM ? (nM - fm) : WGM;
        pm = fm + ((wgid % nig) % gsz); pn = (wgid % nig) / gsz; return true;
    }
    __device__ __forceinline__ bool next(int i, Unit& u) const { if (!map(i, u.pm, u.pn)) return false; u.pb = u.pn; u.e = 0; u.cnt = 0; u.pos0 = 0; return true; }
    __device__ __forceinline__ int arow(const Unit&, int) const { return 0; }
    __device__ __forceinline__ void tables(LAS unsigned char*, LAS unsigned char*, const Unit&, int, int) const {}
    __device__ __forceinline__ void a_ready(const Unit&) const {}
    __device__ __forceinline__ void done(const Unit&) const {}
};
struct MoeOrder : StaticOrder {
    const LAS int* tb; const unsigned char* ws;
    const LAS int* ul;
    __device__ void init_moe(int nN_, int G_, int c_, const LAS int* tb_, const unsigned char* ws_, LAS int* ul_) { tb = tb_; ws = ws_; ul = ul_; nM = __builtin_amdgcn_readfirstlane(tb_[32]); nN = nN_; nwg = nM * nN; G = G_; c = c_;
        const int k = threadIdx.x;
        if (k < 128) { int pm = -1, pn = 0, e = 0, cnt = 0, pos0 = 0;
            if (map(k, pm, pn)) { if (nN_ == 8) pm = nM - 1 - pm;
#pragma unroll
                for (int s = 16; s >= 1; s >>= 1) if (tb[e + s] <= pm) e += s;
                cnt = tb[33 + e]; pos0 = (pm - tb[e]) * BM; } else pm = -1;
            ul_[k * 8 + 0] = pm; ul_[k * 8 + 1] = pn; ul_[k * 8 + 2] = e; ul_[k * 8 + 3] = cnt; ul_[k * 8 + 4] = pos0; ul_[k * 8 + 5] = e * nN_ + pn; }
        __syncthreads(); }
    __device__ __forceinline__ bool next(int i, Unit& u) const {
        if (i >= 128) return false;
        const i32x4 a = *(const LAS i32x4*)(ul + i * 8); const int p0 = ul[i * 8 + 4], pb = ul[i * 8 + 5];
        u.pm = __builtin_amdgcn_readfirstlane(a[0]); if (u.pm < 0) return false;
        u.pn = __builtin_amdgcn_readfirstlane(a[1]); u.e = __builtin_amdgcn_readfirstlane(a[2]); u.cnt = __builtin_amdgcn_readfirstlane(a[3]); u.pos0 = __builtin_amdgcn_readfirstlane(p0); u.pb = __builtin_amdgcn_readfirstlane(pb); return true;
    }
    __device__ __forceinline__ void tables(LAS unsigned char* tbl, LAS unsigned char* b2l, const Unit& u, int wid, int lane) const {
        if (wid < 4) { int pos = u.pos0 + 64 * wid + lane; pos = pos < u.cnt ? pos : u.cnt - 1; const int vo = (u.e * LIST_CAP + pos) * 4;
            const __amdgpu_buffer_rsrc_t rl = __builtin_amdgcn_make_buffer_rsrc((void*)(ws + WS_LIST), 0, 0xFFFFFFF0u, 0x00020000);
            __builtin_amdgcn_raw_ptr_buffer_load_lds(rl, (LAS void*)(tbl + wid * 256), 4, vo, 0, 0, 0);
            if (nN == 8) { const __amdgpu_buffer_rsrc_t rg = __builtin_amdgcn_make_buffer_rsrc((void*)(ws + WS_LGATE), 0, 0xFFFFFFF0u, 0x00020000);
                __builtin_amdgcn_raw_ptr_buffer_load_lds(rg, (LAS void*)(tbl + 1024 + wid * 256), 4, vo, 0, 0, 0); }
        } else if (nN == 8) {
            const __amdgpu_buffer_rsrc_t rb = __builtin_amdgcn_make_buffer_rsrc((void*)(ws + WS_B2C), 0, 0xFFFFFFF0u, 0x00020000);
            __builtin_amdgcn_raw_ptr_buffer_load_lds(rb, (LAS void*)(b2l + (wid - 4) * 256), 4, (u.e * D_ + u.pn * BM + 64 * (wid - 4) + lane) * 4, 0, 0, 0);
        } else if (wid < 6) { const __amdgpu_buffer_rsrc_t rb = __builtin_amdgcn_make_buffer_rsrc((void*)(ws + (wid == 4 ? WS_B1G : WS_B1L)), 0, 0xFFFFFFF0u, 0x00020000);
            const int vo = (u.e * FF + u.pn * HALF + lane) * 4;
            __builtin_amdgcn_raw_ptr_buffer_load_lds(rb, (LAS void*)(tbl + 1024 + (wid - 4) * 512), 4, vo, 0, 0, 0);
            __builtin_amdgcn_raw_ptr_buffer_load_lds(rb, (LAS void*)(tbl + 1024 + (wid - 4) * 512 + 256), 4, vo + 256, 0, 0, 0); }
    }
    __device__ __forceinline__ int arow(const Unit& u, int r) const { int pos = u.pos0 + r; pos = pos < u.cnt ? pos : u.cnt - 1; return ((const int*)(ws + WS_LIST))[(size_t)u.e * LIST_CAP + pos] >> 2; }
};

struct EpiBf16 {
    static constexpr bool PERM = true;
    bf16_t* O; int ldc; int colo; float scale;
    __device__ __forceinline__ void operator()(const f32x4 (&acc)[2][2][4][2], const Unit& u, int wr, int wc, int fr, int fq, LAS const unsigned char* tbl, LAS const unsigned char* b2l) const {
        { int t_ = threadIdx.x; asm volatile("" : "+v"(t_)); fr = t_ & 15; fq = (t_ >> 4) & 3; }
        const int row0 = u.pm * BM + wr * 64 + fr; const int col0 = colo + u.pn * BM + wc * 32 + 8 * fq;
#pragma unroll
        for (int ai = 0; ai < 2; ++ai)
#pragma unroll
            for (int m = 0; m < 4; ++m) { bf16_t* rowp = O + (size_t)(row0 + ai * HALF + m * 16) * ldc + col0;
#pragma unroll
                for (int bj = 0; bj < 2; ++bj) { const f32x4 v0 = acc[ai][bj][m][0] * scale, v1 = acc[ai][bj][m][1] * scale;
                    u32x4 w; w.x = cvt_pk_bf16(v0[0], v0[1]); w.y = cvt_pk_bf16(v0[2], v0[3]); w.z = cvt_pk_bf16(v1[0], v1[1]); w.w = cvt_pk_bf16(v1[2], v1[3]);
                    *(u32x4*)(rowp + bj * HALF) = w; } }
    }
};
struct EpiResF32 {
    static constexpr bool PERM = true;
    const Args* ka; unsigned char* ws; int ldc; size_t rowss_off; float scale;
    __device__ __forceinline__ void operator()(const f32x4 (&acc)[2][2][4][2], const Unit& u, int wr, int wc, int fr, int fq, LAS const unsigned char* tbl, LAS const unsigned char* b2l) const {
        const int row0 = u.pm * BM + wr * 64 + fr, col0 = u.pn * BM + wc * 32 + 8 * fq;
        const float* __restrict__ rp = args_in(ka, 0); _Float16* __restrict__ cp = (_Float16*)(ws + WS_X1H); float* rowss = (float*)(ws + rowss_off);
#pragma unroll
        for (int ai = 0; ai < 2; ++ai)
#pragma unroll
            for (int mp = 0; mp < 2; ++mp) { f32x4 r[2][2][2];
#pragma unroll
                for (int mm = 0; mm < 2; ++mm) { const size_t off = (size_t)(row0 + ai * HALF + (2 * mp + mm) * 16) * ldc + col0;
#pragma unroll
                    for (int bj = 0; bj < 2; ++bj)
#pragma unroll
                        for (int n = 0; n < 2; ++n) r[mm][bj][n] = __builtin_nontemporal_load((const f32x4*)(rp + off + bj * HALF + n * 4)); }
#pragma unroll
                for (int mm = 0; mm < 2; ++mm) { const int m = 2 * mp + mm; const int row = row0 + ai * HALF + m * 16; const size_t off = (size_t)row * ldc + col0; float ss = 0.f;
#pragma unroll
                    for (int bj = 0; bj < 2; ++bj) { const f32x4 o0 = r[mm][bj][0] + acc[ai][bj][m][0] * scale, o1 = r[mm][bj][1] + acc[ai][bj][m][1] * scale;
                        ss += ((o0[0] * o0[0] + o0[1] * o0[1]) + (o0[2] * o0[2] + o0[3] * o0[3])) + ((o1[0] * o1[0] + o1[1] * o1[1]) + (o1[2] * o1[2] + o1[3] * o1[3]));
                        f16x8 h;
#pragma unroll
                        for (int j = 0; j < 4; ++j) { h[j] = (_Float16)__builtin_amdgcn_fmed3f(o0[j], -65504.0f, 65504.0f); h[4 + j] = (_Float16)__builtin_amdgcn_fmed3f(o1[j], -65504.0f, 65504.0f); }
                        *(f16x8*)(cp + off + bj * HALF) = h; }
                    ss += __shfl_xor(ss, 16); ss += __shfl_xor(ss, 32);
                    if (fq == 0) rowss[(size_t)row * 32 + u.pn * 4 + wc] = ss; } }
    }
};
struct EpiGlu {
    static constexpr bool PERM = true;
    unsigned char* ws;
    __device__ __forceinline__ void operator()(const f32x4 (&acc)[2][2][4][2], const Unit& u, int wr, int wc, int fr, int fq, LAS const unsigned char* tbl, LAS const unsigned char* b2l) const {
        { int t_ = threadIdx.x; asm volatile("" : "+v"(t_)); fr = t_ & 15; fq = (t_ >> 4) & 3; }
        const int row0 = u.pm * BM + wr * 64 + fr; const int cl = wc * 32 + 8 * fq; const int col0 = u.pn * HALF + cl;
        unsigned char* act = ws + WS_ACT;
        typedef float f32x2_ __attribute__((ext_vector_type(2)));
        f32x4 gb[2], lb[2]; gb[0] = *(LAS const f32x4*)(tbl + 1024 + cl * 4); gb[1] = *(LAS const f32x4*)(tbl + 1024 + cl * 4 + 16); lb[0] = *(LAS const f32x4*)(tbl + 1536 + cl * 4) + 1.0f; lb[1] = *(LAS const f32x4*)(tbl + 1536 + cl * 4 + 16) + 1.0f;
        const f32x2_ sc2 = {1.0f / W_FP8_SCALE, 1.0f / W_FP8_SCALE}, ce2 = {-1.702f * 1.4426950409f, -1.702f * 1.4426950409f}, one2 = {1.0f, 1.0f};
#pragma unroll
        for (int ai = 0; ai < 2; ++ai)
#pragma unroll
            for (int m = 0; m < 4; ++m) { unsigned char* rowp = act + (size_t)(row0 + ai * HALF + m * 16) * FF + col0; f32x2_ o[4];
#pragma unroll
                for (int n = 0; n < 2; ++n)
#pragma unroll
                    for (int h = 0; h < 2; ++h) { const f32x4 ag = acc[ai][0][m][n], al = acc[ai][1][m][n];
                        const f32x2_ a2 = {ag[2 * h], ag[2 * h + 1]}, b2 = {al[2 * h], al[2 * h + 1]}, g2 = {gb[n][2 * h], gb[n][2 * h + 1]}, l2 = {lb[n][2 * h], lb[n][2 * h + 1]};
                        f32x2_ gv = __builtin_elementwise_fma(a2, sc2, g2), lv = __builtin_elementwise_fma(b2, sc2, l2);
                        gv[0] = fminf(gv[0], 7.0f); gv[1] = fminf(gv[1], 7.0f); lv[0] = __builtin_amdgcn_fmed3f(lv[0], -6.0f, 8.0f); lv[1] = __builtin_amdgcn_fmed3f(lv[1], -6.0f, 8.0f);
                        f32x2_ e = gv * ce2; e[0] = __builtin_amdgcn_exp2f(e[0]); e[1] = __builtin_amdgcn_exp2f(e[1]); e = e + one2; e[0] = __builtin_amdgcn_rcpf(e[0]); e[1] = __builtin_amdgcn_rcpf(e[1]);
                        o[n * 2 + h] = (gv * e) * lv; }
                u32x2 w; int p0 = __builtin_amdgcn_cvt_pk_fp8_f32(o[0][0], o[0][1], 0, false); p0 = __builtin_amdgcn_cvt_pk_fp8_f32(o[1][0], o[1][1], p0, true);
                int p1 = __builtin_amdgcn_cvt_pk_fp8_f32(o[2][0], o[2][1], 0, false); p1 = __builtin_amdgcn_cvt_pk_fp8_f32(o[3][0], o[3][1], p1, true); w.x = (unsigned)p0; w.y = (unsigned)p1;
                *(u32x2*)rowp = w; }
    }
};
struct EpiScatter {
    static constexpr bool PERM = true;
    unsigned char* ws; const Args* ka;
    __device__ __forceinline__ void operator()(const f32x4 (&acc)[2][2][4][2], const Unit& u, int wr, int wc, int fr, int fq, LAS const unsigned char* tbl, LAS const unsigned char* b2l) const {
        { int t_ = threadIdx.x; asm volatile("" : "+v"(t_)); fr = t_ & 15; fq = (t_ >> 4) & 3; }
        const int r0 = wr * 64 + fr; const int col0 = u.pn * BM + wc * 32 + 8 * fq;
        unsigned char* Y = ws + WS_Y;
        f32x4 bv[2][2];
#pragma unroll
        for (int bj = 0; bj < 2; ++bj)
#pragma unroll
            for (int n = 0; n < 2; ++n) bv[bj][n] = *(LAS const f32x4*)(b2l + (wc * 32 + 8 * fq + bj * HALF + 4 * n) * 4);
#pragma unroll
        for (int ai = 0; ai < 2; ++ai)
#pragma unroll
            for (int m = 0; m < 4; ++m) { const int row = r0 + ai * HALF + m * 16;
                if (u.pos0 + row < u.cnt) { const int pid = *(LAS const int*)(tbl + row * 4); const float gt = *(LAS const float*)(tbl + 1024 + row * 4) * Y_FP8_SCALE; unsigned char* rowp = Y + (size_t)pid * D_ + col0;
#pragma unroll
                    for (int bj = 0; bj < 2; ++bj) { const f32x4 v0 = (acc[ai][bj][m][0] * (1.0f / W_FP8_SCALE) + bv[bj][0]) * gt, v1 = (acc[ai][bj][m][1] * (1.0f / W_FP8_SCALE) + bv[bj][1]) * gt;
                        u32x2 w; w.x = pk4_fp8(v0[0], v0[1], v0[2], v0[3]); w.y = pk4_fp8(v1[0], v1[1], v1[2], v1[3]);
                        *(u32x2*)(rowp + bj * HALF) = w; } } }
    }
};

template <class Epi, class Sched, bool GATHER, int FP8 = 0  >
__device__ __forceinline__ void gemm_phase(LAS unsigned char* lds, const Gemm g, const Sched& S, const Epi& E) {
    int tid_ = threadIdx.x; asm volatile("" : "+v"(tid_));
    const int tid = tid_, wid = __builtin_amdgcn_readfirstlane(tid >> 6), lane = tid & 63, wr = wid >> 2, wc = wid & 3, fr = lane & 15, fq = lane >> 4;
    const int K = g.K, nt = K / BK;
    const __amdgpu_buffer_rsrc_t rsA = __builtin_amdgcn_make_buffer_rsrc((void*)g.A, 0, 0xFFFFFFF0u, 0x00020000);
    const __amdgpu_buffer_rsrc_t rsB = __builtin_amdgcn_make_buffer_rsrc((void*)g.Bt, 0, 0xFFFFFFF0u, 0x00020000);
    unsigned voffB[2];
#pragma unroll
    for (int i = 0; i < 2; ++i) { int R, C; stage_rc(tid * 16 + i * 8192, R, C); const int Rb = Epi::PERM ? ((R & ~31) + perm32(R & 31)) : R; voffB[i] = (unsigned)(Rb * K + C) * 2u; }
    const unsigned kstep = (unsigned)(BK * 2);
    const unsigned hstep = (unsigned)HALF * (unsigned)K * 2u;
    const unsigned tstep = 2u * hstep;
    const unsigned ldsw = (unsigned)wid * 1024u;
    const int aoff = lds_byte(wr * 64 + fr, fq * 8), boff = lds_byte(wc * 32 + fr, fq * 8);
#define PG8_SA(b, h) (((b) * 2 + (h)) * HTB)
#define PG8_SB(b, h) ((4 + (b) * 2 + (h)) * HTB)
#define PG8_STAGE(bufoff, rs, soff, voff) do { _Pragma("unroll") for (int _i = 0; _i < 2; ++_i) \
        __builtin_amdgcn_raw_ptr_buffer_load_lds(rs, (LAS void*)(lds + (bufoff) + ldsw + _i * 8192), 16, (int)(voff)[_i], (int)(soff), 0, 0); } while (0)
#define PG8_STAGE2(bufoff, rs, soff, o0, o1) do { \
        __builtin_amdgcn_raw_ptr_buffer_load_lds(rs, (LAS void*)(lds + (bufoff) + ldsw), 16, (int)(o0), (int)(soff), 0, 0); \
        __builtin_amdgcn_raw_ptr_buffer_load_lds(rs, (LAS void*)(lds + (bufoff) + ldsw + 8192), 16, (int)(o1), (int)(soff), 0, 0); } while (0)
#define PG8_LDA(dst, b, h) do { _Pragma("unroll") for (int m = 0; m < 4; ++m) _Pragma("unroll") for (int k = 0; k < 2; ++k) dst[m][k] = *(const LAS bf16x8*)(lds + PG8_SA(b, h) + aoff + m * 2048 + k * 1024); } while (0)
#define PG8_LDB(dst, b, h) do { _Pragma("unroll") for (int n = 0; n < 2; ++n) _Pragma("unroll") for (int k = 0; k < 2; ++k) dst[n][k] = *(const LAS bf16x8*)(lds + PG8_SB(b, h) + boff + n * 2048 + k * 1024); } while (0)
#define PG8_MMA(ai, bj, At, Bt) do { __builtin_amdgcn_s_setprio(1); _Pragma("unroll") for (int m = 0; m < 4; ++m) _Pragma("unroll") for (int n = 0; n < 2; ++n) { \
        if (f8now) { const i32x8 _b = __builtin_shufflevector(__builtin_bit_cast(i32x4, Bt[n][0]), __builtin_bit_cast(i32x4, Bt[n][1]), 0, 1, 2, 3, 4, 5, 6, 7); \
                   const i32x8 _a = __builtin_shufflevector(__builtin_bit_cast(i32x4, At[m][0]), __builtin_bit_cast(i32x4, At[m][1]), 0, 1, 2, 3, 4, 5, 6, 7); \
                   acc[ai][bj][m][n] = __builtin_amdgcn_mfma_scale_f32_16x16x128_f8f6f4(_b, _a, acc[ai][bj][m][n], 0, 0, 0, 0, 0, 0); } \
        else { _Pragma("unroll") for (int k = 0; k < 2; ++k) acc[ai][bj][m][n] = __builtin_amdgcn_mfma_f32_16x16x32_bf16(Bt[n][k], At[m][k], acc[ai][bj][m][n], 0, 0, 0); } } \
        __builtin_amdgcn_s_setprio(0); } while (0)
#define PG8_H1(p) (GATHER ? (p) : (p) + hstep)
#define PG8_CV1(i) (GATHER ? cv[1][i] : cv[0][i])
#define PG8_WAIT_V(n) asm volatile("s_waitcnt vmcnt(" #n ")" ::: "memory")
#define PG8_WAIT_L(n) asm volatile("s_waitcnt lgkmcnt(" #n ")" ::: "memory")
#define PG8_BAR __builtin_amdgcn_s_barrier()
#define PG8_SCHED __builtin_amdgcn_sched_barrier(0)
#define PG8_AOFF(dst, un) do { _Pragma("unroll") for (int _i = 0; _i < 2; ++_i) { int _R, _C; stage_rc(tid * 16 + _i * 8192, _R, _C); _Pragma("unroll") for (int _h = 0; _h < 2; ++_h) \
        dst[_h][_i] = GATHER ? (unsigned)S.arow(un, _h * HALF + _R) * (unsigned)(K * 2) + (unsigned)(_C * 2) : (unsigned)((_h * HALF + _R) * K + _C) * 2u; } } while (0)
    Unit cur, nxt; int ui = 0;
    if (!S.next(0, cur)) return;
    f32x4 acc[2][2][4][2];
#pragma unroll
    for (int a = 0; a < 2; ++a)
#pragma unroll
        for (int b = 0; b < 2; ++b)
#pragma unroll
            for (int m = 0; m < 4; ++m)
#pragma unroll
                for (int n = 0; n < 2; ++n) acc[a][b][m][n] = (f32x4){0.f, 0.f, 0.f, 0.f};
    bf16x8 At[4][2], B0[2][2], B1[2][2];
    unsigned cv[2][2];
    PG8_AOFF(cv, cur);
    unsigned cA = GATHER ? 0u : (unsigned)cur.pm * tstep, cB = (unsigned)cur.pb * tstep;
    S.a_ready(cur);
    int tbi = 0;
#define PG8_B2L(tb_) ((tb_) < 2 ? STAGE_BYTES + 6144 + (tb_) * 1024 : LDS_MISC + 6144)
    S.tables(lds + STAGE_BYTES, lds + PG8_B2L(0), cur, wid, lane);
    PG8_STAGE(PG8_SB(0, 0), rsB, cB, voffB); PG8_STAGE2(PG8_SA(0, 0), rsA, cA, cv[0][0], cv[0][1]); PG8_STAGE(PG8_SB(0, 1), rsB, cB + hstep, voffB); PG8_STAGE2(PG8_SA(0, 1), rsA, PG8_H1(cA), PG8_CV1(0), PG8_CV1(1));
    if (wr == 1) PG8_BAR;
    PG8_WAIT_V(4); PG8_BAR;
    PG8_STAGE(PG8_SB(1, 0), rsB, cB + kstep, voffB); PG8_STAGE2(PG8_SA(1, 0), rsA, cA + kstep, cv[0][0], cv[0][1]); PG8_STAGE(PG8_SB(1, 1), rsB, cB + hstep + kstep, voffB);
    PG8_WAIT_V(6); PG8_BAR;
    for (;;) {
        const bool has_next = S.next(ui + 1, nxt);
        const unsigned nA = has_next ? (GATHER ? 0u : (unsigned)nxt.pm * tstep) : cA, nB = has_next ? (unsigned)nxt.pb * tstep : cB;
        const int tbn = tbi == 2 ? 0 : tbi + 1;
        if (has_next) S.tables(lds + STAGE_BYTES + tbn * 2048, lds + PG8_B2L(tbn), nxt, wid, lane);
#define PG8_ITER(F8_) do { \
            const bool last = (t == nt - 2); const bool f8now = (F8_); (void)f8now; \
            const unsigned a1 = cA + (unsigned)(t + 1) * kstep; \
            const unsigned a2 = last ? nA : cA + (unsigned)(t + 2) * kstep, b2 = last ? nB : cB + (unsigned)(t + 2) * kstep; \
            const unsigned a3 = a2 + kstep, b3 = b2 + kstep; \
            if (last && has_next) S.a_ready(nxt); \
            PG8_LDB(B0, 0, 0); PG8_SCHED; PG8_LDA(At, 0, 0); PG8_STAGE2(PG8_SA(1, 1), rsA, PG8_H1(a1), PG8_CV1(0), PG8_CV1(1)); \
            PG8_WAIT_L(8); PG8_BAR; PG8_WAIT_L(0); PG8_MMA(0, 0, At, B0); PG8_BAR; PG8_SCHED; \
            PG8_LDB(B1, 0, 1); PG8_STAGE(PG8_SB(0, 0), rsB, b2, voffB); \
            PG8_BAR; PG8_WAIT_L(0); PG8_MMA(0, 1, At, B1); PG8_BAR; \
            if (GATHER && last && has_next) { const LAS int* _tb = (const LAS int*)(lds + STAGE_BYTES + tbn * 2048); \
                _Pragma("unroll") for (int _i = 0; _i < 2; ++_i) { int _R, _C; stage_rc(tid * 16 + _i * 8192, _R, _C); _Pragma("unroll") for (int _h = 0; _h < 2; ++_h) cv[_h][_i] = (unsigned)(_tb[_h * HALF + _R] >> 2) * (unsigned)(K * 2) + (unsigned)(_C * 2); } \
                PG8_WAIT_L(0); } \
            PG8_LDA(At, 0, 1); PG8_STAGE2(PG8_SA(0, 0), rsA, a2, cv[0][0], cv[0][1]); \
            PG8_BAR; PG8_WAIT_L(0); PG8_MMA(1, 0, At, B0); PG8_BAR; PG8_SCHED; \
            PG8_STAGE(PG8_SB(0, 1), rsB, b2 + hstep, voffB); \
            PG8_WAIT_V(6); PG8_BAR; PG8_MMA(1, 1, At, B1); PG8_BAR; \
            PG8_LDB(B0, 1, 0); PG8_SCHED; PG8_LDA(At, 1, 0); PG8_STAGE2(PG8_SA(0, 1), rsA, PG8_H1(a2), PG8_CV1(0), PG8_CV1(1)); \
            PG8_WAIT_L(8); PG8_BAR; PG8_WAIT_L(0); PG8_MMA(0, 0, At, B0); PG8_BAR; PG8_SCHED; \
            PG8_LDB(B1, 1, 1); PG8_STAGE(PG8_SB(1, 0), rsB, b3, voffB); \
            PG8_BAR; PG8_WAIT_L(0); PG8_MMA(0, 1, At, B1); PG8_BAR; \
            PG8_LDA(At, 1, 1); PG8_STAGE2(PG8_SA(1, 0), rsA, a3, cv[0][0], cv[0][1]); \
            PG8_BAR; PG8_WAIT_L(0); PG8_MMA(1, 0, At, B0); PG8_BAR; PG8_SCHED; \
            PG8_STAGE(PG8_SB(1, 1), rsB, b3 + hstep, voffB); \
            PG8_WAIT_V(6); PG8_BAR; PG8_MMA(1, 1, At, B1); PG8_BAR; \
        } while (0)
        if (FP8 == 2) { for (int t = 0; t < 8; t += 2) PG8_ITER(false); for (int t = 8; t < nt; t += 2) PG8_ITER(true); }
        else { for (int t = 0; t < nt; t += 2) PG8_ITER(FP8 == 1); }
#undef PG8_ITER
        E(acc, cur, wr, wc, fr, fq, lds + STAGE_BYTES + tbi * 2048, lds + PG8_B2L(tbi)); S.done(cur);
#ifdef MK_EPI2
        if (FP8 == 1) { asm volatile("" ::: "memory"); E(acc, cur, wr, wc, fr, fq, lds + STAGE_BYTES + tbi * 2048, lds + PG8_B2L(tbi)); }
#endif
        if (!has_next) break;
#pragma unroll
        for (int a = 0; a < 2; ++a)
#pragma unroll
            for (int b = 0; b < 2; ++b)
#pragma unroll
                for (int m = 0; m < 4; ++m)
#pragma unroll
                    for (int n = 0; n < 2; ++n) acc[a][b][m][n] = (f32x4){0.f, 0.f, 0.f, 0.f};
        cur = nxt; cA = nA; cB = nB; ++ui; tbi = tbn;
    }
    PG8_WAIT_V(0);
    if (wr == 0) PG8_BAR;
    PG8_BAR;
#undef PG8_SA
#undef PG8_SB
#undef PG8_STAGE
#undef PG8_STAGE2
#undef PG8_LDA
#undef PG8_LDB
#undef PG8_MMA
#undef PG8_WAIT_V
#undef PG8_WAIT_L
#undef PG8_BAR
#undef PG8_SCHED
#undef PG8_AOFF
#undef PG8_B2L
#undef PG8_H1
#undef PG8_CV1
}
}
struct Args { const float* in[27]; float* out; unsigned char* ws; int ph_lo, ph_hi; };
__device__ __forceinline__ const float* args_in(const Args* ka, int k) { return ka->in[k]; }
struct Ctx {
    const Args* ka;
    float* out; unsigned char* ws;
    LAS unsigned char* lds; int tid, lane, wave, G, bid;
};
#define WSP(type, off) ((type*)(C.ws + (off)))
enum { I_X = 0, I_MEM, I_POS, I_MIXG, I_MEMG, I_WIN, I_WOUT, I_GWS, I_GBS, I_GVG, I_CPOS, I_CK1, I_CK2, I_CV1, I_CV2, I_NQG, I_NKG, I_WKV, I_XQG, I_XKG, I_FFG, I_WR, I_BR, I_WE1, I_BE1, I_WE2, I_BE2 };

struct TReg { f32x4 v[4]; };
__device__ __forceinline__ int tt_idx(int k, int n) { return k * 65 + 8 * (k >> 5) + n; }
constexpr int TT_TILE_BYTES = (128 * 65 + 32) * 4;
__device__ __forceinline__ void tt_load(TReg& R, const float* src, int N, int ld, int k0, int n0, int tid) {
    const int kr = tid >> 4, nc = (tid & 15) * 4;
#pragma unroll
    for (int rep = 0; rep < 4; ++rep) { R.v[rep] = (f32x4){0.f, 0.f, 0.f, 0.f}; if (n0 + nc < N) R.v[rep] = *(const f32x4*)(src + (size_t)(k0 + kr + 32 * rep) * ld + n0 + nc); } }
__device__ __forceinline__ void tt_put(const TReg& R, LAS float* tile, int tid) {
    const int kr = tid >> 4, nc = (tid & 15) * 4;
#pragma unroll
    for (int rep = 0; rep < 4; ++rep) { LAS float* p = tile + tt_idx(kr + 32 * rep, nc); p[0] = R.v[rep][0]; p[1] = R.v[rep][1]; p[2] = R.v[rep][2]; p[3] = R.v[rep][3]; } }
__device__ __forceinline__ void tt_finish(LAS const float* tile, bf16_t* dst, int ldd, int k0, int n0, int N, int map, bool fp8, int tid) {
    const int n = tid >> 3; const int ns = n0 + n;
    if (ns < N) { int r = ns;
        if (map == 1) r = ns < 3584 ? ns : (ns < 3608 ? C_GATE + (ns - 3584) : C_QX + (ns - 3608));
        else if (map == 2) { const int j = ns >> 1, par = ns & 1; r = 256 * (j >> 7) + 128 * par + (j & 127); }
        else if (map == 3) { const int no = ns + 1024; r = (no < 3584 ? no : (no < 3608 ? C_GATE + (no - 3584) : C_QX + (no - 3608))) - 1024; }
        if (map == 4) {
            unsigned char* rowp = (unsigned char*)dst + (size_t)r * MIXP;
            if (k0 < 512) { const int kc = (tid & 7) * 8;
#pragma unroll
                for (int rep = 0; rep < 2; ++rep) { const int kk = kc + 64 * rep; float f[8];
#pragma unroll
                    for (int j = 0; j < 8; ++j) f[j] = tile[tt_idx(kk + j, n)] * W_FP8_SCALE;
                    u32x4 w; w.x = cvt_pk_bf16(f[0], f[1]); w.y = cvt_pk_bf16(f[2], f[3]); w.z = cvt_pk_bf16(f[4], f[5]); w.w = cvt_pk_bf16(f[6], f[7]);
                    *(u32x4*)(rowp + 2 * (k0 + kk)) = w; }
            } else { const int kk = (tid & 7) * 16; float f[16];
#pragma unroll
                for (int j = 0; j < 16; ++j) f[j] = tile[tt_idx(kk + j, n)] * W_FP8_SCALE;
                u32x4 w; w.x = pk4_fp8(f[0], f[1], f[2], f[3]); w.y = pk4_fp8(f[4], f[5], f[6], f[7]); w.z = pk4_fp8(f[8], f[9], f[10], f[11]); w.w = pk4_fp8(f[12], f[13], f[14], f[15]);
                *(u32x4*)(rowp + 1024 + (k0 - 512) + kk) = w; }
        } else if (fp8) { const int kk = (tid & 7) * 16; float f[16];
#pragma unroll
            for (int j = 0; j < 16; ++j) f[j] = tile[tt_idx(kk + j, n)] * W_FP8_SCALE;
            u32x4 w; w.x = pk4_fp8(f[0], f[1], f[2], f[3]); w.y = pk4_fp8(f[4], f[5], f[6], f[7]); w.z = pk4_fp8(f[8], f[9], f[10], f[11]); w.w = pk4_fp8(f[12], f[13], f[14], f[15]);
            *(u32x4*)((unsigned char*)dst + (size_t)r * ldd + k0 + kk) = w;
        } else { const int kc = (tid & 7) * 8;
#pragma unroll
            for (int rep = 0; rep < 2; ++rep) { const int kk = kc + 64 * rep; float f[8];
#pragma unroll
                for (int j = 0; j < 8; ++j) f[j] = tile[tt_idx(kk + j, n)];
                u32x4 w; w.x = cvt_pk_bf16(f[0], f[1]); w.y = cvt_pk_bf16(f[2], f[3]); w.z = cvt_pk_bf16(f[4], f[5]); w.w = cvt_pk_bf16(f[6], f[7]);
                *(u32x4*)(dst + (size_t)r * ldd + k0 + kk) = w; } } }
}
__device__ __forceinline__ void ttb_load(TReg& R, const float* src, int ld, int k0, int n0, int tid) {
    const int kr = tid >> 4, nq = tid & 15;
#pragma unroll
    for (int rep = 0; rep < 4; ++rep) R.v[rep] = __builtin_nontemporal_load((const f32x4*)(src + (size_t)(k0 + 4 * kr + rep) * ld + n0 + 4 * nq)); }
__device__ __forceinline__ void ttb_put(const TReg& R, LAS unsigned* tile, int tid) {
    const int kr = tid >> 4, nq = tid & 15;
#pragma unroll
    for (int c = 0; c < 4; ++c) { const int n = 4 * nq + c;
        tile[n * 32 + (kr ^ (n & 31))] = pk4_fp8(R.v[0][c] * W_FP8_SCALE, R.v[1][c] * W_FP8_SCALE, R.v[2][c] * W_FP8_SCALE, R.v[3][c] * W_FP8_SCALE); } }
__device__ __forceinline__ void ttb_finish(LAS const unsigned* tile, unsigned char* dst, int ldd, int k0, int n0, int map, int tid) {
    const int n = tid >> 3, kq = tid & 7, m = n & 31, ns = n0 + n; int r = ns;
    if (map == 2) { const int j = ns >> 1, par = ns & 1; r = 256 * (j >> 7) + 128 * par + (j & 127); }
    const u32x4 g = *(LAS const u32x4*)(tile + n * 32 + 4 * (kq ^ (m >> 2)));
    const unsigned a0 = (m & 1) ? g.y : g.x, a1 = (m & 1) ? g.x : g.y, a2 = (m & 1) ? g.w : g.z, a3 = (m & 1) ? g.z : g.w;
    u32x4 w; w.x = (m & 2) ? a2 : a0; w.y = (m & 2) ? a3 : a1; w.z = (m & 2) ? a0 : a2; w.w = (m & 2) ? a1 : a3;
    __builtin_nontemporal_store(w, (u32x4*)(dst + (size_t)r * ldd + k0 + 16 * kq));
}
template <int K_, int N_, int MAP_> __device__ __forceinline__ void tjob_b(const Ctx& C, int bid, int G, const float* src, unsigned char* dstb, int nbatch) {
    constexpr int kt = K_ / 128, ntile = N_ / 64, per = kt * ntile; const int tot = per * nbatch;
    TReg R0, R1, R2, R3; int kbuf = 0;
#define TB_LOAD(R_, t_) do { const int _t = (t_); if (_t < tot) { const int _b = _t / per, _r = _t % per; ttb_load(R_, src + (size_t)_b * K_ * N_, N_, (_r % kt) * 128, (_r / kt) * 64, C.tid); } } while (0)
#define TB_STEP(R_, t_) do { const int _u = (t_); if (_u < tot) { LAS unsigned* tile = (LAS unsigned*)(C.lds + kbuf * 8192); ttb_put(R_, tile, C.tid); TB_LOAD(R_, _u + 4 * G); __syncthreads(); \
        { const int _b = _u / per, _r = _u % per; ttb_finish(tile, dstb + (size_t)_b * K_ * (MAP_ == 2 ? 4096 : N_), K_, (_r % kt) * 128, (_r / kt) * 64, MAP_, C.tid); } kbuf ^= 1; } } while (0)
    TB_LOAD(R0, bid); TB_LOAD(R1, bid + G); TB_LOAD(R2, bid + 2 * G); TB_LOAD(R3, bid + 3 * G);
    for (int t = bid; t < tot; t += 4 * G) { TB_STEP(R0, t); TB_STEP(R1, t + G); TB_STEP(R2, t + 2 * G); TB_STEP(R3, t + 3 * G); }
    __syncthreads();
#undef TB_LOAD
#undef TB_STEP
}
template <int K_, int N_, int MAP_> __device__ __forceinline__ void tjob_deep(const Ctx& C, int bid, int G, const float* src, unsigned char* dstb, int nbatch) {
    constexpr int kt = K_ / 128, ntile = N_ / 64, per = kt * ntile; const int tot = per * nbatch;
    TReg R0, R1, R2, R3; int kbuf = 0;
#define TD_LOAD(R_, t_) do { const int _t = (t_); if (_t < tot) { const int _b = _t / per, _r = _t % per; tt_load(R_, src + (size_t)_b * K_ * N_, N_, N_, (_r % kt) * 128, (_r / kt) * 64, C.tid); } } while (0)
#define TD_STEP(R_, t_) do { const int _u = (t_); if (_u < tot) { LAS float* tile = (LAS float*)(C.lds + kbuf * TT_TILE_BYTES); tt_put(R_, tile, C.tid); TD_LOAD(R_, _u + 4 * G); __syncthreads(); \
        { const int _b = _u / per, _r = _u % per; tt_finish(tile, (bf16_t*)(dstb + (size_t)_b * K_ * (MAP_ == 2 ? 4096 : N_)), K_, (_r % kt) * 128, (_r / kt) * 64, N_, MAP_, true, C.tid); } kbuf ^= 1; } } while (0)
    TD_LOAD(R0, bid); TD_LOAD(R1, bid + G); TD_LOAD(R2, bid + 2 * G); TD_LOAD(R3, bid + 3 * G);
    for (int t = bid; t < tot; t += 4 * G) { TD_STEP(R0, t); TD_STEP(R1, t + G); TD_STEP(R2, t + 2 * G); TD_STEP(R3, t + 3 * G); }
    __syncthreads();
#undef TD_LOAD
#undef TD_STEP
}
__device__ __forceinline__ void p0_prologue(const Ctx& C) {
    int base = 0;
#define TJOB(IN_, DST_, K_, N_, BATCH_, MAP_, FP8_) TJOBX(IN_, DST_, K_, N_, N_, 0, BATCH_, MAP_, FP8_)
#define TJOBX(IN_, DST_, K_, N_, LD_, COLOFF_, BATCH_, MAP_, FP8_) do { constexpr int kt = (K_) / 128, ntile = ((N_) + 63) / 64, per = kt * ntile, tot = per * (BATCH_); \
        const int first = (C.bid - base % C.G + C.G) % C.G; const float* srcb = C.ka->in[IN_] + (COLOFF_); TReg R; int kbuf = 0; \
        if (first < tot) { const int b = first / per, r = first % per; tt_load(R, srcb + (size_t)b * (K_) * (LD_), (N_), (LD_), (r % kt) * 128, (r / kt) * 64, C.tid); } \
        for (int t = first; t < tot; t += C.G, kbuf ^= 1) { LAS float* tile = (LAS float*)(C.lds + kbuf * TT_TILE_BYTES); \
            tt_put(R, tile, C.tid); \
            { const int tn = t + C.G; if (tn < tot) { const int b = tn / per, r = tn % per; tt_load(R, srcb + (size_t)b * (K_) * (LD_), (N_), (LD_), (r % kt) * 128, (r / kt) * 64, C.tid); } } \
            __syncthreads(); \
            { const int b = t / per, r = t % per; \
              tt_finish(tile, (bf16_t*)(C.ws + (DST_) + (size_t)b * (K_) * ((MAP_) == 2 ? 4096 : (N_)) * ((FP8_) ? 1 : 2)), (K_), (r % kt) * 128, (r / kt) * 64, (N_), (MAP_), (FP8_), C.tid); } } \
        __syncthreads(); base += tot; } while (0)
      TJOBX(I_WIN, WS_WIN, 2048, 1024, IN_COLS, 0, 1, 0, false); TJOBX(I_WIN, WS_WIN8, 2048, IN_COLS - 1024, IN_COLS, 1024, 1, 3, true); TJOB(I_WOUT, WS_WOUT, 2048, 2048, 1, 4, false);
    TJOB(I_WKV, WS_WKV, 2048, 1024, 1, 0, true); TJOB(I_CK1, WS_CK1, 4096, 128, 1, 0, false); TJOB(I_CV1, WS_CV1, 4096, 128, 1, 0, false); TJOB(I_CK2, WS_CK2, 128, 128, 1, 0, false); TJOB(I_CV2, WS_CV2, 128, 128, 1, 0, false);
#undef TJOB
#undef TJOBX
    const int gw = C.bid * 8 + C.wave, NWV = C.G * 8, lane = C.lane;
    for (int row = gw; row < T_ + NB * MEMT; row += NWV) {
        const bool ismem = row >= T_; const float* src = ismem ? C.ka->in[I_MEM] + (size_t)(row - T_) * D_ : C.ka->in[I_X] + (size_t)row * D_;
        const float* gv = ismem ? C.ka->in[I_MEMG] : C.ka->in[I_MIXG]; bf16_t* dst = WSP(bf16_t, WS_H) + (size_t)row * D_; unsigned char* d8 = ismem ? WSP(unsigned char, WS_MEMN) + (size_t)(row - T_) * D_ : WSP(unsigned char, WS_H8) + (size_t)row * D_;
        f32x4 v[8]; float ss = 0.f;
#pragma unroll
        for (int c = 0; c < 8; ++c) { v[c] = __builtin_nontemporal_load((const f32x4*)(src + c * 256 + lane * 4)); ss += (v[c][0] * v[c][0] + v[c][1] * v[c][1]) + (v[c][2] * v[c][2] + v[c][3] * v[c][3]); }
        ss = wave_sum(ss); const float rs = rsqrtf(ss * (1.0f / D_) + EPS);
#pragma unroll
        for (int c = 0; c < 8; ++c) { const f32x4 g4 = *(const f32x4*)(gv + c * 256 + lane * 4); const float h0 = v[c][0] * rs * g4[0], h1 = v[c][1] * rs * g4[1], h2 = v[c][2] * rs * g4[2], h3 = v[c][3] * rs * g4[3];
            if (!ismem) { u32x2 w; w.x = cvt_pk_bf16(h0, h1); w.y = cvt_pk_bf16(h2, h3); *(u32x2*)(dst + c * 256 + lane * 4) = w; }
            *(unsigned*)(d8 + c * 256 + lane * 4) = pk4_fp8(h0, h1, h2, h3); }
    }
    const size_t gt = (size_t)C.bid * 512 + C.tid, GT = (size_t)C.G * 512;
    for (size_t i = gt; i < (size_t)32 * D_; i += GT) {
        const int e = (int)(i / D_), k = (int)(i % D_); const float w = C.ka->in[I_WR][(size_t)k * 32 + e]; const bf16_t hi = f2bf(w); WSP(bf16_t, WS_WRH)[i] = hi; WSP(bf16_t, WS_WRL)[i] = f2bf(w - bf2f(hi)); }
    for (size_t i = gt; i < (size_t)NEXP * D_; i += GT) WSP(float, WS_B2C)[i] = C.ka->in[I_BE2][i];
    for (size_t i = gt; i < (size_t)NEXP * FF; i += GT) {
        const int e = (int)(i / FF), j = (int)(i % FF); WSP(float, WS_B1G)[i] = C.ka->in[I_BE1][(size_t)e * 4096 + 2 * j]; WSP(float, WS_B1L)[i] = C.ka->in[I_BE1][(size_t)e * 4096 + 2 * j + 1]; }
    for (size_t i = gt; i < (size_t)4 * 128 * 128; i += GT) {
        const int s = (int)(i & 127), t = (int)((i >> 7) & 127); WSP(bf16_t, WS_GWS)[i] = s <= t ? f2bf(C.ka->in[I_GWS][i]) : (bf16_t)0; }
    if (C.bid == 0) {
        if (C.tid < 64) WSP(float, WS_MISC)[C.tid] = (float)pow(10000.0, -(double)C.tid / 64.0);
        if (C.wave == 1) {
            float a = fmaxf(fabsf(C.ka->in[I_NQG][lane]), fabsf(C.ka->in[I_NQG][lane + 64])), b = fmaxf(fabsf(C.ka->in[I_NKG][lane]), fabsf(C.ka->in[I_NKG][lane + 64]));
            float c = fmaxf(fabsf(C.ka->in[I_XQG][lane]), fabsf(C.ka->in[I_XQG][lane + 64])), d = fmaxf(fabsf(C.ka->in[I_XKG][lane]), fabsf(C.ka->in[I_XKG][lane + 64]));
            for (int o = 32; o >= 1; o >>= 1) { a = fmaxf(a, __shfl_xor(a, o)); b = fmaxf(b, __shfl_xor(b, o)); c = fmaxf(c, __shfl_xor(c, o)); d = fmaxf(d, __shfl_xor(d, o)); }
            if (lane == 0) { WSP(float, WS_MISC)[64] = 11.313708499f * a * b * 1.4426950409f; WSP(float, WS_MISC)[65] = 11.313708499f * c * d * 1.4426950409f; } }
    }
    for (int job = C.bid; job < 64; job += C.G) { const int m = job >> 5, j = job & 31;
        const float* w1 = m == 0 ? C.ka->in[I_CK1] : C.ka->in[I_CV1]; const float* pos = C.ka->in[I_CPOS]; LAS float* red = (LAS float*)C.lds;
        const int o = C.tid & 127, part = C.tid >> 7; float s = 0.f; const int k0 = j * 128 + part * 32;
#pragma unroll
        for (int kk = 0; kk < 32; ++kk) s += pos[k0 + kk] * w1[(size_t)(k0 + kk) * 128 + o];
        __syncthreads(); red[C.tid] = s; __syncthreads();
        if (C.tid < 128) ((float*)(C.ws + WS_CTL + 32768))[(m * 32 + j) * 128 + o] = (red[o] + red[128 + o]) + (red[256 + o] + red[384 + o]);
    }
    __syncthreads();
}
__device__ __forceinline__ float row16_sum(float v) { v += dppf<0xB1>(v); v += dppf<0x4E>(v); v += dppf<0x141>(v); v += dppf<0x140>(v); return v; }
__device__ __forceinline__ void unpack8(const u32x4 w, float (&f)[8]) {
    f[0] = __uint_as_float(w.x << 16); f[1] = __uint_as_float(w.x & 0xFFFF0000u); f[2] = __uint_as_float(w.y << 16); f[3] = __uint_as_float(w.y & 0xFFFF0000u);
    f[4] = __uint_as_float(w.z << 16); f[5] = __uint_as_float(w.z & 0xFFFF0000u); f[6] = __uint_as_float(w.w << 16); f[7] = __uint_as_float(w.w & 0xFFFF0000u); }
__device__ __forceinline__ u32x4 pack8u(const float (&f)[8]) { u32x4 w; w.x = cvt_pk_bf16(f[0], f[1]); w.y = cvt_pk_bf16(f[2], f[3]); w.z = cvt_pk_bf16(f[4], f[5]); w.w = cvt_pk_bf16(f[6], f[7]); return w; }
__device__ __forceinline__ u32x4 ror8(const u32x4 w) { u32x4 o; o.x = dppu<0x128>(w.x); o.y = dppu<0x128>(w.y); o.z = dppu<0x128>(w.z); o.w = dppu<0x128>(w.w); return o; }
__device__ __forceinline__ void p2_token_prep(const Ctx& C) {
    const int gw = C.bid * 8 + C.wave, NWV = C.G * 8, L = C.lane, r = L & 15, rowid = L >> 4, rp = r ^ 8;
    if (C.bid == 0 && C.tid < 256) { const float* cp = (const float*)(C.ws + WS_CTL + 32768) + (C.tid >> 7) * 32 * 128 + (C.tid & 127); float s = 0.f;
        for (int j = 0; j < 32; ++j) s += cp[j * 128];
        WSP(float, WS_C1)[C.tid] = s; }
    const bf16_t* PROJ = WSP(bf16_t, WS_PROJ);
    LAS bf16_t* TS = (LAS bf16_t*)C.lds; LAS bf16_t* TW = (LAS bf16_t*)(C.lds + 32768); LAS bf16_t* TG = (LAS bf16_t*)(C.lds + 65536);
    LAS float* cs = (LAS float*)(C.lds + 131072 + C.wave * 512);
    const float inv = WSP(float, WS_MISC)[L];
    float qgo[8], qgp[8], kgo[8], kgp[8], xgo[8], gvo[8];
#pragma unroll
    for (int j = 0; j < 8; ++j) { qgo[j] = C.ka->in[I_NQG][8 * r + j]; qgp[j] = C.ka->in[I_NQG][8 * rp + j]; kgo[j] = C.ka->in[I_NKG][8 * r + j]; kgp[j] = C.ka->in[I_NKG][8 * rp + j];
        xgo[j] = C.ka->in[I_XQG][8 * r + j]; gvo[j] = C.ka->in[I_GVG][rowid * 128 + 8 * r + j]; }
    const float sgn = r < 8 ? -1.0f : 1.0f;
    for (int uu_ = C.bid; uu_ < T_ / 64; uu_ += C.G) { const int unit = T_ / 64 - 1 - uu_;
      for (int tl = 0; tl < 8; ++tl) {
        const int tok = 8 * C.wave + tl, t = unit * 64 + tok;
        const bf16_t* pr = PROJ + (size_t)t * NPROJ + 8 * L; const int b = t / S_, s = t % S_;
        u32x4 ld[8];
#pragma unroll
        for (int m = 0; m < 8; ++m) ld[m] = __builtin_nontemporal_load((const u32x4*)(pr + 512 * m));
        { const float ang = (float)((const int*)C.ka->in[I_POS])[t] * inv; float sn, c; sincosf(ang, &sn, &c); cs[L] = c; cs[64 + L] = sn; }
        float cw[8], sw[8];
        { const f32x4 c0 = *(const LAS f32x4*)(cs + 8 * (r & 7)), c1 = *(const LAS f32x4*)(cs + 8 * (r & 7) + 4), s0 = *(const LAS f32x4*)(cs + 64 + 8 * (r & 7)), s1 = *(const LAS f32x4*)(cs + 64 + 8 * (r & 7) + 4);
#pragma unroll
          for (int j = 0; j < 4; ++j) { cw[j] = c0[j]; cw[4 + j] = c1[j]; sw[j] = s0[j] * sgn; sw[4 + j] = s1[j] * sgn; } }
        float f[8], fp[8], o[8];
        { unpack8(ld[0], f);
#pragma unroll
          for (int j = 0; j < 8; ++j) o[j] = gelu_tanh(f[j]);
          *(u32x4*)(WSP(bf16_t, WS_UB) + (size_t)t * 512 + 128 * rowid + 8 * r) = pack8u(o); }
        { unpack8(ld[1], f); float ss = 0.f;
#pragma unroll
          for (int j = 0; j < 8; ++j) { f[j] = gelu_tanh(f[j]); ss += f[j] * f[j]; }
          const float rn = rsqrtf(row16_sum(ss) * (1.0f / 128.0f) + EPS);
          LAS bf16_t* vt = TG + (rowid * 128 + 8 * r) * 64 + tok;
#pragma unroll
          for (int j = 0; j < 8; ++j) vt[j * 64] = f2bf(f[j] * rn * gvo[j]); }
#pragma unroll
        for (int m = 2; m < 4; ++m) { unpack8(ld[m], f); unpack8(ror8(ld[m]), fp); float ss = 0.f;
#pragma unroll
            for (int j = 0; j < 8; ++j) ss += f[j] * f[j];
            const float rn = rsqrtf(row16_sum(ss) * (1.0f / 128.0f) + EPS); const int h = 4 * (m - 2) + rowid;
#pragma unroll
            for (int j = 0; j < 8; ++j) { f[j] *= rn * qgo[j]; o[j] = f[j] * cw[j] + fp[j] * rn * qgp[j] * sw[j]; }
            *(u32x4*)(WSP(bf16_t, WS_QN) + (size_t)t * 1024 + h * 128 + 8 * r) = pack8u(f);
            *(u32x4*)(WSP(bf16_t, WS_QR) + (size_t)t * 1024 + h * 128 + 8 * r) = pack8u(o); }
        { const size_t rowkv = ((size_t)(b * 2 + (rowid & 1)) * S_ + s) * 128 + 8 * r; *(u32x4*)(WSP(bf16_t, rowid < 2 ? WS_KCMP : WS_VCMP) + rowkv) = ld[4]; }
#pragma unroll
        for (int m = 5; m < 7; ++m) { unpack8(ld[m], f); unpack8(ror8(ld[m]), fp); float ss = 0.f;
#pragma unroll
            for (int j = 0; j < 8; ++j) ss += f[j] * f[j];
            const float rn = rsqrtf(row16_sum(ss) * (1.0f / 128.0f) + EPS); const int g = rowid & 1;
            if (rowid < 2) {
#pragma unroll
                for (int j = 0; j < 8; ++j) o[j] = f[j] * rn * kgo[j] * cw[j] + fp[j] * rn * kgp[j] * sw[j];
                *(u32x4*)(WSP(bf16_t, m == 5 ? WS_KSEL : WS_KWIN) + ((size_t)(b * 2 + g) * S_ + s) * 128 + 8 * r) = pack8u(o);
            } else { LAS bf16_t* d = (m == 5 ? TS : TW) + (g * 128 + 8 * r) * 64 + tok;
                const u32x4 wv = ld[m];
                d[0] = (bf16_t)(wv.x & 0xFFFFu); d[64] = (bf16_t)(wv.x >> 16); d[128] = (bf16_t)(wv.y & 0xFFFFu); d[192] = (bf16_t)(wv.y >> 16);
                d[256] = (bf16_t)(wv.z & 0xFFFFu); d[320] = (bf16_t)(wv.z >> 16); d[384] = (bf16_t)(wv.w & 0xFFFFu); d[448] = (bf16_t)(wv.w >> 16); } }
        { unpack8(ld[7], f); float ss = 0.f;
#pragma unroll
          for (int j = 0; j < 8; ++j) ss += f[j] * f[j];
          const float rn = rsqrtf(row16_sum(ss) * (1.0f / 128.0f) + EPS);
#pragma unroll
          for (int j = 0; j < 8; ++j) o[j] = f[j] * rn * xgo[j];
          *(u32x4*)(WSP(bf16_t, WS_QX) + (size_t)t * 512 + rowid * 128 + 8 * r) = pack8u(o); }
        if (L < 24) WSP(float, WS_GATES)[(size_t)t * 24 + L] = sigmoidf_(bf2f(PROJ[(size_t)t * NPROJ + C_GATE + L]));
      }
      __syncthreads();
      { const int t0 = unit * 64, b = t0 / S_, s0 = t0 % S_;
#pragma unroll
        for (int k = 0; k < 4; ++k) { const int c = C.tid + 512 * k, g = c >> 10;
            const size_t dst = ((size_t)(b * 2 + g) * 256 + (s0 >> 6)) * 8192 + (size_t)(c & 1023) * 8;
            *(u32x4*)(WSP(bf16_t, WS_VSELT) + dst) = *(const LAS u32x4*)(TS + c * 8); *(u32x4*)(WSP(bf16_t, WS_VWINT) + dst) = *(const LAS u32x4*)(TW + c * 8); }
#pragma unroll
        for (int k = 0; k < 8; ++k) { const int c = C.tid + 512 * k, row = c >> 3, ch = c & 7;
            *(u32x4*)(WSP(bf16_t, WS_VTG) + ((size_t)(t0 >> 7) * 512 + row) * 128 + ((t0 >> 6) & 1) * 64 + ch * 8) = *(const LAS u32x4*)(TG + c * 8); } }
      __syncthreads();
    }
    const int i = C.lane;
    const float mg0 = C.ka->in[I_XKG][i], mg1 = C.ka->in[I_XKG][i + 64];
    for (int m = gw; m < NB * MEMT; m += NWV) { const bf16_t* pr = WSP(bf16_t, WS_MEMKV) + (size_t)m * 1024; const int b = m / MEMT, mm = m % MEMT;
#pragma unroll
        for (int h = 0; h < 4; ++h) { const float a = bf2f(pr[h * 128 + i]), bb = bf2f(pr[h * 128 + 64 + i]); const float r = rsqrtf(wave_sum(a * a + bb * bb) * (1.0f / 128.0f) + EPS);
            bf16_t* k = WSP(bf16_t, WS_KX) + ((size_t)(b * 4 + h) * 256 + mm) * 128; k[i] = f2bf(a * r * mg0); k[i + 64] = f2bf(bb * r * mg1);
            bf16_t* v = WSP(bf16_t, WS_VXT) + ((size_t)(b * 4 + h) * 4 + (mm >> 6)) * 128 * 64 + (mm & 63); v[(size_t)i * 64] = pr[512 + h * 128 + i]; v[(size_t)(i + 64) * 64] = pr[512 + h * 128 + 64 + i]; } }
}

struct QF { bf16x8 f[4]; };
enum { MODE_NONE = 0, MODE_WIN = 1, MODE_CMP = 2, MODE_SEL = 3 };
__device__ __forceinline__ QF load_qf(const bf16_t* qrow, int g) { QF q;
#pragma unroll
    for (int ks = 0; ks < 4; ++ks) q.f[ks] = *(const bf16x8*)(qrow + 32 * ks + 8 * g);
    return q; }
template <int MODE> __device__ __forceinline__ void qk_group(const QF& q, const bf16_t* Kblk, int kg, int i, int g, int tq, int kbase, float c2, float mb, float (&p)[8]) {
    f32x4 s0 = {0.f, 0.f, 0.f, 0.f}, s1 = {0.f, 0.f, 0.f, 0.f};
    const bf16_t* k0 = Kblk + (size_t)(32 * kg + 8 * (i >> 2) + (i & 3)) * 128 + 8 * g;
#pragma unroll
    for (int ks = 0; ks < 4; ++ks) { const bf16x8 a0 = *(const bf16x8*)(k0 + 32 * ks), a1 = *(const bf16x8*)(k0 + 4 * 128 + 32 * ks);
        s0 = __builtin_amdgcn_mfma_f32_16x16x32_bf16(a0, q.f[ks], s0, 0, 0, 0); s1 = __builtin_amdgcn_mfma_f32_16x16x32_bf16(a1, q.f[ks], s1, 0, 0, 0); }
#pragma unroll
    for (int r = 0; r < 8; ++r) { const int key = kbase + 32 * kg + 8 * g + r; const float sv = r < 4 ? s0[r & 3] : s1[r & 3];
        bool valid = true;
        if (MODE == MODE_WIN) valid = (key <= tq) && (key > tq - 512);
        if (MODE == MODE_CMP) valid = (16 * key + 31 <= tq);
        if (MODE == MODE_SEL) valid = (key <= tq);
        p[r] = valid ? __builtin_amdgcn_exp2f(sv * c2 - mb) : 0.f; }
}
__device__ __forceinline__ void pv_group(const float (&p)[8], const bf16_t* VTblk, int kg, int i, int g, f32x4 (&O)[8]) {
    const bf16x8 pf = pack8(p[0], p[1], p[2], p[3], p[4], p[5], p[6], p[7]);
    const bf16_t* v0 = VTblk + (size_t)i * 64 + 32 * kg + 8 * g;
#pragma unroll
    for (int dt = 0; dt < 8; ++dt) { const bf16x8 vt = *(const bf16x8*)(v0 + (size_t)dt * 16 * 64); O[dt] = __builtin_amdgcn_mfma_f32_16x16x32_bf16(vt, pf, O[dt], 0, 0, 0); }
}
template <int MODE> __device__ __forceinline__ void attn_block(const QF& q, const bf16_t* Kblk, const bf16_t* VTblk, f32x4 (&O)[8], float& l, int i, int g, int tq, int kbase, float c2, float mb) {
#pragma unroll
    for (int kg = 0; kg < 2; ++kg) { float p[8]; qk_group<MODE>(q, Kblk, kg, i, g, tq, kbase, c2, mb, p);
        l += ((p[0] + p[1]) + (p[2] + p[3])) + ((p[4] + p[5]) + (p[6] + p[7]));
        pv_group(p, VTblk, kg, i, g, O); }
}
constexpr float C2_ = 0.08838834764831845f * 1.4426950408889634f;
__device__ __forceinline__ void compress_coop(const Ctx& C) {
    const int w = C.wave, lane = C.lane, i = lane & 15, g4 = lane >> 4, half = w >> 2, kq = w & 3;
    LAS float* part = (LAS float*)C.lds;
    for (int pair = C.bid; pair < 256; pair += C.G) {
        const int task = pair * 2 + half;
        const int kv = task >> 8, bg = (task >> 6) & 3, rt = task & 63, n = 16 * rt + i;
        const bf16_t* src = WSP(bf16_t, kv ? WS_VCMP : WS_KCMP) + (size_t)bg * S_ * 128;
        const bf16_t* w1T = WSP(bf16_t, kv ? WS_CV1 : WS_CK1);
        const bf16_t* brow = src + (size_t)(16 * n) * 128 + 8 * g4 + 1024 * kq;
        const bf16_t* arow = w1T + (size_t)i * 4096 + 8 * g4 + 1024 * kq;
        f32x4 acc[8];
#pragma unroll
        for (int ot = 0; ot < 8; ++ot) acc[ot] = (f32x4){0.f, 0.f, 0.f, 0.f};
        bf16x8 bN = *(const bf16x8*)brow, aN[8], bM = *(const bf16x8*)(brow + 32), aM[8];
#pragma unroll
        for (int ot = 0; ot < 8; ++ot) { aN[ot] = *(const bf16x8*)(arow + (size_t)ot * 16 * 4096); aM[ot] = *(const bf16x8*)(arow + (size_t)ot * 16 * 4096 + 32); }
        for (int ks = 0; ks < 32; ++ks) { const bf16x8 bfr = bN; bf16x8 a[8];
#pragma unroll
            for (int ot = 0; ot < 8; ++ot) { a[ot] = aN[ot]; aN[ot] = aM[ot]; }
            bN = bM;
            const int kn = ks + 2 < 32 ? ks + 2 : 31;
            bM = *(const bf16x8*)(brow + 32 * kn);
#pragma unroll
            for (int ot = 0; ot < 8; ++ot) aM[ot] = *(const bf16x8*)(arow + (size_t)ot * 16 * 4096 + 32 * kn);
#pragma unroll
            for (int ot = 0; ot < 8; ++ot) acc[ot] = __builtin_amdgcn_mfma_f32_16x16x32_bf16(a[ot], bfr, acc[ot], 0, 0, 0); }
#pragma unroll
        for (int ot = 0; ot < 8; ++ot) *(LAS f32x4*)(part + (((half * 4 + kq) * 8 + ot) * 64 + lane) * 4) = acc[ot];
        __syncthreads();
        if (kq == 0) {
#pragma unroll
            for (int ot = 0; ot < 8; ++ot) { acc[ot] = *(const LAS f32x4*)(part + (((half * 4 + 0) * 8 + ot) * 64 + lane) * 4);
#pragma unroll
                for (int qq = 1; qq < 4; ++qq) acc[ot] += *(const LAS f32x4*)(part + (((half * 4 + qq) * 8 + ot) * 64 + lane) * 4); }
            const float* c1 = WSP(float, WS_C1) + kv * 128;
#pragma unroll
            for (int ot = 0; ot < 8; ++ot) { const f32x4 cb = *(const f32x4*)(c1 + 16 * ot + 4 * g4);
#pragma unroll
                for (int r = 0; r < 4; ++r) acc[ot][r] = gelu_tanh(acc[ot][r] + cb[r]); }
            const bf16_t* w2T = WSP(bf16_t, kv ? WS_CV2 : WS_CK2);
            f32x4 acc2[8];
#pragma unroll
            for (int ot = 0; ot < 8; ++ot) acc2[ot] = (f32x4){0.f, 0.f, 0.f, 0.f};
#pragma unroll
            for (int ks2 = 0; ks2 < 4; ++ks2) {
                const bf16x8 pf = pack8(acc[2 * ks2][0], acc[2 * ks2][1], acc[2 * ks2][2], acc[2 * ks2][3], acc[2 * ks2 + 1][0], acc[2 * ks2 + 1][1], acc[2 * ks2 + 1][2], acc[2 * ks2 + 1][3]);
#pragma unroll
                for (int o2t = 0; o2t < 8; ++o2t) { const bf16_t* wr = w2T + (size_t)(16 * o2t + i) * 128 + 32 * ks2 + 4 * g4;
                    const u32x2 lo = *(const u32x2*)wr, hi = *(const u32x2*)(wr + 16); const u32x4 wv = {lo.x, lo.y, hi.x, hi.y};
                    acc2[o2t] = __builtin_amdgcn_mfma_f32_16x16x32_bf16(__builtin_bit_cast(bf16x8, wv), pf, acc2[o2t], 0, 0, 0); } }
            const bool pad = (n == 1023);
            if (kv == 0) {
                float ss = 0.f;
#pragma unroll
                for (int o2t = 0; o2t < 8; ++o2t) ss += (acc2[o2t][0] * acc2[o2t][0] + acc2[o2t][1] * acc2[o2t][1]) + (acc2[o2t][2] * acc2[o2t][2] + acc2[o2t][3] * acc2[o2t][3]);
                ss += __shfl_xor(ss, 16); ss += __shfl_xor(ss, 32);
                const float r = pad ? 0.f : rsqrtf(ss * (1.0f / 128.0f) + EPS);
                bf16_t* dst = WSP(bf16_t, WS_KC) + ((size_t)bg * 1024 + n) * 128;
                const float* nkg = C.ka->in[I_NKG] + 4 * g4; f32x4 kgv[8];
#pragma unroll
                for (int o2t = 0; o2t < 8; ++o2t) kgv[o2t] = *(const f32x4*)(nkg + 16 * o2t);
#pragma unroll
                for (int o2t = 0; o2t < 8; ++o2t) { const f32x4 kg = kgv[o2t]; u32x2 wv;
                    wv.x = cvt_pk_bf16(acc2[o2t][0] * r * kg[0], acc2[o2t][1] * r * kg[1]); wv.y = cvt_pk_bf16(acc2[o2t][2] * r * kg[2], acc2[o2t][3] * r * kg[3]);
                    *(u32x2*)(dst + 16 * o2t + 4 * g4) = wv; }
            } else {
                bf16_t* dst = WSP(bf16_t, WS_VCT) + ((size_t)bg * 16 + (n >> 6)) * 128 * 64 + (n & 63);
#pragma unroll
                for (int o2t = 0; o2t < 8; ++o2t)
#pragma unroll
                    for (int r = 0; r < 4; ++r) dst[(size_t)(16 * o2t + 4 * g4 + r) * 64] = pad ? (bf16_t)0 : f2bf(acc2[o2t][r]);
            }
        }
        __syncthreads();
    }
}
__device__ __forceinline__ void gmlp_task(const Ctx& C, int task) {
    const int i = C.lane & 15, g4 = C.lane >> 4;
    const int tt = task & 7, gg = (task >> 3) & 3, ch = task >> 5;
    const bf16_t* arow = WSP(bf16_t, WS_VTG) + ((size_t)(ch * 4 + gg) * 128 + i) * 128 + 8 * g4;
    const bf16_t* brow = WSP(bf16_t, WS_GWS) + ((size_t)gg * 128 + 16 * tt + i) * 128 + 8 * g4;
    f32x4 acc[8];
#pragma unroll
    for (int dt = 0; dt < 8; ++dt) acc[dt] = (f32x4){0.f, 0.f, 0.f, 0.f};
    bf16x8 bfr[4], af[4][8];
#pragma unroll
    for (int ks = 0; ks < 4; ++ks) { bfr[ks] = *(const bf16x8*)(brow + 32 * ks);
#pragma unroll
        for (int dt = 0; dt < 8; ++dt) af[ks][dt] = *(const bf16x8*)(arow + (size_t)dt * 16 * 128 + 32 * ks); }
    const int tok = ch * 128 + 16 * tt + i; const float bs = C.ka->in[I_GBS][gg * 128 + 16 * tt + i];
    const bf16_t* ub = WSP(bf16_t, WS_UB) + (size_t)tok * 512 + gg * 128 + 4 * g4; bf16_t* mix = (bf16_t*)(WSP(unsigned char, WS_MIX) + (size_t)tok * MIXP) + gg * 128 + 4 * g4;
    u32x2 uq[8];
#pragma unroll
    for (int dt = 0; dt < 8; ++dt) uq[dt] = *(const u32x2*)(ub + 16 * dt);
#pragma unroll
    for (int ks = 0; ks < 4; ++ks)
#pragma unroll
        for (int dt = 0; dt < 8; ++dt) acc[dt] = __builtin_amdgcn_mfma_f32_16x16x32_bf16(af[ks][dt], bfr[ks], acc[dt], 0, 0, 0);
#pragma unroll
    for (int dt = 0; dt < 8; ++dt) { const u32x2 uu = uq[dt];
        const float u0 = __uint_as_float(uu.x << 16), u1 = __uint_as_float(uu.x & 0xFFFF0000u), u2 = __uint_as_float(uu.y << 16), u3 = __uint_as_float(uu.y & 0xFFFF0000u);
        u32x2 w; w.x = cvt_pk_bf16(MIX_SCALE * u0 * (acc[dt][0] + bs), MIX_SCALE * u1 * (acc[dt][1] + bs)); w.y = cvt_pk_bf16(MIX_SCALE * u2 * (acc[dt][2] + bs), MIX_SCALE * u3 * (acc[dt][3] + bs));
        *(u32x2*)(mix + 16 * dt) = w; }
}
__device__ __forceinline__ void window_task(const Ctx& C, int task) {
    const int i = C.lane & 15, g4 = C.lane >> 4;
    const int qt = task & 1023, h = (task >> 10) & 7, b = task >> 13, bg = b * 2 + (h >> 2);
    const int t0 = 16 * qt, tq = t0 + i; const size_t t = (size_t)b * S_ + tq;
    const float mb = WSP(float, WS_MISC)[64];
    const QF qf = load_qf(WSP(bf16_t, WS_QR) + t * 1024 + h * 128, g4);
    f32x4 O[8];
#pragma unroll
    for (int dt = 0; dt < 8; ++dt) O[dt] = (f32x4){0.f, 0.f, 0.f, 0.f};
    float l = 0.f;
    const int blo = (t0 - 511 > 0 ? t0 - 511 : 0) >> 6, bhi = (t0 + 15) >> 6;
    for (int blk = blo; blk <= bhi; ++blk)
        attn_block<MODE_WIN>(qf, WSP(bf16_t, WS_KWIN) + ((size_t)bg * S_ + 64 * blk) * 128, WSP(bf16_t, WS_VWINT) + ((size_t)bg * 256 + blk) * 8192, O, l, i, g4, tq, 64 * blk, C2_, mb);
    l += __shfl_xor(l, 16); l += __shfl_xor(l, 32);
    const float sc = (l > 0.f ? 1.0f / l : 0.f) * WSP(float, WS_GATES)[t * 24 + h * 3 + 2];
    float* dst = WSP(float, WS_MIXACC) + t * 1024 + h * 128 + 4 * g4;
#pragma unroll
    for (int dt = 0; dt < 8; ++dt) *(f32x4*)(dst + 16 * dt) = O[dt] * sc;
}
__device__ __forceinline__ void xattn_task(const Ctx& C, int task) {
    const int i = C.lane & 15, g4 = C.lane >> 4;
    const int qt = task & 1023, hx = (task >> 10) & 3, b = task >> 12;
    const int tq = 16 * qt + i; const size_t t = (size_t)b * S_ + tq;
    const float mb = WSP(float, WS_MISC)[65];
    const QF qf = load_qf(WSP(bf16_t, WS_QX) + t * 512 + hx * 128, g4);
    f32x4 O[8];
#pragma unroll
    for (int dt = 0; dt < 8; ++dt) O[dt] = (f32x4){0.f, 0.f, 0.f, 0.f};
    float l = 0.f;
    for (int blk = 0; blk < 4; ++blk)
        attn_block<MODE_NONE>(qf, WSP(bf16_t, WS_KX) + ((size_t)(b * 4 + hx) * 256 + 64 * blk) * 128, WSP(bf16_t, WS_VXT) + ((size_t)(b * 4 + hx) * 4 + blk) * 8192, O, l, i, g4, tq, 64 * blk, C2_, mb);
    l += __shfl_xor(l, 16); l += __shfl_xor(l, 32);
    const float sc = l > 0.f ? 1.0f / l : 0.f;
    bf16_t* dst = WSP(bf16_t, WS_MIX) + t * D_ + 1536 + hx * 128 + 4 * g4;
#pragma unroll
    for (int dt = 0; dt < 8; ++dt) { u32x2 w; w.x = cvt_pk_bf16(O[dt][0] * sc, O[dt][1] * sc); w.y = cvt_pk_bf16(O[dt][2] * sc, O[dt][3] * sc); *(u32x2*)(dst + 16 * dt) = w; }
}
constexpr int P3_NX = NB * 4 * 1024, P3_NG = 256 * 4 * 8;
#ifndef MK_REPEAT
#define MK_REPEAT 0
#endif
__device__ __forceinline__ void p3_tasks(const Ctx& C) {
    for (int rep = 0; rep < 1 + ((MK_REPEAT >> 12) & 1); ++rep) compress_coop(C);
    const int gw = C.bid * 8 + C.wave, NWV = C.G * 8;
    for (int rep = 0; rep < 1 + ((MK_REPEAT >> 14) & 1); ++rep) for (int task = gw; task < P3_NG; task += NWV) gmlp_task(C, task);
}

__device__ __forceinline__ void p4_compressed(const Ctx& C) {
    const int gw = C.bid * 8 + C.wave, NWV = C.G * 8, lane = C.lane, i = lane & 15, g4 = lane >> 4;
    LAS float* imp = (LAS float*)(C.lds + C.wave * 16448);
    const float mb = WSP(float, WS_MISC)[64];
    const int NTASK = 4 * 1024;
    for (int task = gw; task < NTASK; task += NWV) {
        const int round = task / NWV, base = NWV * round, cntr = (NTASK - base) < NWV ? (NTASK - base) : NWV, off = task - base;
        const int tk = base + ((round & 1) ? cntr - 1 - off : off);
        const int qt = 1023 - (tk >> 2), bg = tk & 3, b = bg >> 1, g = bg & 1;
        const int t0 = 16 * qt, tq = t0 + i; const size_t t = (size_t)b * S_ + tq;
        for (int k = lane; k < 16 * 257; k += 64) imp[k] = 0.f;
        const int nb = (qt + 63) >> 6;
        const bf16_t* KC = WSP(bf16_t, WS_KC) + (size_t)bg * 1024 * 128; const bf16_t* VCT = WSP(bf16_t, WS_VCT) + (size_t)bg * 16 * 8192;
        float invl[4];
#pragma unroll
        for (int r = 0; r < 4; ++r) { const QF qf = load_qf(WSP(bf16_t, WS_QN) + t * 1024 + (g * 4 + r) * 128, g4); float l = 0.f;
            for (int blk = 0; blk < nb; ++blk)
#pragma unroll
                for (int kg = 0; kg < 2; ++kg) { float p[8]; qk_group<MODE_CMP>(qf, KC + (size_t)blk * 64 * 128, kg, i, g4, tq, 64 * blk, C2_, mb, p); l += ((p[0] + p[1]) + (p[2] + p[3])) + ((p[4] + p[5]) + (p[6] + p[7])); }
            l += __shfl_xor(l, 16); l += __shfl_xor(l, 32); invl[r] = l > 0.f ? 1.0f / l : 0.f; }
#pragma unroll
        for (int r = 0; r < 4; ++r) { const QF qf = load_qf(WSP(bf16_t, WS_QN) + t * 1024 + (g * 4 + r) * 128, g4);
            f32x4 O[8];
#pragma unroll
            for (int dt = 0; dt < 8; ++dt) O[dt] = (f32x4){0.f, 0.f, 0.f, 0.f};
            for (int blk = 0; blk < nb; ++blk)
#pragma unroll
                for (int kg = 0; kg < 2; ++kg) { float p[8]; qk_group<MODE_CMP>(qf, KC + (size_t)blk * 64 * 128, kg, i, g4, tq, 64 * blk, C2_, mb, p);
#pragma unroll
                    for (int j = 0; j < 8; ++j) p[j] *= invl[r];
                    LAS float* ip = imp + i * 257 + 16 * blk + 8 * kg + 2 * g4;
                    __hip_atomic_fetch_add(ip, 2.0f * (p[0] + p[1] + p[2]) + p[3], __ATOMIC_RELAXED, __HIP_MEMORY_SCOPE_WORKGROUP);
                    __hip_atomic_fetch_add(ip + 1, p[3] + 2.0f * (p[4] + p[5] + p[6]) + p[7], __ATOMIC_RELAXED, __HIP_MEMORY_SCOPE_WORKGROUP);
                    __hip_atomic_fetch_add(ip + 2, p[7], __ATOMIC_RELAXED, __HIP_MEMORY_SCOPE_WORKGROUP);
                    pv_group(p, VCT + (size_t)blk * 8192, kg, i, g4, O); }
            const float gate = WSP(float, WS_GATES)[t * 24 + (g * 4 + r) * 3 + 0];
            float* dst = WSP(float, WS_MIXACC) + t * 1024 + (g * 4 + r) * 128 + 4 * g4;
#pragma unroll
            for (int dt = 0; dt < 8; ++dt) { const f32x4 old = *(const f32x4*)(dst + 16 * dt); *(f32x4*)(dst + 16 * dt) = old + O[dt] * gate; } }
        const int cur = t0 >> 6; int* idx = WSP(int, WS_IDX) + ((size_t)bg * S_ + t0) * 16;
        if (cur <= 15) { for (int q = 0; q < 16; ++q) if (lane < 16) idx[q * 16 + lane] = lane <= cur ? lane : -1; }
        else {
            for (int q = 0; q < 16; ++q) {
                unsigned key[4];
#pragma unroll
                for (int c = 0; c < 4; ++c) { const int j = lane + 64 * c; const float v = imp[q * 257 + j]; key[c] = (j >= 1 && j <= cur - 2) ? ((__float_as_uint(v) & 0xFFFFFF00u) | (unsigned)(255 - j)) : 0u; }
                int mypick = lane == 0 ? 0 : (lane == 1 ? cur - 1 : (lane == 2 ? cur : -1));
                for (int rd = 0; rd < 13; ++rd) {
                    unsigned m = key[0] > key[1] ? key[0] : key[1]; const unsigned m2 = key[2] > key[3] ? key[2] : key[3]; m = m > m2 ? m : m2;
                    const unsigned M = wave_umax(m); const int jsel = M ? 255 - (int)(M & 255u) : -1;
#pragma unroll
                    for (int c = 0; c < 4; ++c) if (key[c] == M) key[c] = 0u;
                    if (lane == 3 + rd) mypick = jsel;
                }
                if (lane < 16) idx[q * 16 + lane] = mypick;
            }
        }
    }
}

__device__ __forceinline__ void p5_selected(const Ctx& C) {
    const int gw = C.bid * 8 + C.wave, NWV = C.G * 8, lane = C.lane, i = lane & 15, g4 = lane >> 4;
    const float mb = WSP(float, WS_MISC)[64];
    for (int task = gw; task < 4 * S_; task += NWV) {
        const int bg = task / S_, tq = task % S_, b = bg >> 1, g = bg & 1; const size_t t = (size_t)b * S_ + tq;
        const int idxv = lane < 16 ? WSP(int, WS_IDX)[((size_t)bg * S_ + tq) * 16 + lane] : -1;
        QF qf;
        if (i < 4) qf = load_qf(WSP(bf16_t, WS_QR) + t * 1024 + (g * 4 + i) * 128, g4);
        else {
#pragma unroll
            for (int ks = 0; ks < 4; ++ks) qf.f[ks] = (bf16x8){0, 0, 0, 0, 0, 0, 0, 0}; }
        f32x4 O[8];
#pragma unroll
        for (int dt = 0; dt < 8; ++dt) O[dt] = (f32x4){0.f, 0.f, 0.f, 0.f};
        float l = 0.f;
        for (int k = 0; k < 16; ++k) { const int j = __builtin_amdgcn_readlane(idxv, k); if (j < 0) continue;
            attn_block<MODE_SEL>(qf, WSP(bf16_t, WS_KSEL) + ((size_t)bg * S_ + 64 * j) * 128, WSP(bf16_t, WS_VSELT) + ((size_t)bg * 256 + j) * 8192, O, l, i, g4, tq, 64 * j, C2_, mb); }
        l += __shfl_xor(l, 16); l += __shfl_xor(l, 32);
        if (i < 4) { const int h = g * 4 + i; const float sc = (l > 0.f ? 1.0f / l : 0.f) * WSP(float, WS_GATES)[t * 24 + h * 3 + 1];
            const float* ma = WSP(float, WS_MIXACC) + t * 1024 + h * 128 + 4 * g4; bf16_t* dst = WSP(bf16_t, WS_MIX) + t * D_ + 512 + h * 128 + 4 * g4;
#pragma unroll
            for (int dt = 0; dt < 8; ++dt) { const f32x4 v = *(const f32x4*)(ma + 16 * dt) + O[dt] * sc; u32x2 w; w.x = cvt_pk_bf16(v[0], v[1]); w.y = cvt_pk_bf16(v[2], v[3]); *(u32x2*)(dst + 16 * dt) = w; } }
    }
}
__device__ __forceinline__ int ta_swk(int r) { return (((r >> 3) & 3) << 2) | (r & 3); }
__device__ __forceinline__ void ta_issue(LAS unsigned char* lds, int bufi, const bf16_t* Kb, const bf16_t* Vb, int w, int lane, bool konly = false) {
    LAS unsigned char* kb = lds + bufi * 32768; LAS unsigned char* vb = kb + 16384;
#pragma unroll
    for (int q = 0; q < 2; ++q) { const int r = 8 * w + 4 * q + (lane >> 4), s = lane & 15;
        __builtin_amdgcn_global_load_lds((const unsigned*)(Kb + (size_t)r * 128 + ((s ^ ta_swk(r)) * 8)), (LAS unsigned*)(kb + (8 * w + 4 * q) * 256), 16, 0, 0); }
    if (konly) return;
#pragma unroll
    for (int q = 0; q < 2; ++q) { const int d = 16 * w + 8 * q + (lane >> 3), s = lane & 7;
        __builtin_amdgcn_global_load_lds((const unsigned*)(Vb + (size_t)d * 64 + ((s ^ ((d >> 1) & 7)) * 8)), (LAS unsigned*)(vb + (16 * w + 8 * q) * 128), 16, 0, 0); }
}
#define TA_SB __builtin_amdgcn_sched_barrier(0)
__device__ __forceinline__ void ta_ldk(LAS const unsigned char* kb, int kg, int i, int g4, bf16x8 (&a0)[4], bf16x8 (&a1)[4]) {
    LAS const unsigned char* kr = kb + (32 * kg + 8 * (i >> 2) + (i & 3)) * 256;
#pragma unroll
    for (int ks = 0; ks < 4; ++ks) { const int co = ((4 * ks + g4) ^ i) * 16; a0[ks] = *(LAS const bf16x8*)(kr + co); a1[ks] = *(LAS const bf16x8*)(kr + 4 * 256 + co); } }
__device__ __forceinline__ void ta_ldv(LAS const unsigned char* vb, int kg, int i, int g4, bf16x8 (&vt)[8]) {
    LAS const unsigned char* vr = vb + i * 128 + (((4 * kg + g4) ^ ((i >> 1) & 7)) * 16);
#pragma unroll
    for (int dt = 0; dt < 8; ++dt) vt[dt] = *(LAS const bf16x8*)(vr + dt * 16 * 128); }
__device__ __forceinline__ void ta_qk(const bf16x8 (&a0)[4], const bf16x8 (&a1)[4], const QF& q, f32x4& s0, f32x4& s1) {
    s0 = (f32x4){0.f, 0.f, 0.f, 0.f}; s1 = (f32x4){0.f, 0.f, 0.f, 0.f};
#pragma unroll
    for (int ks = 0; ks < 4; ++ks) { s0 = __builtin_amdgcn_mfma_f32_16x16x32_bf16(a0[ks], q.f[ks], s0, 0, 0, 0); s1 = __builtin_amdgcn_mfma_f32_16x16x32_bf16(a1[ks], q.f[ks], s1, 0, 0, 0); } }
template <int MODE, bool FULL = false> __device__ __forceinline__ bf16x8 ta_sm(const f32x4 s0, const f32x4 s1, float& l, int kg, int g4, int tq, bool colvalid, int kbase, float mb) {
    float p[8];
#pragma unroll
    for (int r = 0; r < 8; ++r) { const int key = kbase + 32 * kg + 8 * g4 + r; const float sv = r < 4 ? s0[r & 3] : s1[r & 3];
        bool valid = colvalid && (key <= tq);
        if (MODE == MODE_WIN) valid = valid && (key > tq - 512);
        if (MODE == MODE_NONE || FULL) valid = true;
        p[r] = valid ? __builtin_amdgcn_exp2f(sv * C2_ - mb) : 0.f; }
    l += ((p[0] + p[1]) + (p[2] + p[3])) + ((p[4] + p[5]) + (p[6] + p[7]));
    return pack8(p[0], p[1], p[2], p[3], p[4], p[5], p[6], p[7]); }
__device__ __forceinline__ void ta_pv(const bf16x8 (&vt)[8], const bf16x8 pf, f32x4 (&O)[8]) {
#pragma unroll
    for (int dt = 0; dt < 8; ++dt) O[dt] = __builtin_amdgcn_mfma_f32_16x16x32_bf16(vt[dt], pf, O[dt], 0, 0, 0); }
template <int MODE> __device__ __forceinline__ void ta_compute_pinned(LAS const unsigned char* kb, const QF& q, f32x4 (&O)[8], float& l, int i, int g4, int tq, bool colvalid, int kbase, float mb) {
    LAS const unsigned char* vb = kb + 16384;
    bf16x8 ka0[4], ka1[4], kb0[4], kb1[4], va[8], vc[8]; f32x4 s0, s1, t0, t1;
    ta_ldk(kb, 0, i, g4, ka0, ka1); TA_SB; ta_ldk(kb, 1, i, g4, kb0, kb1); TA_SB;
    ta_qk(ka0, ka1, q, s0, s1); TA_SB;
    ta_ldv(vb, 0, i, g4, va); TA_SB;
    ta_qk(kb0, kb1, q, t0, t1); TA_SB;
    const bf16x8 pf0 = ta_sm<MODE>(s0, s1, l, 0, g4, tq, colvalid, kbase, mb); TA_SB;
    ta_ldv(vb, 1, i, g4, vc); TA_SB;
    ta_pv(va, pf0, O); TA_SB;
    const bf16x8 pf1 = ta_sm<MODE>(t0, t1, l, 1, g4, tq, colvalid, kbase, mb); TA_SB;
    ta_pv(vc, pf1, O); TA_SB;
}
template <int MODE, bool FULL = false> __device__ __forceinline__ void ta_compute_plain(LAS const unsigned char* kb, const QF& q, f32x4 (&O)[8], float& l, int i, int g4, int tq, bool colvalid, int kbase, float mb) {
    LAS const unsigned char* vb = kb + 16384;
#pragma unroll
    for (int kg = 0; kg < 2; ++kg) {
        bf16x8 a0[4], a1[4], vt[8]; f32x4 s0, s1;
        ta_ldk(kb, kg, i, g4, a0, a1); ta_qk(a0, a1, q, s0, s1);
        const bf16x8 pf = ta_sm<MODE, FULL>(s0, s1, l, kg, g4, tq, colvalid, kbase, mb);
        ta_ldv(vb, kg, i, g4, vt); ta_pv(vt, pf, O);
    }
}
template <int MODE, bool FULL = false> __device__ __forceinline__ void ta_compute2(LAS const unsigned char* kb, const QF& q0, const QF& q1, f32x4 (&O0)[8], f32x4 (&O1)[8], float& l0, float& l1, int i, int g4, int tq0, int tq1, bool n0, bool n1, bool cv0, bool cv1, int kbase, float mb, bool full = false  ) {
    LAS const unsigned char* vb = kb + 16384;
    const float m0 = cv0 ? mb : 1e30f, m1 = cv1 ? mb : 1e30f;
    bf16x8 ka0[4], ka1[4], kb0[4], kb1[4], va[8], vc[8]; f32x4 s0, s1, t0, t1, u0, u1, v0, v1; bf16x8 pa0, pb0, pa1, pb1;
    ta_ldk(kb, 0, i, g4, ka0, ka1); ta_ldk(kb, 1, i, g4, kb0, kb1); TA_SB;
    if (n0) { ta_qk(ka0, ka1, q0, s0, s1); ta_qk(kb0, kb1, q0, t0, t1); } TA_SB;
    if (n1) { ta_qk(ka0, ka1, q1, u0, u1); ta_qk(kb0, kb1, q1, v0, v1); } TA_SB;
    ta_ldv(vb, 0, i, g4, va); TA_SB;
    if (n0) { if (full) { pa0 = ta_sm<MODE, true>(s0, s1, l0, 0, g4, tq0, true, kbase, m0); pb0 = ta_sm<MODE, true>(t0, t1, l0, 1, g4, tq0, true, kbase, m0); }
              else { pa0 = ta_sm<MODE, FULL>(s0, s1, l0, 0, g4, tq0, cv0, kbase, mb); pb0 = ta_sm<MODE, FULL>(t0, t1, l0, 1, g4, tq0, cv0, kbase, mb); } } TA_SB;
    if (n1) { if (full) { pa1 = ta_sm<MODE, true>(u0, u1, l1, 0, g4, tq1, true, kbase, m1); pb1 = ta_sm<MODE, true>(v0, v1, l1, 1, g4, tq1, true, kbase, m1); }
              else { pa1 = ta_sm<MODE, FULL>(u0, u1, l1, 0, g4, tq1, cv1, kbase, mb); pb1 = ta_sm<MODE, FULL>(v0, v1, l1, 1, g4, tq1, cv1, kbase, mb); } } TA_SB;
    ta_ldv(vb, 1, i, g4, vc); TA_SB;
    if (n0) { ta_pv(va, pa0, O0); ta_pv(vc, pb0, O0); } TA_SB;
    if (n1) { ta_pv(va, pa1, O1); ta_pv(vc, pb1, O1); } TA_SB;
}
template <int MODE> __device__ __forceinline__ void ta_compute(LAS const unsigned char* kb, const QF& q, f32x4 (&O)[8], float& l, int i, int g4, int tq, bool colvalid, int kbase, float mb) {
    if (MODE == MODE_SEL) ta_compute_pinned<MODE>(kb, q, O, l, i, g4, tq, colvalid, kbase, mb); else ta_compute_plain<MODE>(kb, q, O, l, i, g4, tq, colvalid, kbase, mb);
}
template <int MODE, int DRY = 0  > __device__ __forceinline__ void tile_attn_phase(const Ctx& C) {
    const int w = C.wave, lane = C.lane, i = lane & 15, g4 = lane >> 4, tid = C.tid;
    LAS unsigned char* lds = C.lds;
    LAS unsigned* MASK = (LAS unsigned*)(lds + 131072);
    LAS int* USED = (LAS int*)(lds + LDS_MISC + 512);
    LAS int* WCNT = (LAS int*)(lds + LDS_MISC + 512 + 1024);
    const float mb = WSP(float, WS_MISC)[64];
    const bf16_t* Kall = WSP(bf16_t, MODE == MODE_SEL ? WS_KSEL : WS_KWIN); const bf16_t* VTall = WSP(bf16_t, MODE == MODE_SEL ? WS_VSELT : WS_VWINT);
    constexpr int NT = 4 * 256;
    for (int it = C.bid; it < NT; it += C.G) {
        const int round = it / C.G, base = C.G * round, cntr = (NT - base) < C.G ? (NT - base) : C.G, off = it - base;
        const int tk = base + ((round & 1) ? cntr - 1 - off : off);
        const int qt = 255 - (tk >> 2), bg = tk & 3, b = bg >> 1, g = bg & 1, t0 = 64 * qt;
        int nblk, blo = 0;
        if (MODE == MODE_SEL) {
            for (int k = tid; k < 2048; k += 512) MASK[k] = 0u;
            __syncthreads();
            const int* idx = WSP(int, WS_IDX) + ((size_t)bg * S_ + t0) * 16;
#pragma unroll
            for (int e = tid; e < 1024; e += 512) { const int j = idx[e]; const int qq = e >> 4; if (j >= 0) __hip_atomic_fetch_or(MASK + j * 8 + (qq >> 3), 1u << (qq & 7), __ATOMIC_RELAXED, __HIP_MEMORY_SCOPE_WORKGROUP); }
            __syncthreads();
            bool any = false; unsigned long long bal = 0ull;
            if (tid < 256) { unsigned o = 0u;
#pragma unroll
                for (int k = 0; k < 8; ++k) o |= MASK[tid * 8 + k];
                any = o != 0u; bal = __ballot(any); if (lane == 0) WCNT[w] = __popcll(bal); }
            __syncthreads();
            if (tid < 256 && any) { int bs = 0;
#pragma unroll
                for (int k = 0; k < 4; ++k) bs += (k < w) ? WCNT[k] : 0;
                USED[bs + __popcll(bal & ((1ull << lane) - 1ull))] = tid; }
            nblk = WCNT[0] + WCNT[1] + WCNT[2] + WCNT[3];
            __syncthreads();
            if (32 * w < nblk) {
                const int cb = 32 * w, cn = (nblk - cb) < 32 ? (nblk - cb) : 32;
                const int id = lane < cn ? USED[cb + lane] : 0; unsigned h1 = 0u, h2 = 0u;
                { const u32x4 ma = *(LAS const u32x4*)(MASK + id * 8), mc = *(LAS const u32x4*)(MASK + id * 8 + 4);
#pragma unroll
                  for (int k = 0; k < 8; ++k) { const unsigned m = k < 4 ? ma[k & 3] : mc[k & 3]; const unsigned a = (m & 0x0Fu) ? 1u : 0u, c = (m & 0xF0u) ? 1u : 0u; h1 |= (a | c) << k; h2 |= (a & c) << k; } }
                unsigned long long alive = __ballot(lane < cn); int k = 0;
                while (alive) {
                    const int l1 = __builtin_ctzll(alive); alive &= alive - 1ull;
                    const unsigned a1 = __builtin_amdgcn_readlane(h1, l1), a2 = __builtin_amdgcn_readlane(h2, l1); const int id1 = __builtin_amdgcn_readlane(id, l1); int id2 = -1;
                    if (alive) {
                        const bool c4 = (h2 & a2) != 0u, c3 = ((h2 & a1) | (h1 & a2)) != 0u, c2 = ((h2 | a2) | (h1 & a1)) != 0u;
                        const unsigned long long m1 = __ballot(!c2) & alive, m2 = __ballot(!c3) & alive, m3 = __ballot(!c4) & alive;
                        const unsigned long long pick = m1 ? m1 : (m2 ? m2 : (m3 ? m3 : alive));
                        const int l2 = __builtin_ctzll(pick); alive &= ~(1ull << l2); id2 = __builtin_amdgcn_readlane(id, l2); }
                    if (lane == 0) { USED[cb + k] = id1; if (id2 >= 0) USED[cb + k + 1] = id2; }
                    k += 2; }
            }
            __syncthreads();
        } else { blo = (t0 - 511 > 0 ? t0 - 511 : 0) >> 6; nblk = qt - blo + 1; __syncthreads(); }
        const int tq0 = t0 + 8 * w + (i >> 2), tq1 = tq0 + 4; const size_t tt0 = (size_t)b * S_ + tq0, tt1 = tt0 + 4; const int hh = g * 4 + (i & 3);
        const QF q0 = load_qf(WSP(bf16_t, WS_QR) + tt0 * 1024 + hh * 128, g4), q1 = load_qf(WSP(bf16_t, WS_QR) + tt1 * 1024 + hh * 128, g4);
        f32x4 O0[8], O1[8]; float l0 = 0.f, l1 = 0.f;
#pragma unroll
        for (int dt = 0; dt < 8; ++dt) { O0[dt] = (f32x4){0.f, 0.f, 0.f, 0.f}; O1[dt] = (f32x4){0.f, 0.f, 0.f, 0.f}; }
        const bf16_t* Kbg = Kall + (size_t)bg * S_ * 128; const bf16_t* Vbg = VTall + (size_t)bg * 256 * 8192;
#define TA_BLK(n_) (MODE == MODE_SEL ? USED[n_] : blo + (n_))
#define TA_ISSUE(n_) do { if (DRY == 2) break; const int _j = TA_BLK(n_); ta_issue(lds, (n_) & 3, Kbg + (size_t)_j * 64 * 128, Vbg + (size_t)_j * 8192, w, lane); } while (0)
#define TA_DO(n_) do { if (DRY == 1) break; const int _j = TA_BLK(n_); const unsigned _m = MODE == MODE_SEL ? (unsigned)__builtin_amdgcn_readfirstlane((int)MASK[_j * 8 + w]) : 0xFFu; unsigned _ko = ((n_) & 3) * 32768; asm volatile("" : "+s"(_ko)); LAS const unsigned char* _kb = lds + _ko;   \
            if (_m) ta_compute2<MODE>(_kb, q0, q1, O0, O1, l0, l1, i, g4, tq0, tq1, (_m & 0x0Fu) != 0u, (_m & 0xF0u) != 0u, ((_m >> (i >> 2)) & 1u) != 0u, ((_m >> (4 + (i >> 2))) & 1u) != 0u, 64 * _j, mb, MODE == MODE_SEL ? _j < qt : (_j < qt && _j > qt - 8)); } while (0)
        if (MODE == MODE_SEL) {
            TA_ISSUE(0); if (nblk > 1) TA_ISSUE(1);
            for (int n = 0; n < nblk; n += 2) {
                asm volatile("s_waitcnt vmcnt(0)" ::: "memory"); __syncthreads();
                if (n + 2 < nblk) TA_ISSUE(n + 2);
                if (n + 3 < nblk) TA_ISSUE(n + 3);
                TA_DO(n);
                if (n + 1 < nblk) TA_DO(n + 1);
            }
        } else {
            TA_ISSUE(0);
            for (int n = 0; n < nblk; ++n) {
                asm volatile("s_waitcnt vmcnt(0)" ::: "memory"); __syncthreads();
                if (n + 1 < nblk) TA_ISSUE(n + 1);
                TA_DO(n);
            }
        }
#undef TA_ISSUE
#undef TA_DO
#undef TA_BLK
        l0 += __shfl_xor(l0, 16); l0 += __shfl_xor(l0, 32); l1 += __shfl_xor(l1, 16); l1 += __shfl_xor(l1, 32);
        const float* gates = WSP(float, WS_GATES);
        const float sc0 = (l0 > 0.f ? 1.0f / l0 : 0.f) * gates[tt0 * 24 + hh * 3 + (MODE == MODE_SEL ? 1 : 2)], sc1 = (l1 > 0.f ? 1.0f / l1 : 0.f) * gates[tt1 * 24 + hh * 3 + (MODE == MODE_SEL ? 1 : 2)];
        float* ma0 = WSP(float, WS_MIXACC) + tt0 * 1024 + hh * 128 + 4 * g4; float* ma1 = WSP(float, WS_MIXACC) + tt1 * 1024 + hh * 128 + 4 * g4;
        if (DRY) { asm volatile("" :: "v"(sc0), "v"(sc1));
#pragma unroll
            for (int dt = 0; dt < 8; ++dt) asm volatile("" :: "v"(O0[dt]), "v"(O1[dt]));
        } else if (MODE == MODE_SEL) {
            unsigned char* d0 = WSP(unsigned char, WS_MIX) + tt0 * MIXP + 1024 + hh * 128 + 4 * g4; unsigned char* d1 = WSP(unsigned char, WS_MIX) + tt1 * MIXP + 1024 + hh * 128 + 4 * g4;
#pragma unroll
            for (int dt = 0; dt < 8; ++dt) { const f32x4 v0 = (*(const f32x4*)(ma0 + 16 * dt) + O0[dt] * sc0) * MIX_SCALE, v1 = (*(const f32x4*)(ma1 + 16 * dt) + O1[dt] * sc1) * MIX_SCALE;
                *(unsigned*)(d0 + 16 * dt) = pk4_fp8(v0[0], v0[1], v0[2], v0[3]); *(unsigned*)(d1 + 16 * dt) = pk4_fp8(v1[0], v1[1], v1[2], v1[3]); }
        } else {
#pragma unroll
            for (int dt = 0; dt < 8; ++dt) { *(f32x4*)(ma0 + 16 * dt) = O0[dt] * sc0; *(f32x4*)(ma1 + 16 * dt) = O1[dt] * sc1; }
        }
        __syncthreads();
    }
}

template <int PASS, bool FULL = false> __device__ __forceinline__ bf16x8 cmp_sm(const f32x4 s0, const f32x4 s1, float& l, float mbi  , LAS float* improw, int kg, int i, int g4, int tq, int j, float mb) {
    float p[8];
#pragma unroll
    for (int r = 0; r < 8; ++r) { const int key = 64 * j + 32 * kg + 8 * g4 + r; const float sv = r < 4 ? s0[r & 3] : s1[r & 3];
        const float e = __builtin_amdgcn_exp2f(sv * C2_ - (PASS == 1 ? mb : mbi));
        p[r] = (FULL || 16 * key + 31 <= tq) ? e : 0.f; }
    if (PASS == 1) { l += ((p[0] + p[1]) + (p[2] + p[3])) + ((p[4] + p[5]) + (p[6] + p[7])); return (bf16x8){0, 0, 0, 0, 0, 0, 0, 0}; }
    float ia = 2.0f * (p[0] + p[1] + p[2]) + p[3], ib = p[3] + 2.0f * (p[4] + p[5] + p[6]) + p[7], ic = p[7];
    ia += dppf<0xB1>(ia); ia += dppf<0x4E>(ia); ib += dppf<0xB1>(ib); ib += dppf<0x4E>(ib); ic += dppf<0xB1>(ic); ic += dppf<0x4E>(ic);
    if ((i & 3) == 0) { LAS float* ip = improw + 16 * j + 8 * kg + 2 * g4;
        __hip_atomic_fetch_add(ip, ia, __ATOMIC_RELAXED, __HIP_MEMORY_SCOPE_WORKGROUP); __hip_atomic_fetch_add(ip + 1, ib, __ATOMIC_RELAXED, __HIP_MEMORY_SCOPE_WORKGROUP); __hip_atomic_fetch_add(ip + 2, ic, __ATOMIC_RELAXED, __HIP_MEMORY_SCOPE_WORKGROUP); }
    return pack8(p[0], p[1], p[2], p[3], p[4], p[5], p[6], p[7]);
}
template <int PASS> __device__ __forceinline__ void cmp_compute(LAS const unsigned char* kb, const QF& q, f32x4 (&O)[8], float& l, float inv, LAS float* improw, int i, int g4, int tq, int j, float mb) {
    LAS const unsigned char* vb = kb + 16384;
    bf16x8 ka0[4], ka1[4], kb0[4], kb1[4]; f32x4 s0, s1, t0, t1;
    ta_ldk(kb, 0, i, g4, ka0, ka1); TA_SB; ta_ldk(kb, 1, i, g4, kb0, kb1); TA_SB;
    ta_qk(ka0, ka1, q, s0, s1); TA_SB;
    if (PASS == 1) { ta_qk(kb0, kb1, q, t0, t1); TA_SB; (void)cmp_sm<1>(s0, s1, l, inv, improw, 0, i, g4, tq, j, mb); (void)cmp_sm<1>(t0, t1, l, inv, improw, 1, i, g4, tq, j, mb); TA_SB; }
    else { bf16x8 va[8], vc[8];
        ta_ldv(vb, 0, i, g4, va); TA_SB;
        ta_qk(kb0, kb1, q, t0, t1); TA_SB;
        const bf16x8 pf0 = cmp_sm<2>(s0, s1, l, inv, improw, 0, i, g4, tq, j, mb); TA_SB;
        ta_ldv(vb, 1, i, g4, vc); TA_SB;
        ta_pv(va, pf0, O); TA_SB;
        const bf16x8 pf1 = cmp_sm<2>(t0, t1, l, inv, improw, 1, i, g4, tq, j, mb); TA_SB;
        ta_pv(vc, pf1, O); TA_SB; }
}
template <int PASS> __device__ __forceinline__ void cmp_compute2(LAS const unsigned char* kb, const QF& q0, const QF& q1, f32x4 (&O0)[8], f32x4 (&O1)[8], float& l0, float& l1, float inv0, float inv1, LAS float* imp0, LAS float* imp1, int i, int g4, int tq0, int tq1, int j, float mb, bool full) {
    LAS const unsigned char* vb = kb + 16384;
    bf16x8 ka0[4], ka1[4], kb0[4], kb1[4]; f32x4 s0, s1, t0, t1, u0, u1, v0, v1;
    ta_ldk(kb, 0, i, g4, ka0, ka1); ta_ldk(kb, 1, i, g4, kb0, kb1); TA_SB;
    ta_qk(ka0, ka1, q0, s0, s1); ta_qk(kb0, kb1, q0, t0, t1); TA_SB;
    ta_qk(ka0, ka1, q1, u0, u1); ta_qk(kb0, kb1, q1, v0, v1); TA_SB;
    if (PASS == 1) {
        if (full) { (void)cmp_sm<1, true>(s0, s1, l0, inv0, imp0, 0, i, g4, tq0, j, mb); (void)cmp_sm<1, true>(t0, t1, l0, inv0, imp0, 1, i, g4, tq0, j, mb);
                    (void)cmp_sm<1, true>(u0, u1, l1, inv1, imp1, 0, i, g4, tq1, j, mb); (void)cmp_sm<1, true>(v0, v1, l1, inv1, imp1, 1, i, g4, tq1, j, mb); }
        else { (void)cmp_sm<1>(s0, s1, l0, inv0, imp0, 0, i, g4, tq0, j, mb); (void)cmp_sm<1>(t0, t1, l0, inv0, imp0, 1, i, g4, tq0, j, mb);
               (void)cmp_sm<1>(u0, u1, l1, inv1, imp1, 0, i, g4, tq1, j, mb); (void)cmp_sm<1>(v0, v1, l1, inv1, imp1, 1, i, g4, tq1, j, mb); }
        TA_SB; }
    else { bf16x8 va[8], vc[8], pa0, pb0, pa1, pb1;
        ta_ldv(vb, 0, i, g4, va); TA_SB;
        if (full) { pa0 = cmp_sm<2, true>(s0, s1, l0, inv0, imp0, 0, i, g4, tq0, j, mb); pb0 = cmp_sm<2, true>(t0, t1, l0, inv0, imp0, 1, i, g4, tq0, j, mb);
                    pa1 = cmp_sm<2, true>(u0, u1, l1, inv1, imp1, 0, i, g4, tq1, j, mb); pb1 = cmp_sm<2, true>(v0, v1, l1, inv1, imp1, 1, i, g4, tq1, j, mb); }
        else { pa0 = cmp_sm<2>(s0, s1, l0, inv0, imp0, 0, i, g4, tq0, j, mb); pb0 = cmp_sm<2>(t0, t1, l0, inv0, imp0, 1, i, g4, tq0, j, mb);
               pa1 = cmp_sm<2>(u0, u1, l1, inv1, imp1, 0, i, g4, tq1, j, mb); pb1 = cmp_sm<2>(v0, v1, l1, inv1, imp1, 1, i, g4, tq1, j, mb); }
        TA_SB;
        ta_ldv(vb, 1, i, g4, vc); TA_SB;
        ta_pv(va, pa0, O0); ta_pv(vc, pb0, O0); TA_SB;
        ta_pv(va, pa1, O1); ta_pv(vc, pb1, O1); TA_SB; }
}
__device__ __forceinline__ void p4_tiled(const Ctx& C, bool dry = false) {
    const int w = C.wave, lane = C.lane, i = lane & 15, g4 = lane >> 4, tid = C.tid;
    LAS unsigned char* lds = C.lds;
    LAS float* IMP = (LAS float*)(lds + 65536);
    const float mb = WSP(float, WS_MISC)[64];
    constexpr int NT = 4 * 256;
    for (int it = C.bid; it < NT; it += C.G) {
        const int round = it / C.G, base = C.G * round, cntr = (NT - base) < C.G ? (NT - base) : C.G, off = it - base;
        const int tk = base + ((round & 1) ? cntr - 1 - off : off);
        const int qt = 255 - (tk >> 2), bg = tk & 3, b = bg >> 1, g = bg & 1, t0 = 64 * qt;
        const int nvis = (4 * qt + 3) < 1023 ? (4 * qt + 3) : 1023, nb = (nvis + 63) >> 6;
        for (int k = tid; k < 64 * 257; k += 512) IMP[k] = 0.f;
        const int tq0 = t0 + 8 * w + (i >> 2), tq1 = tq0 + 4; const size_t tt0 = (size_t)b * S_ + tq0, tt1 = tt0 + 4; const int hh = g * 4 + (i & 3);
        const QF q0 = load_qf(WSP(bf16_t, WS_QN) + tt0 * 1024 + hh * 128, g4), q1 = load_qf(WSP(bf16_t, WS_QN) + tt1 * 1024 + hh * 128, g4);
        f32x4 O0[8], O1[8]; float l0 = 0.f, l1 = 0.f;
#pragma unroll
        for (int dt = 0; dt < 8; ++dt) { O0[dt] = (f32x4){0.f, 0.f, 0.f, 0.f}; O1[dt] = (f32x4){0.f, 0.f, 0.f, 0.f}; }
        const bf16_t* Kbg = WSP(bf16_t, WS_KC) + (size_t)bg * 1024 * 128; const bf16_t* Vbg = WSP(bf16_t, WS_VCT) + (size_t)bg * 16 * 8192;
        LAS float* imp0 = IMP + (8 * w + (i >> 2)) * 257; LAS float* imp1 = imp0 + 4 * 257;
        __syncthreads();
        ta_issue(lds, 0, Kbg, Vbg, w, lane, true);
        for (int n = 0; n < nb; ++n) {
            asm volatile("s_waitcnt vmcnt(0)" ::: "memory"); __syncthreads();
            if (n + 1 < nb) ta_issue(lds, (n + 1) & 1, Kbg + (size_t)(n + 1) * 64 * 128, Vbg + (size_t)(n + 1) * 8192, w, lane, true);
            LAS const unsigned char* kb = lds + (n & 1) * 32768;
#ifdef MK_P4NOCOMP
            if (!dry)
#endif
            cmp_compute2<1>(kb, q0, q1, O0, O1, l0, l1, 0.f, 0.f, imp0, imp1, i, g4, tq0, tq1, n, mb, 1024 * n + 1039 <= t0);
        }
        l0 += __shfl_xor(l0, 16); l0 += __shfl_xor(l0, 32); l1 += __shfl_xor(l1, 16); l1 += __shfl_xor(l1, 32);
        const float mbi0 = l0 > 0.f ? mb + __builtin_amdgcn_logf(l0) : 1e30f, mbi1 = l1 > 0.f ? mb + __builtin_amdgcn_logf(l1) : 1e30f;
        __syncthreads();
        ta_issue(lds, 0, Kbg, Vbg, w, lane);
        for (int n = 0; n < nb; ++n) {
            asm volatile("s_waitcnt vmcnt(0)" ::: "memory"); __syncthreads();
            if (n + 1 < nb) ta_issue(lds, (n + 1) & 1, Kbg + (size_t)(n + 1) * 64 * 128, Vbg + (size_t)(n + 1) * 8192, w, lane);
            LAS const unsigned char* kb = lds + (n & 1) * 32768;
#ifdef MK_P4NOCOMP
            if (!dry)
#endif
            cmp_compute2<2>(kb, q0, q1, O0, O1, l0, l1, mbi0, mbi1, imp0, imp1, i, g4, tq0, tq1, n, mb, 1024 * n + 1039 <= t0);
        }
        { const float* gates = WSP(float, WS_GATES); const float gc0 = gates[tt0 * 24 + hh * 3 + 0], gc1 = gates[tt1 * 24 + hh * 3 + 0];
          float* ma0 = WSP(float, WS_MIXACC) + tt0 * 1024 + hh * 128 + 4 * g4; float* ma1 = WSP(float, WS_MIXACC) + tt1 * 1024 + hh * 128 + 4 * g4;
#pragma unroll
          for (int dt = 0; dt < 8; ++dt) { const f32x4 v0 = *(const f32x4*)(ma0 + 16 * dt) + O0[dt] * gc0, v1 = *(const f32x4*)(ma1 + 16 * dt) + O1[dt] * gc1; if (!dry) { *(f32x4*)(ma0 + 16 * dt) = v0; *(f32x4*)(ma1 + 16 * dt) = v1; } else { asm volatile("" :: "v"(v0), "v"(v1)); } } }
        __syncthreads();
        const int cur = qt; int* idx = WSP(int, WS_IDX) + ((size_t)bg * S_ + t0 + 8 * w) * 16;
        if (cur <= 15) { for (int q = 0; q < 8; ++q) if (lane < 16) idx[q * 16 + lane] = lane <= cur ? lane : -1; }
        else {
            for (int q0 = 0; q0 < 8; q0 += 2) {
                unsigned key[2][4]; int mypick[2];
#pragma unroll
                for (int u = 0; u < 2; ++u) {
#pragma unroll
                    for (int c = 0; c < 4; ++c) { const int j = lane + 64 * c; const float v = IMP[(8 * w + q0 + u) * 257 + j]; key[u][c] = (j >= 1 && j <= cur - 2) ? ((__float_as_uint(v) & 0xFFFFFF00u) | (unsigned)(255 - j)) : 0u; }
#define SEL_CS(a_, b_) do { const unsigned _h = key[u][a_] > key[u][b_] ? key[u][a_] : key[u][b_], _l = key[u][a_] > key[u][b_] ? key[u][b_] : key[u][a_]; key[u][a_] = _h; key[u][b_] = _l; } while (0)
                    SEL_CS(0, 1); SEL_CS(2, 3); SEL_CS(0, 2); SEL_CS(1, 3); SEL_CS(1, 2);
#undef SEL_CS
                    mypick[u] = lane == 0 ? 0 : (lane == 1 ? cur - 1 : (lane == 2 ? cur : -1)); }
                for (int rd = 0; rd < 13; ++rd) {
#pragma unroll
                    for (int u = 0; u < 2; ++u) {
                        const unsigned M = wave_umax63(key[u][0]); const int jsel = M ? 255 - (int)(M & 255u) : -1;
                        const bool hit = key[u][0] == M && M != 0u;
                        key[u][0] = hit ? key[u][1] : key[u][0]; key[u][1] = hit ? key[u][2] : key[u][1]; key[u][2] = hit ? key[u][3] : key[u][2]; key[u][3] = hit ? 0u : key[u][3];
                        if (lane == 3 + rd) mypick[u] = jsel; }
                }
#pragma unroll
                for (int u = 0; u < 2; ++u) if (lane < 16) idx[(q0 + u) * 16 + lane] = mypick[u];
            }
        }
        __syncthreads();
    }
}

__device__ __forceinline__ void xattn_tiled(const Ctx& C) {
    const int w = C.wave, lane = C.lane, i = lane & 15, g4 = lane >> 4;
    LAS unsigned char* lds = C.lds;
    const float mb = WSP(float, WS_MISC)[65];
    for (int tile = C.bid; tile < NB * 4 * (S_ / 256); tile += C.G) {
        const int qb = tile & 63, hx = (tile >> 6) & 3, b = tile >> 8;
        const bf16_t* Kb = WSP(bf16_t, WS_KX) + (size_t)(b * 4 + hx) * 256 * 128; const bf16_t* Vb = WSP(bf16_t, WS_VXT) + (size_t)(b * 4 + hx) * 4 * 8192;
        __syncthreads();
#pragma unroll
        for (int n = 0; n < 4; ++n) ta_issue(lds, n, Kb + (size_t)n * 64 * 128, Vb + (size_t)n * 8192, w, lane);
        const size_t t0 = (size_t)b * S_ + qb * 256 + 32 * w + i, t1 = t0 + 16;
        const QF q0 = load_qf(WSP(bf16_t, WS_QX) + t0 * 512 + hx * 128, g4), q1 = load_qf(WSP(bf16_t, WS_QX) + t1 * 512 + hx * 128, g4);
        f32x4 O0[8], O1[8]; float l0 = 0.f, l1 = 0.f;
#pragma unroll
        for (int dt = 0; dt < 8; ++dt) { O0[dt] = (f32x4){0.f, 0.f, 0.f, 0.f}; O1[dt] = (f32x4){0.f, 0.f, 0.f, 0.f}; }
        asm volatile("s_waitcnt vmcnt(0)" ::: "memory"); __syncthreads();
        for (int n = 0; n < 4; ++n) { unsigned ko = n * 32768; asm volatile("" : "+s"(ko)); LAS const unsigned char* kb = lds + ko;
            ta_compute2<MODE_NONE>(kb, q0, q1, O0, O1, l0, l1, i, g4, 0, 0, true, true, true, true, 64 * n, mb); }
        l0 += __shfl_xor(l0, 16); l0 += __shfl_xor(l0, 32); l1 += __shfl_xor(l1, 16); l1 += __shfl_xor(l1, 32);
        const float sc0 = l0 > 0.f ? 1.0f / l0 : 0.f, sc1 = l1 > 0.f ? 1.0f / l1 : 0.f;
        unsigned char* d0 = WSP(unsigned char, WS_MIX) + t0 * MIXP + 2048 + hx * 128 + 4 * g4; unsigned char* d1 = WSP(unsigned char, WS_MIX) + t1 * MIXP + 2048 + hx * 128 + 4 * g4;
        const float z0 = sc0 * MIX_SCALE, z1 = sc1 * MIX_SCALE;
#pragma unroll
        for (int dt = 0; dt < 8; ++dt) { *(unsigned*)(d0 + 16 * dt) = pk4_fp8(O0[dt][0] * z0, O0[dt][1] * z0, O0[dt][2] * z0, O0[dt][3] * z0);
            *(unsigned*)(d1 + 16 * dt) = pk4_fp8(O1[dt][0] * z1, O1[dt][1] * z1, O1[dt][2] * z1, O1[dt][3] * z1); }
    }
    __syncthreads();
}
__device__ __forceinline__ void p7_ffn_prep(const Ctx& C, bool dummy = false) {
    const int lane = C.lane, i = lane & 15, g4 = lane >> 4;
    LAS int* cnt = (LAS int*)C.lds; LAS int* basew = (LAS int*)(C.lds + 128); LAS float* lg = (LAS float*)(C.lds + 1024 + C.wave * 2112);
    const bf16_t* WRH = WSP(bf16_t, WS_WRH); const bf16_t* WRL = WSP(bf16_t, WS_WRL);
    unsigned* gcount = (unsigned*)WSP(unsigned, WS_CTL) + CW_GCOUNT + (dummy ? 64 : 0);
    const size_t lofs = dummy ? (WS_PROJ - WS_LIST) / 4 : 0;
    for (int u = C.bid; u < T_ / 128; u += C.G) {
        if (C.tid < 32) cnt[C.tid] = 0;
        __syncthreads();
        const int row = u * 128 + C.wave * 16 + i;
        float ssq = 0.f; { const f32x4* rp = (const f32x4*)(WSP(float, WS_ROWSS) + (size_t)row * 32);
#pragma unroll
          for (int k = 0; k < 8; ++k) { const f32x4 v = rp[k]; ssq += (v[0] + v[1]) + (v[2] + v[3]); } }
        const float rstd = rsqrtf(ssq * (1.0f / D_) + EPS);
        const _Float16* __restrict__ x1 = WSP(_Float16, WS_X1H) + (size_t)row * D_ + 8 * g4; const float* fg = C.ka->in[I_FFG] + 8 * g4; unsigned char* __restrict__ h2 = WSP(unsigned char, WS_H) + (size_t)row * D_ + 8 * g4;
        f32x4 a0 = {0.f, 0.f, 0.f, 0.f}, a1 = {0.f, 0.f, 0.f, 0.f};
        const int rot = ((C.bid >> 3) * 2 + (C.bid & 1)) & 63;
#define P7_RC(c_) (((c_) + rot) & 63)
        f16x8 xq[4];
#pragma unroll
        for (int d = 0; d < 4; ++d) xq[d] = *(const f16x8*)(x1 + 32 * P7_RC(d));
        bf16x8 b0hN = *(const bf16x8*)(WRH + (size_t)i * D_ + 32 * rot + 8 * g4), b1hN = *(const bf16x8*)(WRH + (size_t)(i + 16) * D_ + 32 * rot + 8 * g4), b0lN = *(const bf16x8*)(WRL + (size_t)i * D_ + 32 * rot + 8 * g4), b1lN = *(const bf16x8*)(WRL + (size_t)(i + 16) * D_ + 32 * rot + 8 * g4);
        for (int c4 = 0; c4 < 64; c4 += 4) {
#pragma unroll
          for (int d = 0; d < 4; ++d) { const int cl = c4 + d, c = P7_RC(cl);
            const f32x8 xf = __builtin_convertvector(xq[d], f32x8); const f32x4 xa = {xf[0], xf[1], xf[2], xf[3]}, xb = {xf[4], xf[5], xf[6], xf[7]}, ga = *(const f32x4*)(fg + 32 * c), gb = *(const f32x4*)(fg + 32 * c + 4);
            const bf16x8 b0h = b0hN, b1h = b1hN, b0l = b0lN, b1l = b1lN;
            { const int cx = P7_RC(cl + 4 < 64 ? cl + 4 : 63); xq[d] = *(const f16x8*)(x1 + 32 * cx);
              const int cn = P7_RC(cl < 63 ? cl + 1 : cl); const size_t bn = (size_t)i * D_ + 32 * cn + 8 * g4;
              b0hN = *(const bf16x8*)(WRH + bn); b1hN = *(const bf16x8*)(WRH + bn + (size_t)16 * D_); b0lN = *(const bf16x8*)(WRL + bn); b1lN = *(const bf16x8*)(WRL + bn + (size_t)16 * D_); }
            float h[8]; h[0] = xa[0] * ga[0] * rstd; h[1] = xa[1] * ga[1] * rstd; h[2] = xa[2] * ga[2] * rstd; h[3] = xa[3] * ga[3] * rstd; h[4] = xb[0] * gb[0] * rstd; h[5] = xb[1] * gb[1] * rstd; h[6] = xb[2] * gb[2] * rstd; h[7] = xb[3] * gb[3] * rstd;
            u32x4 hi; hi.x = cvt_pk_bf16(h[0], h[1]); hi.y = cvt_pk_bf16(h[2], h[3]); hi.z = cvt_pk_bf16(h[4], h[5]); hi.w = cvt_pk_bf16(h[6], h[7]);
            { u32x2 w8; w8.x = pk4_fp8(h[0], h[1], h[2], h[3]); w8.y = pk4_fp8(h[4], h[5], h[6], h[7]); *(u32x2*)(h2 + 32 * c) = w8; }
            u32x4 lo; lo.x = cvt_pk_bf16(h[0] - __uint_as_float(hi.x << 16), h[1] - __uint_as_float(hi.x & 0xFFFF0000u)); lo.y = cvt_pk_bf16(h[2] - __uint_as_float(hi.y << 16), h[3] - __uint_as_float(hi.y & 0xFFFF0000u));
            lo.z = cvt_pk_bf16(h[4] - __uint_as_float(hi.z << 16), h[5] - __uint_as_float(hi.z & 0xFFFF0000u)); lo.w = cvt_pk_bf16(h[6] - __uint_as_float(hi.w << 16), h[7] - __uint_as_float(hi.w & 0xFFFF0000u));
            const bf16x8 ah = __builtin_bit_cast(bf16x8, hi), al = __builtin_bit_cast(bf16x8, lo);
            a0 = __builtin_amdgcn_mfma_f32_16x16x32_bf16(ah, b0h, a0, 0, 0, 0); a0 = __builtin_amdgcn_mfma_f32_16x16x32_bf16(ah, b0l, a0, 0, 0, 0); a0 = __builtin_amdgcn_mfma_f32_16x16x32_bf16(al, b0h, a0, 0, 0, 0);
            a1 = __builtin_amdgcn_mfma_f32_16x16x32_bf16(ah, b1h, a1, 0, 0, 0); a1 = __builtin_amdgcn_mfma_f32_16x16x32_bf16(ah, b1l, a1, 0, 0, 0); a1 = __builtin_amdgcn_mfma_f32_16x16x32_bf16(al, b1h, a1, 0, 0, 0);
          }
        }
#pragma unroll
        for (int r = 0; r < 4; ++r) { lg[(4 * g4 + r) * 33 + i] = a0[r]; lg[(4 * g4 + r) * 33 + 16 + i] = a1[r]; }
        int e4[4] = {0, 0, 0, 0}, rk[4] = {0, 0, 0, 0}; float gk[4] = {0.f, 0.f, 0.f, 0.f}; const int tokrow = u * 128 + C.wave * 16 + lane;
        if (lane < 16) {
            float v[32];
#pragma unroll
            for (int e = 0; e < 32; ++e) v[e] = lg[lane * 33 + e] + C.ka->in[I_BR][e];
            float tv[4];
#pragma unroll
            for (int k = 0; k < 4; ++k) { float best = -__builtin_inff(); int be = 0;
#pragma unroll
                for (int e = 0; e < 32; ++e) { const bool taken = (k > 0 && e == e4[0]) || (k > 1 && e == e4[1]) || (k > 2 && e == e4[2]); if (!taken && v[e] > best) { best = v[e]; be = e; } }
                e4[k] = be; tv[k] = best; }
            const float p1 = __expf(tv[1] - tv[0]), p2 = __expf(tv[2] - tv[0]), p3 = __expf(tv[3] - tv[0]); const float inv = 1.0f / (1.0f + p1 + p2 + p3);
            gk[0] = inv; gk[1] = p1 * inv; gk[2] = p2 * inv; gk[3] = p3 * inv;
#pragma unroll
            for (int k = 0; k < 4; ++k) rk[k] = __hip_atomic_fetch_add(cnt + e4[k], 1, __ATOMIC_RELAXED, __HIP_MEMORY_SCOPE_WORKGROUP);
        }
        __syncthreads();
        if (C.tid < 32) basew[C.tid] = (int)__hip_atomic_fetch_add(gcount + C.tid, (unsigned)cnt[C.tid], __ATOMIC_RELAXED, __HIP_MEMORY_SCOPE_AGENT);
        __syncthreads();
        if (lane < 16) {
#pragma unroll
            for (int k = 0; k < 4; ++k) { const size_t li = (size_t)e4[k] * LIST_CAP + basew[e4[k]] + rk[k] + lofs; WSP(int, WS_LIST)[li] = tokrow * 4 + k; WSP(float, WS_LGATE)[li] = gk[k]; } }
        __syncthreads();
    }
}
__device__ __forceinline__ void moe_tables(const Ctx& C, LAS int* tb) {
    if (C.tid < 64) { const unsigned* gcount = (const unsigned*)WSP(unsigned, WS_CTL) + CW_GCOUNT; const int e = C.tid & 31;
        const int c = (int)__hip_atomic_load(gcount + e, __ATOMIC_RELAXED, __HIP_MEMORY_SCOPE_AGENT); const int tiles = (c + 255) >> 8; int incl = tiles;
#pragma unroll
        for (int o = 1; o < 32; o <<= 1) { const int v = __shfl_up(incl, o, 32); if (e >= o) incl += v; }
        if (C.tid < 32) { tb[e] = incl - tiles; tb[33 + e] = c; if (e == 31) tb[32] = incl; } }
    __syncthreads();
}
__device__ __forceinline__ void p10_combine(const Ctx& C, float* dstbase) {
    const size_t gt = (size_t)C.bid * 512 + C.tid, GT = (size_t)C.G * 512; const unsigned char* __restrict__ Y = WSP(unsigned char, WS_Y);
    const _Float16* src = WSP(_Float16, WS_X1H);
    for (size_t idx0 = gt; idx0 < (size_t)T_ * 256; idx0 += 2 * GT) {
        f16x8 xh[2]; u32x2 y[2][4]; bool ok[2];
#pragma unroll
        for (int u = 0; u < 2; ++u) { const size_t idx = idx0 + u * GT; ok[u] = idx < (size_t)T_ * 256; const size_t t = ok[u] ? idx >> 8 : 0; const int c8 = (int)(idx & 255) * 8;
            xh[u] = __builtin_nontemporal_load((const f16x8*)(src + t * D_ + c8));
#pragma unroll
            for (int k = 0; k < 4; ++k) y[u][k] = __builtin_nontemporal_load((const u32x2*)(Y + (t * 4 + k) * D_ + c8)); }
#pragma unroll
        for (int u = 0; u < 2; ++u) { const size_t idx = idx0 + u * GT; const size_t t = idx >> 8; const int c8 = (int)(idx & 255) * 8; f32x4 sa = {0.f, 0.f, 0.f, 0.f}, sb = {0.f, 0.f, 0.f, 0.f};
#pragma unroll
            for (int k = 0; k < 4; ++k) { const f32x2 y0 = __builtin_amdgcn_cvt_pk_f32_fp8((int)y[u][k].x, false), y1 = __builtin_amdgcn_cvt_pk_f32_fp8((int)y[u][k].x, true), y2 = __builtin_amdgcn_cvt_pk_f32_fp8((int)y[u][k].y, false), y3 = __builtin_amdgcn_cvt_pk_f32_fp8((int)y[u][k].y, true);
                sa[0] += y0.x; sa[1] += y0.y; sa[2] += y1.x; sa[3] += y1.y; sb[0] += y2.x; sb[1] += y2.y; sb[2] += y3.x; sb[3] += y3.y; }
            if (ok[u]) { float* d = dstbase + t * D_ + c8; const f32x8 xf = __builtin_convertvector(xh[u], f32x8); const f32x4 a = {xf[0], xf[1], xf[2], xf[3]}, b = {xf[4], xf[5], xf[6], xf[7]};
                *(f32x4*)d = a + sa * (1.0f / Y_FP8_SCALE); *(f32x4*)(d + 4) = b + sb * (1.0f / Y_FP8_SCALE); } }
    }
}

__device__ __forceinline__ void fresh_tid(Ctx& C) { int t = threadIdx.x; asm volatile("" : "+v"(t)); C.tid = t; C.lane = t & 63; const Args* k = C.ka; asm volatile("" : "+s"(k)); C.ka = k; }
constexpr int N_PHASES = 11;
#ifndef MK_REPEAT
#define MK_REPEAT 0
#endif
#define REP(k) if ((MK_REPEAT >> (k)) & 1)
#ifndef E2_TAIL
#define E2_TAIL 11
#endif
#ifndef NCONV_16THS
#define NCONV_16THS 6
#endif
__global__ void __launch_bounds__(512, 2) mk_fwd(Args args) {
    extern __shared__ __attribute__((aligned(16))) unsigned char lds_raw[];
    Ctx C;
    C.ka = (const Args*)__builtin_amdgcn_kernarg_segment_ptr();
    C.out = args.out; C.ws = args.ws; C.lds = (LAS unsigned char*)lds_raw; C.tid = threadIdx.x; C.lane = C.tid & 63; C.wave = __builtin_amdgcn_readfirstlane(C.tid >> 6); C.G = gridDim.x; C.bid = blockIdx.x;
    volatile LAS unsigned* misc = (volatile LAS unsigned*)(C.lds + LDS_MISC);
    if (C.tid < 4) misc[C.tid] = 0u;
    __syncthreads();
    const int lo = args.ph_lo, hi = args.ph_hi;
    XcdBarrier bar; bar.bar = WSP(unsigned, WS_CTL) + CW_BAR; bar.x = 0; bar.st = misc;
    if (hi - lo > 1) bar = xcd_barrier_post(WSP(unsigned, WS_CTL) + CW_BAR, misc);
#define IN(k) (fresh_tid(C), lo <= (k) && (k) < hi)
#define SEAM(k) do { if (IN(k) && IN((k) + 1)) xcd_barrier(bar); } while (0)
    LAS int* tb = (LAS int*)(C.lds + LDS_MISC + 64);
    if (IN(0)) { p0_prologue(C); REP(0) { xcd_barrier(bar); p0_prologue(C); } } SEAM(0);
    if (IN(1)) for (int rep_ = 0; rep_ < 1 + ((MK_REPEAT >> 1) & 1); ++rep_) { if (rep_) xcd_barrier(bar);
        const int nconv = (C.G % 8 == 0 && C.G >= 64) ? ((C.G * NCONV_16THS / 16) & ~7) : 0, Gg = C.G - nconv;
        if (nconv == 0 || C.bid >= Gg) { const int cb = nconv ? C.bid - Gg : C.bid, cg = nconv ? nconv : C.G;
#ifdef MK_CONV2
            for (int r2 = 0; r2 < MK_CONV2; ++r2) { tjob_b<2048, 4096, 2>(C, cb, cg, C.ka->in[I_WE1], C.ws + WS_W1T, NEXP); tjob_b<2048, 2048, 0>(C, cb, cg, C.ka->in[I_WE2], C.ws + WS_W2T, NEXP); }
#endif
            tjob_b<2048, 4096, 2>(C, cb, cg, C.ka->in[I_WE1], C.ws + WS_W1T, NEXP); tjob_b<2048, 2048, 0>(C, cb, cg, C.ka->in[I_WE2], C.ws + WS_W2T, nconv ? NEXP - E2_TAIL : NEXP); }
        if (nconv == 0 || C.bid < Gg)
#ifdef MK_GEMM2
        for (int r3 = 0; r3 < 2; ++r3)
#endif
        {
        { pg8::Gemm g{WSP(bf16_t, WS_H8), WSP(bf16_t, WS_WIN8), T_, 3328, D_ / 2}; pg8::StaticOrder S; S.init(T_, 3328, Gg, C.bid); pg8::EpiBf16 E{WSP(bf16_t, WS_PROJ), NPROJ, 1024, 1.0f / W_FP8_SCALE};
          pg8::gemm_phase<pg8::EpiBf16, pg8::StaticOrder, false, true>(C.lds, g, S, E); }
        { pg8::Gemm g{WSP(bf16_t, WS_H), WSP(bf16_t, WS_WIN), T_, 1024, D_}; pg8::StaticOrder S; S.init(T_, 1024, Gg, C.bid); pg8::EpiBf16 E{WSP(bf16_t, WS_PROJ), NPROJ, 0, 1.0f};
          pg8::gemm_phase<pg8::EpiBf16, pg8::StaticOrder, false>(C.lds, g, S, E); }
        { pg8::Gemm g{WSP(bf16_t, WS_MEMN), WSP(bf16_t, WS_WKV), NB * MEMT, 1024, D_ / 2}; pg8::StaticOrder S; S.init(NB * MEMT, 1024, Gg, Gg >= 128 ? C.bid - 64 : C.bid); pg8::EpiBf16 E{WSP(bf16_t, WS_MEMKV), 1024, 0, 1.0f / W_FP8_SCALE};
          pg8::gemm_phase<pg8::EpiBf16, pg8::StaticOrder, false, true>(C.lds, g, S, E); }
        fresh_tid(C); if (nconv) tjob_b<2048, 2048, 0>(C, C.bid, Gg, C.ka->in[I_WE2] + (size_t)(NEXP - E2_TAIL) * FF * D_, C.ws + WS_W2T + (size_t)(NEXP - E2_TAIL) * FF * D_, E2_TAIL);
        }
    } SEAM(1);
    if (IN(2)) { p2_token_prep(C); REP(2) { xcd_barrier(bar); p2_token_prep(C); } } SEAM(2);
    if (IN(3)) { tile_attn_phase<MODE_WIN>(C); REP(3) { tile_attn_phase<MODE_WIN>(C); } fresh_tid(C); for (int rep_ = 0; rep_ < 1 + ((MK_REPEAT >> 13) & 1); ++rep_) xattn_tiled(C); fresh_tid(C); p3_tasks(C); REP(4) { xcd_barrier(bar); p3_tasks(C); } } SEAM(3);
    if (IN(4)) { REP(11) { p4_tiled(C, true); xcd_barrier(bar); } p4_tiled(C); } SEAM(4);
    if (IN(5)) { tile_attn_phase<MODE_SEL>(C); REP(5) { xcd_barrier(bar);
#ifdef MK_SELDRY
            tile_attn_phase<MODE_SEL, MK_SELDRY>(C);
#else
            tile_attn_phase<MODE_SEL>(C);
#endif
        } } SEAM(5);
    if (IN(6)) for (int rep_ = ((MK_REPEAT >> 6) & 1) ? 0 : 1; rep_ < 2; ++rep_) { pg8::Gemm g{WSP(bf16_t, WS_MIX), WSP(bf16_t, WS_WOUT), T_, D_, MIXP / 2}; pg8::StaticOrder S; S.init(T_, D_, C.G, C.bid); pg8::EpiResF32 E{C.ka, C.ws, D_, rep_ ? WS_ROWSS : WS_PROJ, 1.0f / (MIX_SCALE * W_FP8_SCALE)};
        pg8::gemm_phase<pg8::EpiResF32, pg8::StaticOrder, false, 2>(C.lds, g, S, E); if (!rep_) xcd_barrier(bar); } SEAM(6);
    if (IN(7)) { REP(7) { p7_ffn_prep(C, true); xcd_barrier(bar); } p7_ffn_prep(C); } SEAM(7);
    if (IN(8)) for (int rep_ = 0; rep_ < 1 + ((MK_REPEAT >> 8) & 1); ++rep_) { if (rep_) xcd_barrier(bar); moe_tables(C, tb); pg8::Gemm g{WSP(bf16_t, WS_H), WSP(bf16_t, WS_W1T), 0, 4096, D_ / 2};   pg8::MoeOrder S; S.init_moe(16, C.G, C.bid, tb, C.ws, (LAS int*)(C.lds + LDS_MISC + 2048));
        pg8::EpiGlu E{C.ws};
        pg8::gemm_phase<pg8::EpiGlu, pg8::MoeOrder, true, true>(C.lds, g, S, E); } SEAM(8);
    if (IN(9)) for (int rep_ = 0; rep_ < 1 + ((MK_REPEAT >> 9) & 1); ++rep_) { if (rep_) xcd_barrier(bar); moe_tables(C, tb); pg8::Gemm g{WSP(bf16_t, WS_ACT), WSP(bf16_t, WS_W2T), 0, D_, FF / 2}; pg8::MoeOrder S; S.init_moe(8, C.G, C.bid, tb, C.ws, (LAS int*)(C.lds + LDS_MISC + 2048));
        pg8::EpiScatter E{C.ws, C.ka};
        pg8::gemm_phase<pg8::EpiScatter, pg8::MoeOrder, false, true>(C.lds, g, S, E); } SEAM(9);
    if (IN(10)) { REP(10) { p10_combine(C, WSP(float, WS_PROJ)); xcd_barrier(bar); } p10_combine(C, C.out); }
#undef IN
#undef SEAM
}

extern "C" void kernel_launch(void* const* d_in, const int* in_sizes, int n_in, void* d_out, int out_size, void* d_ws, size_t ws_size, hipStream_t stream) {
    static int grid = 0;
    if (grid == 0) {
        if (n_in != 27 || out_size != T_ * D_ || ws_size < WS_END) { fprintf(stderr, "kernel_launch: unexpected shapes (n_in %d, out %d, ws %zu < %zu)\n", n_in, out_size, ws_size, (size_t)WS_END); grid = -1; return; }
        int dev = 0, cus = 0, per_cu = 0;
        if (hipGetDevice(&dev) != hipSuccess || hipDeviceGetAttribute(&cus, hipDeviceAttributeMultiprocessorCount, dev) != hipSuccess) { grid = -1; return; }
        if (hipFuncSetAttribute((const void*)mk_fwd, hipFuncAttributeMaxDynamicSharedMemorySize, LDS_BYTES) != hipSuccess) { fprintf(stderr, "kernel_launch: hipFuncSetAttribute failed\n"); grid = -1; return; }
        if (hipOccupancyMaxActiveBlocksPerMultiprocessor(&per_cu, (const void*)mk_fwd, 512, LDS_BYTES) != hipSuccess || per_cu < 1) fprintf(stderr, "kernel_launch: occupancy query reports %d\n", per_cu);
        (void)hipGetLastError();
        grid = cus;
    }
    if (grid < 0) return;
    (void)in_sizes;
    if (hipMemsetAsync((char*)d_ws + WS_CTL, 0, CTL_BYTES, stream) != hipSuccess) return;
    Args a{};
    for (int i = 0; i < 27; ++i) a.in[i] = (const float*)d_in[i];
    a.out = (float*)d_out; a.ws = (unsigned char*)d_ws;
#if MK_N_LAUNCHES == 1
    a.ph_lo = 0; a.ph_hi = N_PHASES;
    hipLaunchKernelGGL(mk_fwd, dim3(grid), dim3(512), LDS_BYTES, stream, a);
#else
    for (int p = 0; p < N_PHASES; ++p) { a.ph_lo = p; a.ph_hi = p + 1; hipLaunchKernelGGL(mk_fwd, dim3(grid), dim3(512), LDS_BYTES, stream, a); }
#endif
}
```
